# Optimizing an MI355X kernel written in HIP

```python
import math
import jax
import jax.numpy as jnp
from jax import lax
import numpy as np

D_MODEL = 1024
BATCH = 2
SEQ = 16384
DEPTH = 2

HEAD_DIM = 64
EPS = 1e-6
A_HEADS = 4
A_PATTERNS = ((128, 1), (512, 4), (2048, 16))
A_BLOCK = 128
ROPE_THETA = 500000.0
ROPE_DIM = HEAD_DIM // 4
R_HEADS = 4
R_QK_DIM = 64
R_V_DIM = 128
R_CHUNK = 128
R_ROPE_THETA = 10000.0
S_CHANNELS = 256
S_GROUP = 16
S_GROUPS = S_CHANNELS // S_GROUP
S_STATE = 64
A_WIDTH = A_HEADS * HEAD_DIM
R_WIDTH = R_HEADS * R_V_DIM
MIX_WIDTH = A_WIDTH + R_WIDTH + S_CHANNELS
IN_SPLITS = (A_WIDTH, A_WIDTH, A_WIDTH, R_HEADS * R_QK_DIM, R_HEADS * R_QK_DIM, R_WIDTH, R_WIDTH, S_CHANNELS)
IN_COLS = sum(IN_SPLITS)
D_FF = 2816
N_EXPERTS = 8
TOP_K = 2
D_FF_EXPERT = 3584

kernel_name = "hybrid_dilated_retention_s5_moe_block"


def rms_norm(x, g):
    xf = x.astype(jnp.float32)
    y = xf * lax.rsqrt(jnp.mean(xf * xf, axis=-1, keepdims=True) + EPS)
    return (y * g.astype(jnp.float32)).astype(x.dtype)


def rotary(x, pos, rot_dim, theta):
    half = rot_dim // 2
    inv = jnp.power(theta, -jnp.arange(half, dtype=jnp.float32) * 2.0 / rot_dim)
    ang = pos.astype(jnp.float32)[:, None] * inv[None, :]
    cos = jnp.cos(ang)[:, None, :]
    sin = jnp.sin(ang)[:, None, :]
    xr = x[..., :rot_dim].astype(jnp.float32)
    x1, x2 = xr[..., :half], xr[..., half:]
    rot = jnp.concatenate([x1 * cos - x2 * sin, x2 * cos + x1 * sin], axis=-1).astype(x.dtype)
    return jnp.concatenate([rot, x[..., rot_dim:]], axis=-1)


def dilated_window_attention(q, k, v, dilation):
    b, h, s, hd = q.shape
    span = A_BLOCK * dilation
    s_pad = -(-s // span) * span
    lr = s_pad // dilation
    nb = lr // A_BLOCK

    def to_blocks(t):
        t = jnp.pad(t, ((0, 0), (0, 0), (0, s_pad - s), (0, 0)))
        t = t.reshape(b, h, lr, dilation, hd).transpose(0, 1, 3, 2, 4)
        return t.reshape(b, h, dilation, nb, A_BLOCK, hd)

    def with_prev(t):
        prev = jnp.pad(t, ((0, 0), (0, 0), (0, 0), (1, 0), (0, 0), (0, 0)))[:, :, :, :-1]
        return jnp.concatenate([prev, t], axis=4)

    qb = to_blocks(q)
    kk = with_prev(to_blocks(k))
    vv = with_prev(to_blocks(v))
    scores = jnp.einsum('bhrnid,bhrnjd->bhrnij', qb, kk) * (hd ** -0.5)
    i = jnp.arange(A_BLOCK)[:, None]
    j = jnp.arange(2 * A_BLOCK)[None, :]
    steps = A_BLOCK + i - j
    band = (steps >= 0) & (steps <= A_BLOCK)
    blk = jnp.arange(nb)[:, None, None]
    mask = band[None] & ((blk > 0) | (j >= A_BLOCK)[None])
    scores = jnp.where(mask, scores, -jnp.inf)
    m = jnp.max(scores, axis=-1, keepdims=True)
    p = jnp.exp(scores - m)
    l = jnp.sum(p, axis=-1, keepdims=True)
    o = jnp.einsum('bhrnij,bhrnjd->bhrnid', p / l, vv)
    lse = (m + jnp.log(l))[..., 0]

    def from_blocks(t):
        t = t.reshape(b, h, dilation, lr, *t.shape[5:])
        t = jnp.moveaxis(t, 2, 3)
        return t.reshape(b, h, s_pad, *t.shape[4:])[:, :, :s]

    return from_blocks(o), from_blocks(lse)


def mixer_dilated(q, k, v, q_g, k_g, pos):
    b, s, _ = q.shape
    shp = (b, s, A_HEADS, HEAD_DIM)
    q = rotary(rms_norm(q.reshape(shp), q_g), pos, ROPE_DIM, ROPE_THETA)
    k = rotary(rms_norm(k.reshape(shp), k_g), pos, ROPE_DIM, ROPE_THETA)
    v = v.reshape(shp)
    qh, kh, vh = [t.astype(jnp.float32).transpose(0, 2, 1, 3) for t in (q, k, v)]
    outs, lses = [], []
    for _, dil in A_PATTERNS:
        o_p, lse_p = dilated_window_attention(qh, kh, vh, dil)
        outs.append(o_p)
        lses.append(lse_p)
    w = jax.nn.softmax(jnp.stack(lses, axis=0), axis=0)
    o = jnp.einsum('pbhs,pbhsd->bhsd', w, jnp.stack(outs, axis=0))
    return o.transpose(0, 2, 1, 3).reshape(b, s, A_WIDTH).astype(q.dtype)


def mixer_retention(q, k, v, g, gn_g, pos):
    f32 = jnp.float32
    b, s, _ = q.shape
    dtype = q.dtype
    q = rotary(q.reshape(b, s, R_HEADS, R_QK_DIM), pos, R_QK_DIM, R_ROPE_THETA).astype(f32)
    k = (rotary(k.reshape(b, s, R_HEADS, R_QK_DIM), pos, R_QK_DIM, R_ROPE_THETA).astype(f32) * (R_QK_DIM ** -0.5))
    v = v.astype(f32).reshape(b, s, R_HEADS, R_V_DIM)
    log_gamma = jnp.log1p(-jnp.exp2(-5.0 - jnp.arange(R_HEADS, dtype=f32)))
    n = s // R_CHUNK
    qc = q.reshape(b, n, R_CHUNK, R_HEADS, R_QK_DIM)
    kc = k.reshape(b, n, R_CHUNK, R_HEADS, R_QK_DIM)
    vc = v.reshape(b, n, R_CHUNK, R_HEADS, R_V_DIM)
    idx = jnp.arange(R_CHUNK, dtype=f32)
    diff = idx[:, None] - idx[None, :]
    decay = jnp.where(diff >= 0, jnp.exp(log_gamma[:, None, None] * jnp.maximum(diff, 0.0)), 0.0)
    inner = jnp.einsum('bnihd,bnjhd->bnhij', qc, kc) * decay
    inner = jnp.einsum('bnhij,bnjhe->bnihe', inner, vc)
    zeta = jnp.exp(log_gamma[:, None] * (R_CHUNK - 1.0 - idx))
    xi = jnp.exp(log_gamma[:, None] * (idx + 1.0))
    kv = jnp.einsum('bnjhd,bnjhe,hj->nbhde', kc, vc, zeta)
    chunk_decay = jnp.exp(log_gamma * R_CHUNK)[None, :, None, None]

    def step(state, kv_n):
        return chunk_decay * state + kv_n, state

    _, prev = lax.scan(step, jnp.zeros((b, R_HEADS, R_QK_DIM, R_V_DIM), f32), kv)
    cross = jnp.einsum('bnihd,nbhde,hi->bnihe', qc, prev, xi)
    y = (inner + cross).reshape(b, s, R_HEADS, R_V_DIM)
    mu = jnp.mean(y, axis=-1, keepdims=True)
    var = jnp.mean(jnp.square(y - mu), axis=-1, keepdims=True)
    y = ((y - mu) * lax.rsqrt(var + 1e-5)).reshape(b, s, R_WIDTH) * gn_g.astype(f32)
    return (jax.nn.silu(g.astype(f32)) * y).astype(dtype)


def mixer_ssm(u, a_re, a_im, b_re, b_im, c_re, c_im, d_skip, log_dt, glu_w, glu_b):
    f32 = jnp.float32
    bsz, s, _ = u.shape
    uf = u.astype(f32).reshape(bsz, s, S_GROUPS, S_GROUP)
    dt = jnp.exp(log_dt.astype(f32))[:, None]
    lam_re = a_re.astype(f32)
    lam_im = a_im.astype(f32)
    mag = jnp.exp(lam_re * dt)
    abar_re = mag * jnp.cos(lam_im * dt)
    abar_im = mag * jnp.sin(lam_im * dt)
    den = lam_re * lam_re + lam_im * lam_im
    nr = abar_re - 1.0
    ni = abar_im
    f_re = ((nr * lam_re + ni * lam_im) / den)[..., None]
    f_im = ((ni * lam_re - nr * lam_im) / den)[..., None]
    br = b_re.astype(f32)
    bi = b_im.astype(f32)
    bb_re = f_re * br - f_im * bi
    bb_im = f_re * bi + f_im * br
    x_re = jnp.einsum('bsgc,gpc->bsgp', uf, bb_re)
    x_im = jnp.einsum('bsgc,gpc->bsgp', uf, bb_im)
    shp = (bsz, s, S_GROUPS, S_STATE)
    at_re = jnp.broadcast_to(abar_re, shp)
    at_im = jnp.broadcast_to(abar_im, shp)

    def combine(e1, e2):
        a1r, a1i, b1r, b1i = e1
        a2r, a2i, b2r, b2i = e2
        return (a2r * a1r - a2i * a1i,
                a2r * a1i + a2i * a1r,
                a2r * b1r - a2i * b1i + b2r,
                a2r * b1i + a2i * b1r + b2i)

    _, _, h_re, h_im = lax.associative_scan(combine, (at_re, at_im, x_re, x_im), axis=1)
    y = (jnp.einsum('gcp,bsgp->bsgc', c_re.astype(f32), h_re)
         - jnp.einsum('gcp,bsgp->bsgc', c_im.astype(f32), h_im)
         + d_skip.astype(f32).reshape(S_GROUPS, S_GROUP) * uf)
    z = jax.nn.gelu(y.reshape(bsz, s, S_CHANNELS))
    out = z * jax.nn.sigmoid(z @ glu_w.astype(f32) + glu_b.astype(f32))
    return out.astype(u.dtype)


def swiglu(x, w_gate, w_up, w_down):
    return (jax.nn.silu(x @ w_gate) * (x @ w_up)) @ w_down


def moe_swiglu(x, router, w_gate, w_up, w_down):
    b, s, d = x.shape
    t = x.reshape(b * s, d)
    probs = jax.nn.softmax((t @ router).astype(jnp.float32), axis=-1)
    top_p, top_i = lax.top_k(probs, TOP_K)
    top_p = top_p / jnp.sum(top_p, axis=-1, keepdims=True)
    gates = jnp.sum(jax.nn.one_hot(top_i, N_EXPERTS, dtype=jnp.float32) * top_p[..., None], axis=1)
    out = jnp.zeros((b * s, d), jnp.float32)
    for e in range(N_EXPERTS):
        out = out + gates[:, e:e + 1] * swiglu(t, w_gate[e], w_up[e], w_down[e]).astype(jnp.float32)
    return out.astype(x.dtype).reshape(b, s, d)


def setup_inputs(seed: int = 0) -> dict:
    key = jax.random.key(seed)
    ks = iter(jax.random.split(key, 32))
    f32 = jnp.float32
    L = DEPTH
    NE = (DEPTH + 1) // 2
    NO = DEPTH // 2
    G, P = S_GROUPS, S_STATE

    def nrm(shape, scale):
        return jax.random.normal(next(ks), shape, f32) * scale

    return {
        "x": nrm((BATCH, SEQ, D_MODEL), 1.0),
        "norm1_g": 1.0 + nrm((L, D_MODEL), 0.02),
        "w_in": nrm((L, D_MODEL, IN_COLS), D_MODEL ** -0.5),
        "q_norm_g": 1.0 + nrm((L, HEAD_DIM), 0.02),
        "k_norm_g": 1.0 + nrm((L, HEAD_DIM), 0.02),
        "ret_gn_g": 1.0 + nrm((L, R_WIDTH), 0.02),
        "ssm_a_re": -0.5 + nrm((L, G, P), 0.01),
        "ssm_a_im": jnp.pi * jnp.arange(P, dtype=f32)[None, None, :] + nrm((L, G, P), 0.01),
        "ssm_b_re": nrm((L, G, P, S_GROUP), (2 * S_GROUP) ** -0.5),
        "ssm_b_im": nrm((L, G, P, S_GROUP), (2 * S_GROUP) ** -0.5),
        "ssm_c_re": nrm((L, G, S_GROUP, P), 0.5),
        "ssm_c_im": nrm((L, G, S_GROUP, P), 0.5),
        "ssm_d": nrm((L, S_CHANNELS), 0.5),
        "ssm_log_dt": jax.random.uniform(next(ks), (L, G), f32, math.log(1e-3), math.log(1e-1)),
        "ssm_glu_w": nrm((L, S_CHANNELS, S_CHANNELS), S_CHANNELS ** -0.5),
        "ssm_glu_b": nrm((L, S_CHANNELS), 0.01),
        "w_out": nrm((L, MIX_WIDTH, D_MODEL), MIX_WIDTH ** -0.5),
        "norm2_g": 1.0 + nrm((L, D_MODEL), 0.02),
        "ffn_w_gate": nrm((NE, D_MODEL, D_FF), D_MODEL ** -0.5),
        "ffn_w_up": nrm((NE, D_MODEL, D_FF), D_MODEL ** -0.5),
        "ffn_w_down": nrm((NE, D_FF, D_MODEL), D_FF ** -0.5),
        "moe_router": nrm((NO, D_MODEL, N_EXPERTS), D_MODEL ** -0.5),
        "moe_w_gate": nrm((NO, N_EXPERTS, D_MODEL, D_FF_EXPERT), D_MODEL ** -0.5),
        "moe_w_up": nrm((NO, N_EXPERTS, D_MODEL, D_FF_EXPERT), D_MODEL ** -0.5),
        "moe_w_down": nrm((NO, N_EXPERTS, D_FF_EXPERT, D_MODEL), D_FF_EXPERT ** -0.5),
    }


def reference(x, norm1_g, w_in, q_norm_g, k_norm_g, ret_gn_g, ssm_a_re, ssm_a_im, ssm_b_re, ssm_b_im,
              ssm_c_re, ssm_c_im, ssm_d, ssm_log_dt, ssm_glu_w, ssm_glu_b, w_out, norm2_g,
              ffn_w_gate, ffn_w_up, ffn_w_down, moe_router, moe_w_gate, moe_w_up, moe_w_down):
    s = x.shape[1]
    pos = jnp.arange(s, dtype=jnp.int32)
    cuts = list(np.cumsum(IN_SPLITS)[:-1])
    h = x
    for layer in range(DEPTH):
        xn = rms_norm(h, norm1_g[layer])
        proj = xn @ w_in[layer]
        qa, ka, va, qr, kr, vr, gr, us = jnp.split(proj, cuts, axis=-1)
        ya = mixer_dilated(qa, ka, va, q_norm_g[layer], k_norm_g[layer], pos)
        yr = mixer_retention(qr, kr, vr, gr, ret_gn_g[layer], pos)
        yc = mixer_ssm(us, ssm_a_re[layer], ssm_a_im[layer], ssm_b_re[layer], ssm_b_im[layer],
                       ssm_c_re[layer], ssm_c_im[layer], ssm_d[layer], ssm_log_dt[layer],
                       ssm_glu_w[layer], ssm_glu_b[layer])
        mixed = jnp.concatenate([ya, yr, yc], axis=-1)
        h = h + mixed @ w_out[layer]
        xn2 = rms_norm(h, norm2_g[layer])
        if layer % 2 == 0:
            i = layer // 2
            h = h + swiglu(xn2, ffn_w_gate[i], ffn_w_up[i], ffn_w_down[i])
        else:
            i = layer // 2
            h = h + moe_swiglu(xn2, moe_router[i], moe_w_gate[i], moe_w_up[i], moe_w_down[i])
    return h
```

```cpp
#include <hip/hip_runtime.h>
#include <cstdio>
#include <cstdint>
namespace pg8 {
#define PG8_LAS __attribute__((address_space(3)))
typedef unsigned short bf16_t;
typedef short bf16x8 __attribute__((ext_vector_type(8)));
typedef float f32x4 __attribute__((ext_vector_type(4)));
typedef unsigned u32x4 __attribute__((ext_vector_type(4)));
typedef int i32x4 __attribute__((ext_vector_type(4)));
constexpr int BM = 256, BK = 64, HALF = 128, HTB = HALF * BK * 2  , STAGE_BYTES = 8 * HTB, NXCD = 8, WGM = 8;

__host__ __device__ __forceinline__ int lds_byte(int r, int c) { const int st = (r >> 4) * 2 + (c >> 5), rr = r & 15, cc = c & 31, ob = rr * 64 + cc * 2; return st * 1024 + (ob ^ (((ob >> 9) & 1) << 5)); }
__host__ __device__ __forceinline__ void stage_rc(int b, int& R, int& C) { const int st = b / 1024, sb = b % 1024, swz = sb ^ (((sb >> 9) & 1) << 5); R = (st >> 1) * 16 + swz / 64; C = (st & 1) * 32 + (swz % 64) / 2; }
__host__ __device__ __forceinline__ int perm32(int rho) { const int n = rho >> 4, i = rho & 15; return 8 * (i >> 2) + 4 * n + (i & 3); }

struct Unit { int pm, pn, pb, e, r0, cn, koff, aux; };
struct Gemm { const bf16_t* A; const bf16_t* Bt; int M, N, K, ld; };

struct StaticOrder {
    int nM, nN, nwg, G, c;
    __host__ __device__ void init(int M, int N, int G_, int c_) { nM = M / BM; nN = N / BM; nwg = nM * nN; G = G_; c = c_; }
    __host__ __device__ bool next(int i, Unit& u) const {
        const long L = (long)i * G + c; if (L >= nwg) return false;
        int wgid = (int)L; { const int q = nwg / NXCD, r = nwg % NXCD, xcd = wgid % NXCD, off = wgid / NXCD; wgid = (xcd < r ? xcd * (q + 1) : r * (q + 1) + (xcd - r) * q) + off; }
        const int nig = WGM * nN, gid = wgid / nig, fm = gid * WGM, gsz = (nM - fm) < WGM ? (nM - fm) : WGM;
        u.pm = fm + ((wgid % nig) % gsz); u.pn = (wgid % nig) / gsz; u.pb = u.pn; u.e = 0; u.r0 = 0; u.cn = 0; u.koff = 0; u.aux = 0; return true;
    }
    __device__ __forceinline__ void a_ready(const Unit&) const {}
    __device__ __forceinline__ void done(const Unit&) const {}
    __device__ __forceinline__ int arow(const Unit&, int) const { return 0; }
};

__device__ __forceinline__ unsigned cvt_pk_bf16(float lo, float hi) { unsigned r; asm volatile("v_cvt_pk_bf16_f32 %0, %1, %2" : "=v"(r) : "v"(lo), "v"(hi)); return r; }

#ifndef RELAX_WAITS
#define RELAX_WAITS 1
#endif
template <class Epi, class Sched, bool ALIGN_EPI = false, bool SP2 = false, bool GATHER = false, bool FP8 = false>
__device__ __forceinline__ void gemm_phase(PG8_LAS unsigned char* lds, const Gemm g, const Sched& S, const Epi& E, int tid) {
    asm volatile("" : "+v"(tid));
    const int wid = __builtin_amdgcn_readfirstlane(tid >> 6), lane = tid & 63, wr = wid >> 2, wc = wid & 3, fr = lane & 15, fq = lane >> 4;
    constexpr int ES = FP8 ? 1 : 2;
    const int K = g.ld, nt = (g.K * ES) / (BK * 2);
    unsigned voffA[2][2], voffN[2][2], voffB[2];
    const size_t kstep = (size_t)(BK * 2);
    const size_t hstep = (size_t)HALF * K * ES;
    const size_t tstep = 2 * hstep;
#pragma unroll
    for (int i = 0; i < 2; ++i) { int R, C; stage_rc(tid * 16 + i * 8192, R, C); const int Rb = Epi::PERM ? ((R & ~31) + perm32(R & 31)) : R;
        voffA[0][i] = (unsigned)(R * K * ES + C * 2); voffA[1][i] = voffA[0][i]; voffN[0][i] = voffA[0][i]; voffN[1][i] = voffA[0][i]; voffB[i] = (unsigned)(Rb * K * ES + C * 2); }
    const unsigned ldsw = (unsigned)wid * 1024u;
    const int aoff = lds_byte(wr * 64 + fr, fq * 8), boff = lds_byte(wc * 32 + fr, fq * 8);
#define PG8_SA(b, h) (((b) * 2 + (h)) * HTB)
#define PG8_SB(b, h) ((4 + (b) * 2 + (h)) * HTB)
#define PG8_STAGE(bufoff, gbase, voff) do { _Pragma("unroll") for (int _i = 0; _i < 2; ++_i) \
        __builtin_amdgcn_global_load_lds((const unsigned*)((const char*)(gbase) + (voff)[_i]), (PG8_LAS unsigned*)(lds + (bufoff) + ldsw + _i * 8192), 16, 0, 0); } while (0)
#define PG8_CAT8(x0, x1) __builtin_shufflevector(__builtin_bit_cast(i32x4, (x0)), __builtin_bit_cast(i32x4, (x1)), 0, 1, 2, 3, 4, 5, 6, 7)
#define PG8_STAGE_A(bufoff, gbase, h) do { if constexpr (GATHER) { PG8_STAGE(bufoff, gbase, voffA[h]); } else { PG8_STAGE(bufoff, (gbase) + (h) * hstep, voffA[0]); } } while (0)
#define PG8_LDA(dst, b, h) do { _Pragma("unroll") for (int m = 0; m < 4; ++m) { \
        if constexpr (FP8) { dst##8[m] = PG8_CAT8(*(const PG8_LAS bf16x8*)(lds + PG8_SA(b, h) + aoff + m * 2048), *(const PG8_LAS bf16x8*)(lds + PG8_SA(b, h) + aoff + m * 2048 + 1024)); } \
        else { _Pragma("unroll") for (int k = 0; k < 2; ++k) dst[m][k] = *(const PG8_LAS bf16x8*)(lds + PG8_SA(b, h) + aoff + m * 2048 + k * 1024); } } } while (0)
#define PG8_LDB(dst, b, h) do { _Pragma("unroll") for (int n = 0; n < 2; ++n) { \
        if constexpr (FP8) { dst##8[n] = PG8_CAT8(*(const PG8_LAS bf16x8*)(lds + PG8_SB(b, h) + boff + n * 2048), *(const PG8_LAS bf16x8*)(lds + PG8_SB(b, h) + boff + n * 2048 + 1024)); } \
        else { _Pragma("unroll") for (int k = 0; k < 2; ++k) dst[n][k] = *(const PG8_LAS bf16x8*)(lds + PG8_SB(b, h) + boff + n * 2048 + k * 1024); } } } while (0)
#define PG8_MMA(ai, bj, At, Bt) do { __builtin_amdgcn_s_setprio(1); \
        if constexpr (FP8) { _Pragma("unroll") for (int m = 0; m < 4; ++m) _Pragma("unroll") for (int n = 0; n < 2; ++n) \
            asm volatile("v_mfma_scale_f32_16x16x128_f8f6f4 %0, %1, %2, %0, %3, %3 op_sel_hi:[0,0,0]" : "+v"(acc[ai][bj][m][n]) : "v"(Bt##8[n]), "v"(At##8[m]), "v"(sc127)); } \
        else { _Pragma("unroll") for (int m = 0; m < 4; ++m) _Pragma("unroll") for (int n = 0; n < 2; ++n) _Pragma("unroll") for (int k = 0; k < 2; ++k) \
            acc[ai][bj][m][n] = __builtin_amdgcn_mfma_f32_16x16x32_bf16(Bt[n][k], At[m][k], acc[ai][bj][m][n], 0, 0, 0); } \
        __builtin_amdgcn_s_setprio(0); } while (0)
#define PG8_WAIT_V(n) asm volatile("s_waitcnt vmcnt(" #n ")" ::: "memory")
    constexpr int kRelax = (8 + Epi::NVM > 63) ? 63 : 8 + Epi::NVM;
#define PG8_WAIT_V8R(pe) asm volatile("v_readfirstlane_b32 vcc_lo, %0\n\ts_cmp_lg_u32 vcc_lo, 0\n\ts_cbranch_scc1 2\n\ts_waitcnt vmcnt(8)\n\ts_branch 1\n\ts_waitcnt vmcnt(%1)" :: "v"(pe), "n"(kRelax) : "memory", "scc", "vcc")
#define PG8_WAIT_L(n) asm volatile("s_waitcnt lgkmcnt(" #n ")" ::: "memory")
#define PG8_BAR __builtin_amdgcn_s_barrier()
#define PG8_SCHED __builtin_amdgcn_sched_barrier(0)
#define PG8_GOFF(vo, u) do { if constexpr (GATHER) { _Pragma("unroll") for (int _h = 0; _h < 2; ++_h) _Pragma("unroll") for (int _i = 0; _i < 2; ++_i) \
        { int _R, _C; stage_rc(tid * 16 + _i * 8192, _R, _C); vo[_h][_i] = (unsigned)S.arow((u), _h * HALF + _R) * (unsigned)(K * ES) + (unsigned)_C * 2u; } } } while (0)
    Unit cur, nxt; int ui = 0;
    if (!S.next(0, cur)) return;
    f32x4 acc[2][2][4][2];
#pragma unroll
    for (int a = 0; a < 2; ++a)
#pragma unroll
        for (int b = 0; b < 2; ++b)
#pragma unroll
            for (int m = 0; m < 4; ++m)
#pragma unroll
                for (int n = 0; n < 2; ++n) acc[a][b][m][n] = (f32x4){0.f, 0.f, 0.f, 0.f};
    bf16x8 At[4][2], B0[2][2], B1[2][2];
    typedef int i32x8 __attribute__((ext_vector_type(8))); i32x8 At8[4], B08[2], B18[2]; int sc127 = 127; asm volatile("" : "+v"(sc127));
    const char* cA = (const char*)g.A + (GATHER ? (size_t)0 : (size_t)cur.pm * tstep) + (size_t)cur.koff * ES; const char* cB = (const char*)g.Bt + (size_t)cur.pb * tstep + (size_t)cur.koff * ES;
    S.a_ready(cur);
    PG8_GOFF(voffA, cur);
    if constexpr (SP2) {
        PG8_STAGE(PG8_SB(0, 0), cB, voffB); PG8_STAGE(PG8_SB(0, 1), cB + hstep, voffB); PG8_STAGE_A(PG8_SA(0, 0), cA, 0); PG8_STAGE_A(PG8_SA(0, 1), cA, 1);
        if (wr == 1) PG8_BAR;
        PG8_WAIT_V(2); PG8_BAR;
        PG8_STAGE(PG8_SB(1, 0), cB + kstep, voffB); PG8_STAGE_A(PG8_SA(1, 0), cA + kstep, 0); PG8_STAGE(PG8_SB(1, 1), cB + hstep + kstep, voffB);
        PG8_WAIT_V(6); PG8_BAR;
    } else {
        PG8_STAGE(PG8_SB(0, 0), cB, voffB); PG8_STAGE_A(PG8_SA(0, 0), cA, 0); PG8_STAGE(PG8_SB(0, 1), cB + hstep, voffB); PG8_STAGE_A(PG8_SA(0, 1), cA, 1);
        if (wr == 1) PG8_BAR;
        PG8_WAIT_V(4); PG8_BAR;
        PG8_STAGE(PG8_SB(1, 0), cB + kstep, voffB); PG8_STAGE_A(PG8_SA(1, 0), cA + kstep, 0); PG8_STAGE(PG8_SB(1, 1), cB + hstep + kstep, voffB);
        PG8_WAIT_V(6); PG8_BAR;
    }
    for (;;) {
        const bool has_next = S.next(ui + 1, nxt);
        const char* nA = (has_next && !GATHER) ? (const char*)g.A + (size_t)nxt.pm * tstep + (size_t)nxt.koff * ES : cA; const char* nB = has_next ? (const char*)g.Bt + (size_t)nxt.pb * tstep + (size_t)nxt.koff * ES : cB;
        if constexpr (GATHER) { if (has_next) { PG8_GOFF(voffN, nxt); } else { _Pragma("unroll") for (int _h = 0; _h < 2; ++_h) _Pragma("unroll") for (int _i = 0; _i < 2; ++_i) voffN[_h][_i] = voffA[_h][_i]; } }
        for (int t = 0; t < nt; t += 2) {
            const bool last = (t == nt - 2);
            const char* a1 = cA + (size_t)(t + 1) * kstep;
            const char* a2 = last ? nA : cA + (size_t)(t + 2) * kstep; const char* b2 = last ? nB : cB + (size_t)(t + 2) * kstep;
            const char* a3 = a2 + kstep; const char* b3 = b2 + kstep;
            if (last && has_next) S.a_ready(nxt);
            if constexpr (SP2) {
            const int post_epi = (RELAX_WAITS && (t == 0) && (ui > 0)) ? 1 : 0;
            PG8_LDB(B0, 0, 0); PG8_LDB(B1, 0, 1); PG8_SCHED; PG8_LDA(At, 0, 0); PG8_STAGE_A(PG8_SA(1, 1), a1, 1);
            if constexpr (GATHER) { if (last) { _Pragma("unroll") for (int _h = 0; _h < 2; ++_h) _Pragma("unroll") for (int _i = 0; _i < 2; ++_i) voffA[_h][_i] = voffN[_h][_i]; } }
            PG8_WAIT_V8R(post_epi); PG8_WAIT_L(0); PG8_BAR; PG8_MMA(0, 0, At, B0); PG8_MMA(0, 1, At, B1); PG8_BAR; PG8_SCHED;
            PG8_LDA(At, 0, 1); PG8_STAGE(PG8_SB(0, 0), b2, voffB); PG8_STAGE(PG8_SB(0, 1), b2 + hstep, voffB); PG8_STAGE_A(PG8_SA(0, 0), a2, 0);
            PG8_WAIT_V8R(post_epi); PG8_WAIT_L(0); PG8_BAR; PG8_MMA(1, 0, At, B0); PG8_MMA(1, 1, At, B1); PG8_BAR; PG8_SCHED;
            PG8_LDB(B0, 1, 0); PG8_LDB(B1, 1, 1); PG8_SCHED; PG8_LDA(At, 1, 0); PG8_STAGE_A(PG8_SA(0, 1), a2, 1);
            PG8_WAIT_V(8); PG8_WAIT_L(0); PG8_BAR; PG8_MMA(0, 0, At, B0); PG8_MMA(0, 1, At, B1); PG8_BAR; PG8_SCHED;
            PG8_LDA(At, 1, 1); PG8_STAGE(PG8_SB(1, 0), b3, voffB); PG8_STAGE(PG8_SB(1, 1), b3 + hstep, voffB); PG8_STAGE_A(PG8_SA(1, 0), a3, 0);
            PG8_WAIT_V(8); PG8_WAIT_L(0); PG8_BAR; PG8_MMA(1, 0, At, B0); PG8_MMA(1, 1, At, B1); PG8_BAR; PG8_SCHED;
            } else {
            PG8_LDB(B0, 0, 0); PG8_SCHED; PG8_LDA(At, 0, 0); PG8_STAGE_A(PG8_SA(1, 1), a1, 1);
            if constexpr (GATHER) { if (last) { _Pragma("unroll") for (int _h = 0; _h < 2; ++_h) _Pragma("unroll") for (int _i = 0; _i < 2; ++_i) voffA[_h][_i] = voffN[_h][_i]; } }
            PG8_WAIT_L(8); PG8_BAR; PG8_WAIT_L(0); PG8_MMA(0, 0, At, B0); PG8_BAR; PG8_SCHED;
            PG8_LDB(B1, 0, 1); PG8_STAGE(PG8_SB(0, 0), b2, voffB);
            PG8_BAR; PG8_WAIT_L(0); PG8_MMA(0, 1, At, B1); PG8_BAR;
            PG8_LDA(At, 0, 1); PG8_STAGE_A(PG8_SA(0, 0), a2, 0);
            PG8_BAR; PG8_WAIT_L(0); PG8_MMA(1, 0, At, B0); PG8_BAR; PG8_SCHED;
            PG8_STAGE(PG8_SB(0, 1), b2 + hstep, voffB);
            PG8_WAIT_V(6); PG8_BAR; PG8_MMA(1, 1, At, B1); PG8_BAR;
            PG8_LDB(B0, 1, 0); PG8_SCHED; PG8_LDA(At, 1, 0); PG8_STAGE_A(PG8_SA(0, 1), a2, 1);
            PG8_WAIT_L(8); PG8_BAR; PG8_WAIT_L(0); PG8_MMA(0, 0, At, B0); PG8_BAR; PG8_SCHED;
            PG8_LDB(B1, 1, 1); PG8_STAGE(PG8_SB(1, 0), b3, voffB);
            PG8_BAR; PG8_WAIT_L(0); PG8_MMA(0, 1, At, B1); PG8_BAR;
            PG8_LDA(At, 1, 1); PG8_STAGE_A(PG8_SA(1, 0), a3, 0);
            PG8_BAR; PG8_WAIT_L(0); PG8_MMA(1, 0, At, B0); PG8_BAR; PG8_SCHED;
            PG8_STAGE(PG8_SB(1, 1), b3 + hstep, voffB);
            PG8_WAIT_V(6); PG8_BAR; PG8_MMA(1, 1, At, B1); PG8_BAR;
            }
        }
        if constexpr (FP8) asm volatile("s_nop 15\n\ts_nop 15" ::: "memory");
        if constexpr (ALIGN_EPI) { if (wr == 0) PG8_BAR; }
        E(acc, cur, wr, wc, fr, fq, ui); S.done(cur);
        if (!has_next) break;
#pragma unroll
        for (int a = 0; a < 2; ++a)
#pragma unroll
            for (int b = 0; b < 2; ++b)
#pragma unroll
                for (int m = 0; m < 4; ++m)
#pragma unroll
                    for (int n = 0; n < 2; ++n) acc[a][b][m][n] = (f32x4){0.f, 0.f, 0.f, 0.f};
        cur = nxt; cA = nA; cB = nB; ++ui;
        if constexpr (ALIGN_EPI) { if (wr == 1) PG8_BAR; }
    }
    PG8_WAIT_V(0);
    if constexpr (!ALIGN_EPI) { if (wr == 0) PG8_BAR; }
    PG8_BAR;
#undef PG8_SA
#undef PG8_SB
#undef PG8_STAGE
#undef PG8_STAGE_A
#undef PG8_LDA
#undef PG8_LDB
#undef PG8_MMA
#undef PG8_CAT8
#undef PG8_WAIT_V
#undef PG8_WAIT_V8R
#undef PG8_WAIT_L
#undef PG8_BAR
#undef PG8_SCHED
#undef PG8_GOFF
}
}
constexpr int BATCH = 2, SEQ = 16384, T = BATCH * SEQ, DM = 1024, NPROJ = 2560, DFF = 2816, NEXP = 8, DFE = 3584, DEPTH = 2;
constexpr int C_QA = 0, C_KA = 256, C_VA = 512, C_QR = 768, C_KR = 1024, C_VR = 1280, C_GR = 1792, C_US = 2304;
constexpr int NCHUNK = SEQ / 128;
constexpr int NWAVES = 8;
constexpr size_t MiB = 1u << 20;
constexpr size_t WS_CTL = 0, CTL_ZERO_BYTES = 1 * MiB;
constexpr size_t WS_TABA = 1 * MiB;
constexpr size_t WS_TABR = 2 * MiB;
constexpr size_t WS_SSM = 6 * MiB;
constexpr size_t SSM_LAYER_BYTES = 512 * 1024, SSM_ABAR = 0, SSM_ABARL = 8192, SSM_BMT = 16384, SSM_CMT = 81920, SSM_GLWT = 147456;
constexpr size_t WS_MAPS = 8 * MiB;
constexpr size_t WS_TOKINFO = 12 * MiB;
constexpr size_t WS_WIN = 8 * MiB;
constexpr size_t WS_WOUT = 18 * MiB;
constexpr size_t WS_FGU = 22 * MiB;
constexpr size_t WS_FDN = 33 * MiB;
constexpr size_t WS_XN = 40 * MiB;
constexpr size_t WS_PROJ = 104 * MiB;
constexpr size_t WS_ATTP = 264 * MiB;
constexpr size_t WS_LSE = 312 * MiB;
constexpr size_t WS_KV = 314 * MiB;
constexpr size_t WS_SST = 346 * MiB;
constexpr size_t WS_XN2 = 280 * MiB;
constexpr size_t WS_SSQ = 348 * MiB;
constexpr size_t WS_ACT = 104 * MiB;
constexpr size_t WS_MGU = 104 * MiB;
constexpr size_t WS_MDN = 216 * MiB;
constexpr size_t WS_MACT = 272 * MiB;
constexpr size_t WS_MACT2 = 391 * MiB;
constexpr size_t WS_END = 512 * MiB;
static_assert(WS_MACT + (size_t)135 * 256 * DFE <= WS_MACT2 && WS_MACT2 + (size_t)135 * 256 * DFE <= WS_END, "ws map");
constexpr int CW_BAR = 4096;
constexpr int CW_MOECNT = 16384;
constexpr int CW_PAIRCNT = 16384 + 64;
constexpr int SCR_BYTES = 155648;
constexpr int MISC_OFF = SCR_BYTES;
constexpr int LDS_BYTES = 159744;

#define GAS __attribute__((address_space(1)))
#define LAS __attribute__((address_space(3)))
typedef unsigned short bf16;
typedef unsigned v4u __attribute__((ext_vector_type(4)));
typedef unsigned v2u __attribute__((ext_vector_type(2)));
typedef float f32x4 __attribute__((ext_vector_type(4)));
typedef GAS unsigned gu32;
#define RLX_AGENT __ATOMIC_RELAXED, __HIP_MEMORY_SCOPE_AGENT
#define LDS_WAIT() asm volatile("s_waitcnt lgkmcnt(0)" ::: "memory")
#define VM_WAIT() asm volatile("s_waitcnt vmcnt(0)" ::: "memory")
#define DI __device__ __forceinline__
DI unsigned f2bf(float f) { unsigned u = __builtin_bit_cast(unsigned, f); return (u + 0x7fffu + ((u >> 16) & 1u)) >> 16; }
DI unsigned pk2(float lo, float hi) { return f2bf(lo) | (f2bf(hi) << 16); }
DI float bflo(unsigned w) { return __uint_as_float(w << 16); }
DI float bfhi(unsigned w) { return __uint_as_float(w & 0xffff0000u); }
DI float bf2f(bf16 h) { return __uint_as_float((unsigned)h << 16); }
DI float wave_sum(float v) {
#pragma unroll
    for (int o = 1; o < 64; o <<= 1) v += __shfl_xor(v, o);
    return v;
}
DI float sigmoidf_(float x) { return 1.f / (1.f + __expf(-x)); }
template <int CTRL> DI float dpp_f(float v) { return __builtin_bit_cast(float, __builtin_amdgcn_mov_dpp(__builtin_bit_cast(int, v), CTRL, 0xf, 0xf, true)); }
DI float qx1(float v) { return dpp_f<0xB1>(v); }
DI float qx2(float v) { return dpp_f<0x4E>(v); }
template <int P> DI float qbc(float v) { return dpp_f<P * 85>(v); }

#define XB_TMO      128
#define XB_XCNT(j)  (256  + 64 * (j))
#define XB_XSUB(j)  (1280 + 64 * (j))
#define XB_XGEN(j)  (2304 + 64 * (j))
#define XB_TOP      3328
#define XB_TOPGEN   3392
#define XCD_BAR_WORDS 3456
#define XB_SPIN_CAP (1u << 18)
DI unsigned xb_ld(unsigned* p)              { return __hip_atomic_load(p, __ATOMIC_RELAXED, __HIP_MEMORY_SCOPE_AGENT); }
DI unsigned xb_add(unsigned* p, unsigned v) { return __hip_atomic_fetch_add(p, v, __ATOMIC_RELAXED, __HIP_MEMORY_SCOPE_AGENT); }
DI unsigned xb_xcc_id() { return (unsigned)__builtin_amdgcn_s_getreg((3 << 11) | 20) & 0xFu; }
#define XB_SPIN(cond, bar) do { unsigned _sp = 0; while (cond) { __builtin_amdgcn_s_sleep(1); \
    if ((++_sp & 255u) == 0u) { if (xb_ld(&(bar)[XB_TMO])) break; if (_sp > XB_SPIN_CAP) { atomicAdd(&(bar)[XB_TMO], 1u); break; } } } } while (0)
struct XcdBarrier { unsigned* bar; unsigned x; volatile LAS unsigned* st; };
DI XcdBarrier xcd_barrier_post(unsigned* bar, volatile LAS unsigned* st, bool t0) {
    XcdBarrier b; b.bar = bar; b.x = xb_xcc_id(); b.st = st;
    if (t0) (void)xb_add(&bar[XB_XCNT(b.x)], 1u);
    return b;
}
DI void xcd_barrier_complete(unsigned* bar, unsigned x, unsigned& nloc, unsigned& nx) {
    const unsigned G = gridDim.x * gridDim.y * gridDim.z;
    unsigned sum, cnt, mine, sp = 0u;
    for (;;) {
        sum = 0u; cnt = 0u; mine = 0u;
#pragma unroll
        for (unsigned j = 0; j < 16; ++j) { const unsigned c = xb_ld(&bar[XB_XCNT(j)]); sum += c; cnt += (c > 0u) ? 1u : 0u; mine = (j == x) ? c : mine; }
        if (sum == G) break;
        __builtin_amdgcn_s_sleep(1);
        if ((++sp & 255u) == 0u) { if (xb_ld(&bar[XB_TMO])) break; if (sp > XB_SPIN_CAP) { atomicAdd(&bar[XB_TMO], 1u); break; } }
    }
    nloc = mine > 0u ? mine : 1u; nx = cnt > 0u ? cnt : 1u;
}
DI void xcd_barrier(const XcdBarrier& b, bool t0) {
    asm volatile("s_waitcnt vmcnt(0)" ::: "memory");
    __syncthreads();
    if (t0) {
        unsigned* bar = b.bar;
        __builtin_amdgcn_s_waitcnt(0);
        unsigned nloc = b.st[0], nx = b.st[1];
        if (nloc == 0u) { xcd_barrier_complete(bar, b.x, nloc, nx); b.st[0] = nloc; b.st[1] = nx; }
        const unsigned old = xb_add(&bar[XB_XSUB(b.x)], 1u);
        const unsigned gen = old / nloc;
        if (old + 1u == (gen + 1u) * nloc) {
            __builtin_amdgcn_fence(__ATOMIC_RELEASE, "agent");
            asm volatile("s_waitcnt vmcnt(0)" ::: "memory");
            const unsigned og = xb_add(&bar[XB_TOP], 1u);
            const unsigned tg = og / nx;
            if (og + 1u == (tg + 1u) * nx) xb_add(&bar[XB_TOPGEN], 1u);
            else XB_SPIN(xb_ld(&bar[XB_TOPGEN]) == tg, bar);
            __builtin_amdgcn_fence(__ATOMIC_ACQUIRE, "agent");
            xb_add(&bar[XB_XGEN(b.x)], 1u);
            asm volatile("s_waitcnt vmcnt(0)" ::: "memory");
        } else {
            XB_SPIN(xb_ld(&bar[XB_XGEN(b.x)]) == gen, bar);
            __builtin_amdgcn_fence(__ATOMIC_ACQUIRE, "agent");
            asm volatile("s_waitcnt vmcnt(0)" ::: "memory");
        }
    }
    __syncthreads();
}

namespace pg8 {
struct EpiBf16 {
    static constexpr bool PERM = true;
    static constexpr int NVM = 16;
    bf16_t* O; int ldc; const PG8_LAS float* rs;
    __device__ __forceinline__ void operator()(const f32x4 (&acc)[2][2][4][2], const Unit& u, int wr, int wc, int fr, int fq, int ui) const {
        const int row0 = u.pm * BM + wr * 64 + fr, col0 = u.pn * BM + wc * 32 + 8 * fq;
#pragma unroll
        for (int ai = 0; ai < 2; ++ai)
#pragma unroll
            for (int m = 0; m < 4; ++m) { bf16_t* rowp = O + (size_t)(row0 + ai * HALF + m * 16) * ldc + col0; const float sc = rs ? rs[ui * 256 + ai * HALF + wr * 64 + m * 16 + fr] : 1.0f;
#pragma unroll
                for (int bj = 0; bj < 2; ++bj) { const f32x4 v0 = acc[ai][bj][m][0] * sc, v1 = acc[ai][bj][m][1] * sc;
                    u32x4 w; w.x = cvt_pk_bf16(v0[0], v0[1]); w.y = cvt_pk_bf16(v0[2], v0[3]); w.z = cvt_pk_bf16(v1[0], v1[1]); w.w = cvt_pk_bf16(v1[2], v1[3]);
                    *(u32x4*)(rowp + bj * HALF) = w; } }
    }
};
__device__ __forceinline__ float silu_mul(float g, float u) { return g * __builtin_amdgcn_rcpf(1.f + __expf(-g)) * u; }
struct EpiSwiGLU {
    static constexpr bool PERM = true;
    static constexpr int NVM = 8;
    bf16_t* O; int ldc; const PG8_LAS float* rs;
    __device__ __forceinline__ void operator()(const f32x4 (&acc)[2][2][4][2], const Unit& u, int wr, int wc, int fr, int fq, int ui) const {
        const int row0 = u.pm * BM + wr * 64 + fr, col0 = u.pn * HALF + wc * 32 + 8 * fq;
#pragma unroll
        for (int ai = 0; ai < 2; ++ai)
#pragma unroll
            for (int m = 0; m < 4; ++m) { bf16_t* rowp = O + (size_t)(row0 + ai * HALF + m * 16) * ldc + col0;
                const float sc = rs ? rs[ui * 256 + ai * HALF + wr * 64 + m * 16 + fr] : 1.0f;
                const f32x4 g0 = acc[ai][0][m][0] * sc, g1 = acc[ai][0][m][1] * sc, u0 = acc[ai][1][m][0] * sc, u1 = acc[ai][1][m][1] * sc;
                u32x4 w; w.x = cvt_pk_bf16(silu_mul(g0[0], u0[0]), silu_mul(g0[1], u0[1])); w.y = cvt_pk_bf16(silu_mul(g0[2], u0[2]), silu_mul(g0[3], u0[3]));
                w.z = cvt_pk_bf16(silu_mul(g1[0], u1[0]), silu_mul(g1[1], u1[1])); w.w = cvt_pk_bf16(silu_mul(g1[2], u1[2]), silu_mul(g1[3], u1[3]));
                *(u32x4*)rowp = w; }
    }
};
__device__ __forceinline__ float clamp_fp8(float x) { return __builtin_amdgcn_fmed3f(x, -448.0f, 448.0f); }
__device__ __forceinline__ unsigned pk4_fp8(float a, float b, float c, float d) { a = clamp_fp8(a); b = clamp_fp8(b); c = clamp_fp8(c); d = clamp_fp8(d); int w = 0; w = __builtin_amdgcn_cvt_pk_fp8_f32(a, b, w, false); w = __builtin_amdgcn_cvt_pk_fp8_f32(c, d, w, true); return (unsigned)w; }
struct EpiSwiGLU8 {
    static constexpr bool PERM = true;
    static constexpr int NVM = 8;
    unsigned char* O; int ldc; float gs, os;
    __device__ __forceinline__ void operator()(const f32x4 (&acc)[2][2][4][2], const Unit& u, int wr, int wc, int fr, int fq, int ui) const {
        const int row0 = u.pm * BM + wr * 64 + fr, col0 = u.pn * HALF + wc * 32 + 8 * fq;
#pragma unroll
        for (int ai = 0; ai < 2; ++ai)
#pragma unroll
            for (int m = 0; m < 4; ++m) { unsigned char* rowp = O + (size_t)(row0 + ai * HALF + m * 16) * ldc + col0;
                const f32x4 g0 = acc[ai][0][m][0] * gs, g1 = acc[ai][0][m][1] * gs, u0 = acc[ai][1][m][0] * (gs * os), u1 = acc[ai][1][m][1] * (gs * os);
                typedef unsigned u32x2 __attribute__((ext_vector_type(2))); u32x2 w;
                w.x = pk4_fp8(silu_mul(g0[0], u0[0]), silu_mul(g0[1], u0[1]), silu_mul(g0[2], u0[2]), silu_mul(g0[3], u0[3]));
                w.y = pk4_fp8(silu_mul(g1[0], u1[0]), silu_mul(g1[1], u1[1]), silu_mul(g1[2], u1[2]), silu_mul(g1[3], u1[3]));
                *(u32x2*)rowp = w; }
    }
};
struct EpiResF32 {
    static constexpr bool PERM = false;
    static constexpr int NVM = 63;
    const float* res; float* out; int ldc; float sc; bf16_t* xr; const float* gain; float* ssq;
    __device__ __forceinline__ void operator()(const f32x4 (&acc)[2][2][4][2], const Unit& u, int wr, int wc, int fr, int fq, int ui) const {
        const int row0 = u.pm * BM + wr * 64 + fr, col0 = u.pn * BM + wc * 32 + 4 * fq;
        f32x4 gv[2][2];
        if (xr) {
#pragma unroll
            for (int bj = 0; bj < 2; ++bj)
#pragma unroll
                for (int n = 0; n < 2; ++n) gv[bj][n] = *(const f32x4*)(gain + col0 + bj * HALF + n * 16); }
#pragma unroll
        for (int ai = 0; ai < 2; ++ai) {
            f32x4 r[4][2][2];
#pragma unroll
            for (int m = 0; m < 4; ++m) { const size_t off = (size_t)(row0 + ai * HALF + m * 16) * ldc + col0;
#pragma unroll
                for (int bj = 0; bj < 2; ++bj)
#pragma unroll
                    for (int n = 0; n < 2; ++n) r[m][bj][n] = *(const f32x4*)(res + off + bj * HALF + n * 16); }
#pragma unroll
            for (int m = 0; m < 4; ++m) { const int row = row0 + ai * HALF + m * 16; const size_t off = (size_t)row * ldc + col0; float s = 0.f;
#pragma unroll
                for (int bj = 0; bj < 2; ++bj)
#pragma unroll
                    for (int n = 0; n < 2; ++n) { const f32x4 o = r[m][bj][n] + acc[ai][bj][m][n] * sc; *(f32x4*)(out + off + bj * HALF + n * 16) = o;
                        if (xr) { s += (o[0] * o[0] + o[1] * o[1]) + (o[2] * o[2] + o[3] * o[3]); const f32x4 y = o * gv[bj][n];
                            unsigned w0 = cvt_pk_bf16(y[0], y[1]), w1 = cvt_pk_bf16(y[2], y[3]); typedef unsigned u32x2 __attribute__((ext_vector_type(2))); *(u32x2*)(xr + off + bj * HALF + n * 16) = (u32x2){w0, w1}; } }
                if (xr) { s += __shfl_xor(s, 16); s += __shfl_xor(s, 32); if (fq == 0) ssq[(size_t)row * 16 + u.pn * 4 + wc] = s; } }
        }
    }
};
#ifndef MDN_ROWS
#define MDN_ROWS 4
#endif
struct EpiMoeDown {
    static constexpr bool PERM = false;
    static constexpr int NVM = 48;
    float* out; int ldc; const int* tok; const float* gate; float sc;
    __device__ __forceinline__ void operator()(const f32x4 (&acc)[2][2][4][2], const Unit& u, int wr, int wc, int fr, int fq, int ui) const {
        const int col0 = u.pn * BM + wc * 32 + 4 * fq;
        int tk[2][4]; float gt[2][4];
#pragma unroll
        for (int ai = 0; ai < 2; ++ai)
#pragma unroll
            for (int m = 0; m < 4; ++m) { const int slot = u.r0 + ai * HALF + wr * 64 + m * 16 + fr, sl = slot < 32767 ? slot : 32767;
                tk[ai][m] = tok[u.e * 32768 + sl]; gt[ai][m] = gate[u.e * 32768 + sl]; }
#pragma unroll
        for (int ai = 0; ai < 2; ++ai)
#pragma unroll
            for (int m = 0; m < 4; ++m) { const bool ok = (u.r0 + ai * HALF + wr * 64 + m * 16 + fr) < u.cn; tk[ai][m] = ok ? tk[ai][m] : -1; gt[ai][m] = ok ? gt[ai][m] * sc : 0.f; }
#pragma unroll
        for (int ai = 0; ai < 2; ++ai)
#pragma unroll
            for (int mh = 0; mh < 4 / MDN_ROWS; ++mh) {
                f32x4 r[MDN_ROWS][2][2];
#pragma unroll
                for (int mm = 0; mm < MDN_ROWS; ++mm) { const int m = MDN_ROWS * mh + mm; const float* rowp = out + (size_t)(tk[ai][m] < 0 ? 0 : tk[ai][m]) * ldc + col0;
#pragma unroll
                    for (int bj = 0; bj < 2; ++bj)
#pragma unroll
                        for (int n = 0; n < 2; ++n) r[mm][bj][n] = *(const f32x4*)(rowp + bj * HALF + n * 16); }
#pragma unroll
                for (int mm = 0; mm < MDN_ROWS; ++mm) { const int m = MDN_ROWS * mh + mm; if (tk[ai][m] >= 0) { float* rowp = out + (size_t)tk[ai][m] * ldc + col0;
#pragma unroll
                    for (int bj = 0; bj < 2; ++bj)
#pragma unroll
                        for (int n = 0; n < 2; ++n) *(f32x4*)(rowp + bj * HALF + n * 16) = r[mm][bj][n] + acc[ai][bj][m][n] * gt[ai][m]; } }
            }
    }
};
struct EpiMoeDownA {
    static constexpr bool PERM = false;
    static constexpr int NVM = 0;
    float* out; int ldc; const int* tok; const float* gate; float sc;
    __device__ __forceinline__ void operator()(const f32x4 (&acc)[2][2][4][2], const Unit& u, int wr, int wc, int fr, int fq, int ui) const {
        const int col0 = u.pn * BM + wc * 32 + 4 * fq;
        int tk[2][4]; float gt[2][4];
#pragma unroll
        for (int ai = 0; ai < 2; ++ai)
#pragma unroll
            for (int m = 0; m < 4; ++m) { const int slot = u.r0 + ai * HALF + wr * 64 + m * 16 + fr, sl = slot < 32767 ? slot : 32767;
                tk[ai][m] = tok[u.e * 32768 + sl]; gt[ai][m] = gate[u.e * 32768 + sl]; }
#pragma unroll
        for (int ai = 0; ai < 2; ++ai)
#pragma unroll
            for (int m = 0; m < 4; ++m) { const bool ok = (u.r0 + ai * HALF + wr * 64 + m * 16 + fr) < u.cn;
                if (ok) { typedef __attribute__((address_space(1))) float gfloat; gfloat* rowp = (gfloat*)(out + (size_t)tk[ai][m] * ldc + col0); const float g_ = gt[ai][m] * sc;
#pragma unroll
                    for (int bj = 0; bj < 2; ++bj)
#pragma unroll
                        for (int n = 0; n < 2; ++n)
#pragma unroll
                            for (int j = 0; j < 4; ++j) __builtin_amdgcn_global_atomic_fadd_f32(rowp + bj * HALF + n * 16 + j, acc[ai][bj][m][n][j] * g_); } }
    }
};
#define MO_T(c) (((c) + 255) >> 8)
struct MoeOrder : StaticOrder {
    int c0, c1, c2, c3, c4, c5, c6, c7; const int* tok; int nNl; const PG8_LAS int* ltab;
    __device__ __forceinline__ void init_moe(const unsigned* cnt, const int* tok_, int N, int G_, int c_, int tile_cap = 1 << 20) {
        tok = tok_; ltab = nullptr;
#define MO_LD(e) (int)__hip_atomic_load(cnt + e, __ATOMIC_RELAXED, __HIP_MEMORY_SCOPE_AGENT)
        c0 = MO_LD(0); c1 = MO_LD(1); c2 = MO_LD(2); c3 = MO_LD(3); c4 = MO_LD(4); c5 = MO_LD(5); c6 = MO_LD(6); c7 = MO_LD(7);
#undef MO_LD
        nNl = N / BM; const int nt_ = tiles(); init((nt_ < tile_cap ? nt_ : tile_cap) * BM, N, G_, c_);
    }
    __device__ __forceinline__ void decode(Unit& u) const {
        int e = 0, tb = 0, c = c0, acc = MO_T(c0);
#define MO_STEP(k, ck) if (u.pm >= acc) { e = k; tb = acc; c = ck; } acc += MO_T(ck);
        MO_STEP(1, c1) MO_STEP(2, c2) MO_STEP(3, c3) MO_STEP(4, c4) MO_STEP(5, c5) MO_STEP(6, c6) MO_STEP(7, c7)
#undef MO_STEP
        u.e = e; u.r0 = (u.pm - tb) * BM; u.cn = c; u.pb = e * nNl + u.pn;
    }
    __device__ __forceinline__ int tiles() const { return MO_T(c0) + MO_T(c1) + MO_T(c2) + MO_T(c3) + MO_T(c4) + MO_T(c5) + MO_T(c6) + MO_T(c7); }
    __device__ __forceinline__ bool next(int i, Unit& u) const {
        if (!StaticOrder::next(i, u)) return false;
        decode(u); u.aux = i; return true;
    }
    __device__ __forceinline__ int arow(const Unit& u, int R) const { if (ltab) return ltab[u.aux * 256 + R]; const int slot = u.r0 + R; return slot < u.cn ? tok[u.e * 32768 + slot] : 0; }
    __device__ __forceinline__ void build_ltab(PG8_LAS int* tab, int tid) { Unit u; for (int i = 0; next(i, u); ++i) if (tid < 256) { const int slot = u.r0 + tid; tab[i * 256 + tid] = slot < u.cn ? tok[u.e * 32768 + slot] : 0; }
        __syncthreads(); ltab = tab; }
};
#undef MO_T
struct MoeTailOrder {
    const MoeOrder* mo; int G, c, ntail, KS, kslice;
    __device__ __forceinline__ void init(const MoeOrder* mo_, int G_, int c_, int KS_, int kslice_, int max_tail) { mo = mo_; G = G_; c = c_; KS = KS_; kslice = kslice_; const int t = (mo_->tiles() - 128) * mo_->nNl; ntail = t < 0 ? 0 : (t > max_tail ? max_tail : t); }
    __device__ __forceinline__ bool next(int i, Unit& u) const {
        const int s = i * G + c; if (s >= ntail * KS) return false;
        const int t = s / KS, ks = s - t * KS; u.pm = 128 + t / mo->nNl; u.pn = t % mo->nNl; mo->decode(u); u.koff = ks * kslice; u.aux = s; return true;
    }
    __device__ __forceinline__ void a_ready(const Unit&) const {}
    __device__ __forceinline__ void done(const Unit&) const {}
    __device__ __forceinline__ int arow(const Unit&, int) const { return 0; }
};
struct EpiPart {
    static constexpr bool PERM = false;
    static constexpr int NVM = 32;
    float* part;
    __device__ __forceinline__ void operator()(const f32x4 (&acc)[2][2][4][2], const Unit& u, int wr, int wc, int fr, int fq, int ui) const {
        float* base = part + (size_t)u.aux * 65536 + (size_t)(wr * 64 + fr) * 256 + wc * 32 + 4 * fq;
#pragma unroll
        for (int ai = 0; ai < 2; ++ai)
#pragma unroll
            for (int m = 0; m < 4; ++m)
#pragma unroll
                for (int bj = 0; bj < 2; ++bj)
#pragma unroll
                    for (int n = 0; n < 2; ++n) *(f32x4*)(base + (size_t)(ai * HALF + m * 16) * 256 + bj * HALF + n * 16) = acc[ai][bj][m][n];
    }
};
}
#include <cmath>
struct Args { const float* in[25]; float* out; unsigned char* ws; int ph_lo, ph_hi; };
struct KArgs {
    typedef const __attribute__((address_space(4))) char* kptr;
    DI kptr base() const { kptr p = (kptr)__builtin_amdgcn_kernarg_segment_ptr(); asm volatile("" : "+s"(p)); return p; }
    DI const float* in(int i) const { return *(const float* const __attribute__((address_space(4)))*)(base() + 8 * i); }
    DI float* out() const { return *(float* const __attribute__((address_space(4)))*)(base() + 200); }
    DI unsigned char* ws() const { return *(unsigned char* const __attribute__((address_space(4)))*)(base() + 208); }
    DI int ph_lo() const { return *(const int __attribute__((address_space(4)))*)(base() + 216); }
    DI int ph_hi() const { return *(const int __attribute__((address_space(4)))*)(base() + 220); }
};
static_assert(sizeof(Args) == 224, "Args layout");
enum { I_X = 0, I_N1G, I_WIN, I_QNG, I_KNG, I_GNG, I_ARE, I_AIM, I_BRE, I_BIM, I_CRE, I_CIM, I_SD, I_LDT, I_GLW, I_GLB, I_WOUT, I_N2G, I_FG, I_FU, I_FD, I_RT, I_MG, I_MU, I_MD };

DI void transpose_item(const float* W, int ldw, bf16* WT, int ldo, int k0, int n0, int drow0, float* scr, int lane) {
    float v[32];
    const float* src = W + (size_t)(k0 + (lane >> 5)) * ldw + n0 + (lane & 31);
#pragma unroll
    for (int i = 0; i < 32; ++i) v[i] = src[(size_t)(2 * i) * ldw];
#pragma unroll
    for (int i = 0; i < 32; ++i) scr[(2 * i + (lane >> 5)) * 33 + (lane & 31)] = v[i];
    LDS_WAIT(); asm volatile("" ::: "memory");
    const int c = lane & 7;
#pragma unroll
    for (int j = 0; j < 4; ++j) { const int n = (lane >> 3) + 8 * j; const float* s = scr + (8 * c) * 33 + n;
        v4u o; o.x = pk2(s[0 * 33], s[1 * 33]); o.y = pk2(s[2 * 33], s[3 * 33]); o.z = pk2(s[4 * 33], s[5 * 33]); o.w = pk2(s[6 * 33], s[7 * 33]);
        *(v4u*)(WT + (size_t)(drow0 + n) * ldo + k0 + 8 * c) = o; }
    LDS_WAIT(); asm volatile("" ::: "memory");
}
DI void rms_row(const float* xrow, const float* g, bf16* orow, int lane, f32x4 (&v)[4]) {
    const f32x4* xr = (const f32x4*)xrow + lane; float s = 0.f;
#pragma unroll
    for (int j = 0; j < 4; ++j) { v[j] = xr[64 * j]; s += (v[j].x * v[j].x + v[j].y * v[j].y) + (v[j].z * v[j].z + v[j].w * v[j].w); }
    const float rs = rsqrtf(wave_sum(s) * (1.f / DM) + 1e-6f);
    v2u* o8 = (v2u*)orow + lane;
#pragma unroll
    for (int j = 0; j < 4; ++j) { const f32x4 gg = ((const f32x4*)g)[lane + 64 * j]; v[j] = v[j] * rs * gg; v2u w; w.x = pk2(v[j].x, v[j].y); w.y = pk2(v[j].z, v[j].w); o8[64 * j] = w; }
}
DI void transpose_item8(const float* W, int ldw, unsigned char* WT, int ldo, int k0, int n0, int drow0, float scale, float* scr, int lane) {
    float v[32];
    const float* src = W + (size_t)(k0 + (lane >> 5)) * ldw + n0 + (lane & 31);
#pragma unroll
    for (int i = 0; i < 32; ++i) v[i] = src[(size_t)(2 * i) * ldw];
#pragma unroll
    for (int i = 0; i < 32; ++i) scr[(2 * i + (lane >> 5)) * 33 + (lane & 31)] = v[i] * scale;
    LDS_WAIT(); asm volatile("" ::: "memory");
    const int n = lane >> 1, hf = lane & 1; const float* s = scr + (32 * hf) * 33 + n;
    v4u o0, o1;
    o0.x = pg8::pk4_fp8(s[0 * 33], s[1 * 33], s[2 * 33], s[3 * 33]); o0.y = pg8::pk4_fp8(s[4 * 33], s[5 * 33], s[6 * 33], s[7 * 33]); o0.z = pg8::pk4_fp8(s[8 * 33], s[9 * 33], s[10 * 33], s[11 * 33]); o0.w = pg8::pk4_fp8(s[12 * 33], s[13 * 33], s[14 * 33], s[15 * 33]);
    o1.x = pg8::pk4_fp8(s[16 * 33], s[17 * 33], s[18 * 33], s[19 * 33]); o1.y = pg8::pk4_fp8(s[20 * 33], s[21 * 33], s[22 * 33], s[23 * 33]); o1.z = pg8::pk4_fp8(s[24 * 33], s[25 * 33], s[26 * 33], s[27 * 33]); o1.w = pg8::pk4_fp8(s[28 * 33], s[29 * 33], s[30 * 33], s[31 * 33]);
    unsigned char* dp = WT + (size_t)(drow0 + n) * ldo + k0 + 32 * hf;
    *(v4u*)dp = o0; *(v4u*)(dp + 16) = o1;
    LDS_WAIT(); asm volatile("" ::: "memory");
}
struct T8Item { const float* W; unsigned char* WT; int ldw, ldo, k0, n0, drow0; float scale; };
DI void t8_load(float (&v)[32], const T8Item& d, int lane) {
    const float* src = d.W + (size_t)(d.k0 + (lane >> 5)) * d.ldw + d.n0 + (lane & 31);
#pragma unroll
    for (int i = 0; i < 32; ++i) v[i] = src[(size_t)(2 * i) * d.ldw];
}
DI void t8_store(const float (&v)[32], const T8Item& d, float* scr, int lane) {
#pragma unroll
    for (int i = 0; i < 32; ++i) scr[(2 * i + (lane >> 5)) * 33 + (lane & 31)] = v[i] * d.scale;
    LDS_WAIT(); asm volatile("" ::: "memory");
    const int n = lane >> 1, hf = lane & 1; const float* s = scr + (32 * hf) * 33 + n;
    v4u o0, o1;
    o0.x = pg8::pk4_fp8(s[0 * 33], s[1 * 33], s[2 * 33], s[3 * 33]); o0.y = pg8::pk4_fp8(s[4 * 33], s[5 * 33], s[6 * 33], s[7 * 33]); o0.z = pg8::pk4_fp8(s[8 * 33], s[9 * 33], s[10 * 33], s[11 * 33]); o0.w = pg8::pk4_fp8(s[12 * 33], s[13 * 33], s[14 * 33], s[15 * 33]);
    o1.x = pg8::pk4_fp8(s[16 * 33], s[17 * 33], s[18 * 33], s[19 * 33]); o1.y = pg8::pk4_fp8(s[20 * 33], s[21 * 33], s[22 * 33], s[23 * 33]); o1.z = pg8::pk4_fp8(s[24 * 33], s[25 * 33], s[26 * 33], s[27 * 33]); o1.w = pg8::pk4_fp8(s[28 * 33], s[29 * 33], s[30 * 33], s[31 * 33]);
    unsigned char* dp = d.WT + (size_t)(d.drow0 + n) * d.ldo + d.k0 + 32 * hf;
    *(v4u*)dp = o0; *(v4u*)(dp + 16) = o1;
    LDS_WAIT(); asm volatile("" ::: "memory");
}
DI void rms_rows_phase(const float* x, const float* g, bf16* out, int gw, int NGW, int lane) {
    f32x4 gg[4];
#pragma unroll
    for (int j = 0; j < 4; ++j) gg[j] = ((const f32x4*)g)[lane + 64 * j];
    for (int m0 = gw; m0 < T; m0 += 4 * NGW) {
        f32x4 v[4][4];
#pragma unroll
        for (int r = 0; r < 4; ++r) { const int m = m0 + r * NGW; if (m < T) {
#pragma unroll
            for (int j = 0; j < 4; ++j) v[r][j] = ((const f32x4*)(x + (size_t)m * DM))[lane + 64 * j]; } }
#pragma unroll
        for (int r = 0; r < 4; ++r) { const int m = m0 + r * NGW; if (m < T) { float s = 0.f;
#pragma unroll
            for (int j = 0; j < 4; ++j) s += (v[r][j].x * v[r][j].x + v[r][j].y * v[r][j].y) + (v[r][j].z * v[r][j].z + v[r][j].w * v[r][j].w);
            const float rs = rsqrtf(wave_sum(s) * (1.f / DM) + 1e-6f); v2u* o8 = (v2u*)(out + (size_t)m * DM) + lane;
#pragma unroll
            for (int j = 0; j < 4; ++j) { const f32x4 y = v[r][j] * rs * gg[j]; v2u w; w.x = pk2(y.x, y.y); w.y = pk2(y.z, y.w); o8[64 * j] = w; } } }
    }
}
DI void unpack8(const v4u w, float (&x)[8]) { x[0] = bflo(w.x); x[1] = bfhi(w.x); x[2] = bflo(w.y); x[3] = bfhi(w.y); x[4] = bflo(w.z); x[5] = bfhi(w.z); x[6] = bflo(w.w); x[7] = bfhi(w.w); }
DI v4u pack8(const float (&x)[8]) { v4u w; w.x = pk2(x[0], x[1]); w.y = pk2(x[2], x[3]); w.z = pk2(x[4], x[5]); w.w = pk2(x[6], x[7]); return w; }

template <class Sched> DI void build_rs(LAS float* RS, const Sched& S, const float* ssq, int tid) {
    pg8::Unit u;
    for (int i = 0; S.next(i, u); ++i) if (tid < 256) { const f32x4* p = (const f32x4*)(ssq + ((size_t)u.pm * 256 + tid) * 16); const f32x4 a0 = p[0], a1 = p[1], a2 = p[2], a3 = p[3];
        const float s = ((a0.x + a0.y) + (a0.z + a0.w)) + ((a1.x + a1.y) + (a1.z + a1.w)) + ((a2.x + a2.y) + (a2.z + a2.w)) + ((a3.x + a3.y) + (a3.z + a3.w));
        RS[i * 256 + tid] = rsqrtf(s * (1.f / DM) + 1e-6f); }
    __syncthreads();
}
DI void phase_prologue(const KArgs& a, char* lds, int gw, int NGW, int wave, int lane) {
    unsigned char* ws = a.ws();
    float* scr = (float*)(lds + wave * 16384);
    constexpr int I_IN = 16 * 80, I_OUT = 16 * 32, I_G = 16 * 88, I_D = 44 * 32;
    constexpr int NIT = 2 * I_IN + 2 * I_OUT + 2 * I_G + I_D;
    for (int it = gw; it < NIT; it += NGW) {
        int r = it;
        if (r < 2 * I_IN) { const int l = r / I_IN; r -= l * I_IN; const int kb = r / 80, nb = r % 80;
            transpose_item(a.in(I_WIN) + (size_t)l * DM * NPROJ, NPROJ, (bf16*)(ws + WS_WIN) + (size_t)l * NPROJ * DM, DM, 64 * kb, 32 * nb, 32 * nb, scr, lane); continue; }
        r -= 2 * I_IN;
        if (r < 2 * I_OUT) { const int l = r / I_OUT; r -= l * I_OUT; const int kb = r / 32, nb = r % 32;
            transpose_item(a.in(I_WOUT) + (size_t)l * DM * DM, DM, (bf16*)(ws + WS_WOUT) + (size_t)l * DM * DM, DM, 64 * kb, 32 * nb, 32 * nb, scr, lane); continue; }
        r -= 2 * I_OUT;
        if (r < 2 * I_G) { const int up = r / I_G; r -= up * I_G; const int kb = r / 88, nb = r % 88, n0 = 32 * nb;
            transpose_item(a.in(up ? I_FU : I_FG), DFF, (bf16*)(ws + WS_FGU), DM, 64 * kb, n0, (n0 >> 7) * 256 + (n0 & 127) + up * 128, scr, lane); continue; }
        r -= 2 * I_G;
        { const int kb = r / 32, nb = r % 32; transpose_item(a.in(I_FD), DM, (bf16*)(ws + WS_FDN), DFF, 64 * kb, 32 * nb, 32 * nb, scr, lane); }
    }
    const int gt = gw * 64 + lane, NGT = NGW * 64;
    float* tabA = (float*)(ws + WS_TABA); float* tabR = (float*)(ws + WS_TABR);
    for (int i = gt; i < SEQ * 8; i += NGT) { const int pos = i >> 3, k = i & 7; const float inv = powf(500000.0f, -(float)k * 2.0f / 16.0f); const double ang = (double)((float)pos * inv);
        tabA[2 * i] = (float)cos(ang); tabA[2 * i + 1] = (float)sin(ang); }
    for (int i = gt; i < SEQ * 32; i += NGT) { const int pos = i >> 5, k = i & 31; const float inv = powf(10000.0f, -(float)k * 2.0f / 64.0f); const double ang = (double)((float)pos * inv);
        tabR[2 * i] = (float)cos(ang); tabR[2 * i + 1] = (float)sin(ang); }
    for (int i = gt; i < DEPTH * 16 * 64; i += NGT) { const int l = i >> 10, gp = i & 1023, gI = gp >> 6;
        float* base = (float*)(ws + WS_SSM + (size_t)l * SSM_LAYER_BYTES);
        const float dt = expf(a.in(I_LDT)[l * 16 + gI]), lr = a.in(I_ARE)[i], li = a.in(I_AIM)[i];
        const float mag = expf(lr * dt), ang = li * dt; const float ar = mag * cosf(ang), ai = mag * sinf(ang);
        const float den = lr * lr + li * li, nr = ar - 1.0f, ni = ai; const float fre = (nr * lr + ni * li) / den, fim = (ni * lr - nr * li) / den;
        bf16* bmt = (bf16*)((char*)base + SSM_BMT) + ((size_t)gI * 128 + (gp & 63)) * 16;
        for (int c = 0; c < 16; ++c) { const float br = a.in(I_BRE)[(size_t)i * 16 + c], bi = a.in(I_BIM)[(size_t)i * 16 + c]; bmt[c] = (bf16)f2bf(fre * br - fim * bi); bmt[64 * 16 + c] = (bf16)f2bf(fre * bi + fim * br); }
        bf16* cmt = (bf16*)((char*)base + SSM_CMT) + (size_t)gI * 16 * 128 + 2 * (gp & 63);
        for (int c = 0; c < 16; ++c) { cmt[c * 128] = (bf16)f2bf(a.in(I_CRE)[((size_t)(l * 16 + gI) * 16 + c) * 64 + (gp & 63)]); cmt[c * 128 + 1] = (bf16)f2bf(-a.in(I_CIM)[((size_t)(l * 16 + gI) * 16 + c) * 64 + (gp & 63)]); }
        base[SSM_ABAR / 4 + 2 * gp] = ar; base[SSM_ABAR / 4 + 2 * gp + 1] = ai;
        float pr = ar, pi = ai;
        for (int k = 0; k < 7; ++k) { const float t0 = pr * pr - pi * pi, t1 = 2.0f * pr * pi; pr = t0; pi = t1; }
        base[SSM_ABARL / 4 + 2 * gp] = pr; base[SSM_ABARL / 4 + 2 * gp + 1] = pi; }
    for (int i = gt; i < DEPTH * 65536; i += NGT) { const int l = i >> 16, n = (i >> 8) & 255, k = i & 255;
        ((bf16*)(ws + WS_SSM + (size_t)l * SSM_LAYER_BYTES + SSM_GLWT))[n * 256 + k] = (bf16)f2bf(a.in(I_GLW)[(size_t)l * 65536 + k * 256 + n]); }
    rms_rows_phase(a.in(I_X), a.in(I_N1G), (bf16*)(ws + WS_XN), gw, NGW, lane);
}

DI void prep_phase(bf16* proj, const float* qg, const float* kg, const float* tabA, int gw, int NGW, int lane) {
    const int vec = lane >> 3, sub = lane & 7;
    const int coff = (vec < 4 ? C_QA + vec * 64 : C_KA + (vec - 4) * 64) + sub * 8;
    float g[8];
    { const f32x4* gp = (const f32x4*)((vec < 4 ? qg : kg) + sub * 8); const f32x4 g0 = gp[0], g1 = gp[1]; g[0] = g0.x; g[1] = g0.y; g[2] = g0.z; g[3] = g0.w; g[4] = g1.x; g[5] = g1.y; g[6] = g1.z; g[7] = g1.w; }
    const float qs = vec < 4 ? 0.125f * 1.4426950408889634f : 1.0f;
    for (int t0 = gw; t0 < T; t0 += 4 * NGW) {
        v4u raw[4]; f32x4 cs[4][4];
#pragma unroll
        for (int r = 0; r < 4; ++r) { const int t = t0 + r * NGW; if (t < T) { raw[r] = *(const v4u*)(proj + (size_t)t * NPROJ + coff); const f32x4* cp = (const f32x4*)(tabA + (size_t)(t & (SEQ - 1)) * 16);
#pragma unroll
            for (int c = 0; c < 4; ++c) cs[r][c] = cp[c]; } }
#pragma unroll
        for (int r = 0; r < 4; ++r) { const int t = t0 + r * NGW; if (t < T) {
            float x[8]; unpack8(raw[r], x);
            float ss = 0.f;
#pragma unroll
            for (int e = 0; e < 8; ++e) ss += x[e] * x[e];
            ss += __shfl_xor(ss, 1); ss += __shfl_xor(ss, 2); ss += __shfl_xor(ss, 4);
            const float rs = rsqrtf(ss * (1.f / 64.f) + 1e-6f);
#pragma unroll
            for (int e = 0; e < 8; ++e) x[e] = x[e] * rs * g[e];
            const float cc[8] = {cs[r][0].x, cs[r][0].z, cs[r][1].x, cs[r][1].z, cs[r][2].x, cs[r][2].z, cs[r][3].x, cs[r][3].z};
            const float sn[8] = {cs[r][0].y, cs[r][0].w, cs[r][1].y, cs[r][1].w, cs[r][2].y, cs[r][2].w, cs[r][3].y, cs[r][3].w};
#pragma unroll
            for (int e = 0; e < 8; ++e) { const float o = __shfl_xor(x[e], 1);
                if (sub == 0) x[e] = x[e] * cc[e] - o * sn[e]; else if (sub == 1) x[e] = x[e] * cc[e] + o * sn[e]; }
#pragma unroll
            for (int e = 0; e < 8; ++e) x[e] *= qs;
            *(v4u*)(proj + (size_t)t * NPROJ + coff) = pack8(x); } }
    }
}
DI void ret_load_rope(float* dst, int ld, const bf16* proj, size_t grow0, int pos0, int col0, float scale, bool zeta, float lg, const float* tabR, int tid) {
    const int row = tid >> 2, qd = tid & 3;
    const bf16* src = proj + (grow0 + row) * NPROJ + col0;
    float own[16], par[16];
    { float t8[8]; unpack8(*(const v4u*)(src + qd * 16), t8);
#pragma unroll
      for (int e = 0; e < 8; ++e) own[e] = t8[e];
      unpack8(*(const v4u*)(src + qd * 16 + 8), t8);
#pragma unroll
      for (int e = 0; e < 8; ++e) own[8 + e] = t8[e];
      unpack8(*(const v4u*)(src + (qd ^ 2) * 16), t8);
#pragma unroll
      for (int e = 0; e < 8; ++e) par[e] = t8[e];
      unpack8(*(const v4u*)(src + (qd ^ 2) * 16 + 8), t8);
#pragma unroll
      for (int e = 0; e < 8; ++e) par[8 + e] = t8[e]; }
    const float* cs = tabR + ((size_t)(pos0 + row) * 32 + (qd & 1) * 16) * 2;
    float sc = scale; if (zeta) sc *= __expf(lg * (float)(127 - row));
    float* d = dst + row * ld + qd * 16;
#pragma unroll
    for (int e = 0; e < 16; ++e) { const float c = cs[2 * e], s = cs[2 * e + 1]; const float r = (qd < 2) ? own[e] * c - par[e] * s : own[e] * c + par[e] * s; d[e] = r * sc; }
}
DI float ret_loggamma(int h) { return log1pf(-exp2f(-5.0f - (float)h)); }

DI void ret_kv_unit(const KArgs& a, char* lds, int unit, int tid) {
    asm volatile("" : "+v"(tid));
    const int n = unit & 127, h = (unit >> 7) & 3, b = unit >> 9;
    float* KS = (float*)lds; float* VS = (float*)(lds + 32768);
    const bf16* proj = (const bf16*)(a.ws() + WS_PROJ); const size_t grow0 = (size_t)b * SEQ + n * 128;
    const float lg = ret_loggamma(h);
    ret_load_rope(KS, 64, proj, grow0, n * 128, C_KR + h * 64, 0.125f, true, lg, (const float*)(a.ws() + WS_TABR), tid);
    { const int row = tid >> 2, q = tid & 3; const bf16* src = proj + (grow0 + row) * NPROJ + C_VR + h * 128 + q * 32; float* d = VS + row * 128 + q * 32;
#pragma unroll
      for (int c = 0; c < 4; ++c) { float t8[8]; unpack8(*(const v4u*)(src + 8 * c), t8);
#pragma unroll
          for (int e = 0; e < 8; ++e) d[8 * c + e] = t8[e]; } }
    __syncthreads();
    const int e = tid & 127, dq = tid >> 7;
    float acc[16];
#pragma unroll
    for (int c = 0; c < 16; ++c) acc[c] = 0.f;
    for (int j = 0; j < 128; ++j) { const float vv = VS[j * 128 + e]; const f32x4* kk = (const f32x4*)(KS + j * 64 + dq * 16);
#pragma unroll
        for (int c = 0; c < 4; ++c) { const f32x4 k4 = kk[c]; acc[4 * c] += vv * k4.x; acc[4 * c + 1] += vv * k4.y; acc[4 * c + 2] += vv * k4.z; acc[4 * c + 3] += vv * k4.w; } }
    float* kv = (float*)(a.ws() + WS_KV) + ((size_t)((b * 4 + h) * 128 + n)) * 8192;
#pragma unroll
    for (int c = 0; c < 16; ++c) kv[(dq * 16 + c) * 128 + e] = acc[c];
    __syncthreads();
}
typedef short bf16x8_t __attribute__((ext_vector_type(8)));
typedef float f32x4_t __attribute__((ext_vector_type(4)));
constexpr int SSM_XLD = 528;
template <bool EMIT> DI void ssm_wave_chunk(const KArgs& a, int layer, int b, int chunk, int g, LAS char* XS  , LAS char* UWb  , LAS char* ZS, int zld  , float& hr, float& hi, int lane) {
    const bf16* proj = (const bf16*)(a.ws() + WS_PROJ); const size_t grow0 = (size_t)b * SEQ + chunk * 128;
    const char* sp = (const char*)(a.ws() + WS_SSM + (size_t)layer * SSM_LAYER_BYTES);
    const int l15 = lane & 15, l4 = lane >> 4;
    const bf16x8_t zero8 = (bf16x8_t){0, 0, 0, 0, 0, 0, 0, 0};
    bf16x8_t bmf[8];
#pragma unroll
    for (int nt = 0; nt < 8; ++nt) bmf[nt] = *(const bf16x8_t*)(sp + SSM_BMT + (((size_t)g * 128 + 16 * nt + l15) * 16 + 8 * (l4 & 1)) * 2);
    bf16x8_t cmf[4]; float dsk = 0.f;
    if (EMIT) {
#pragma unroll
        for (int s = 0; s < 4; ++s) cmf[s] = *(const bf16x8_t*)(sp + SSM_CMT + (((size_t)g * 16 + l15) * 128 + 32 * s + 8 * l4) * 2);
        dsk = a.in(I_SD)[layer * 256 + g * 16 + l15];
    }
    const float ar = ((const float*)(sp + SSM_ABAR))[2 * (g * 64 + lane)], ai = ((const float*)(sp + SSM_ABAR))[2 * (g * 64 + lane) + 1];
    const bf16* usrc = proj + (grow0 + ((lane & 31) >> 1)) * NPROJ + C_US + g * 16 + (lane & 1) * 8;
    v4u unext = *(const v4u*)usrc;
    for (int blk = 0; blk < 8; ++blk) {
        if (lane < 32) *(LAS v4u*)(UWb + lane * 16) = unext;
        unext = *(const v4u*)(usrc + (size_t)(16 * (blk < 7 ? blk + 1 : 7)) * NPROJ);
        LDS_WAIT(); asm volatile("" ::: "memory");
        const bf16x8_t uf = *(const LAS bf16x8_t*)(UWb + l15 * 32 + (l4 & 1) * 16);
        f32x4_t dx[8];
#pragma unroll
        for (int nt = 0; nt < 8; ++nt) dx[nt] = __builtin_amdgcn_mfma_f32_16x16x32_bf16(uf, bmf[nt], (f32x4_t){0.f, 0.f, 0.f, 0.f}, 0, 0, 0);
        asm volatile("" : "+v"(dx[0]), "+v"(dx[1]), "+v"(dx[2]), "+v"(dx[3]), "+v"(dx[4]), "+v"(dx[5]), "+v"(dx[6]), "+v"(dx[7]) : "v"(uf));
#pragma unroll
        for (int nt = 0; nt < 8; ++nt)
#pragma unroll
            for (int r = 0; r < 4; ++r) *(LAS float*)(XS + (4 * l4 + r) * SSM_XLD + (16 * nt + l15) * 4) = 0.5f * dx[nt][r];
        asm volatile("" :: "v"(bmf[0]), "v"(bmf[1]), "v"(bmf[2]), "v"(bmf[3]), "v"(bmf[4]), "v"(bmf[5]), "v"(bmf[6]), "v"(bmf[7]));
        LDS_WAIT(); asm volatile("" ::: "memory");
        float xr_[16], xi_[16];
#pragma unroll
        for (int tt = 0; tt < 16; ++tt) { xr_[tt] = *(const LAS float*)(XS + tt * SSM_XLD + lane * 4); xi_[tt] = *(const LAS float*)(XS + tt * SSM_XLD + 256 + lane * 4); }
        asm volatile("" ::: "memory");
#pragma unroll
        for (int tt = 0; tt < 16; ++tt) { const float xr = xr_[tt], xi = xi_[tt];
            const float nhr = ar * hr - ai * hi + xr, nhi = ar * hi + ai * hr + xi; hr = nhr; hi = nhi;
            if (EMIT) *(LAS unsigned*)(XS + tt * SSM_XLD + lane * 4) = pg8::cvt_pk_bf16(hr, hi); }
        if (EMIT) {
            LDS_WAIT(); asm volatile("" ::: "memory");
            f32x4_t y = (f32x4_t){0.f, 0.f, 0.f, 0.f};
#pragma unroll
            for (int s = 0; s < 4; ++s) { const bf16x8_t hf = *(const LAS bf16x8_t*)(XS + l15 * SSM_XLD + (32 * s + 8 * l4) * 2); y = __builtin_amdgcn_mfma_f32_16x16x32_bf16(hf, cmf[s], y, 0, 0, 0); asm volatile("" : "+v"(y) : "v"(hf), "v"(cmf[s])); }

#pragma unroll
            for (int r = 0; r < 4; ++r) { const int t = 4 * l4 + r; const float uv = bf2f(*(const LAS bf16*)(UWb + t * 32 + l15 * 2)); const float yv = y[r] + dsk * uv;
                const float z = yv * sigmoidf_(1.5957691216057308f * (yv + 0.044715f * yv * yv * yv));
                *(LAS bf16*)(ZS + (16 * blk + t) * zld + (g * 16 + l15) * 2) = (bf16)f2bf(z); }
        }
        LDS_WAIT(); asm volatile("" ::: "memory");
    }
}
DI void attn_unit(const KArgs& a, char* lds, int unit, int tid) {
    asm volatile("" : "+v"(tid));
    const int pat = unit >> 10, rem = unit & 1023, b = rem >> 9, h = (rem >> 7) & 3, rn = rem & 127;
    const int dil = pat == 0 ? 1 : (pat == 1 ? 4 : 16), nbk = 128 / dil;
    const int n = rn % nbk, r = rn / nbk;
    constexpr int LDK = 68;
    float* KS = (float*)lds; float* VS = (float*)(lds + 256 * LDK * 4);
    const bf16* proj = (const bf16*)(a.ws() + WS_PROJ);
    { const int j = tid >> 1, half = tid & 1; const int l = 128 * (n - 1) + j; float* kd = KS + j * LDK + half * 32; float* vd = VS + j * LDK + half * 32;
      if (l >= 0) { const size_t grow = (size_t)b * SEQ + (size_t)l * dil + r; const bf16* ks = proj + grow * NPROJ + C_KA + h * 64 + half * 32; const bf16* vs = proj + grow * NPROJ + C_VA + h * 64 + half * 32;
#pragma unroll
          for (int c = 0; c < 4; ++c) { float t8[8]; unpack8(*(const v4u*)(ks + 8 * c), t8);
#pragma unroll
              for (int e = 0; e < 8; ++e) kd[8 * c + e] = t8[e];
              unpack8(*(const v4u*)(vs + 8 * c), t8);
#pragma unroll
              for (int e = 0; e < 8; ++e) vd[8 * c + e] = t8[e]; }
      } else {
#pragma unroll
          for (int e = 0; e < 32; ++e) { kd[e] = 0.f; vd[e] = 0.f; } } }
    __syncthreads();
    const int qi = tid >> 2, part = tid & 3;
    const size_t growq = (size_t)b * SEQ + (size_t)(128 * n + qi) * dil + r;
    float q[64];
    { const bf16* qs = proj + growq * NPROJ + C_QA + h * 64;
#pragma unroll
      for (int c = 0; c < 8; ++c) { float t8[8]; unpack8(*(const v4u*)(qs + 8 * c), t8);
#pragma unroll
          for (int e = 0; e < 8; ++e) q[8 * c + e] = t8[e]; } }
    float m = -INFINITY, l = 0.f, o[64];
#pragma unroll
    for (int e = 0; e < 64; ++e) o[e] = 0.f;
    for (int jj = 0; jj < 33; ++jj) {
        const int j = qi + 4 * jj + part;
        const bool valid = (j <= qi + 128) && (n > 0 || j >= 128);
        if (valid) {
            const f32x4* kr = (const f32x4*)(KS + j * LDK); float s = 0.f;
#pragma unroll
            for (int c = 0; c < 16; ++c) { const f32x4 k4 = kr[c]; s += q[4 * c] * k4.x + q[4 * c + 1] * k4.y + q[4 * c + 2] * k4.z + q[4 * c + 3] * k4.w; }
            const float mn = fmaxf(m, s), sc = __expf(m - mn), p = __expf(s - mn);
            l = l * sc + p; m = mn;
            const f32x4* vr = (const f32x4*)(VS + j * LDK);
#pragma unroll
            for (int c = 0; c < 16; ++c) { const f32x4 v4 = vr[c]; o[4 * c] = o[4 * c] * sc + p * v4.x; o[4 * c + 1] = o[4 * c + 1] * sc + p * v4.y; o[4 * c + 2] = o[4 * c + 2] * sc + p * v4.z; o[4 * c + 3] = o[4 * c + 3] * sc + p * v4.w; }
        }
    }
    float M = fmaxf(m, qx1(m)); M = fmaxf(M, qx2(M));
    const float f = (m == -INFINITY) ? 0.f : __expf(m - M);
    l *= f; l += qx1(l); l += qx2(l);
    const float il = 1.0f / l;
#pragma unroll
    for (int e = 0; e < 64; ++e) { float t = o[e] * f; t += qx1(t); t += qx2(t); o[e] = t * il; }
    float w[16];
#pragma unroll
    for (int e = 0; e < 16; ++e) w[e] = part == 0 ? o[e] : (part == 1 ? o[16 + e] : (part == 2 ? o[32 + e] : o[48 + e]));
    bf16* op = (bf16*)(a.ws() + WS_ATTP) + ((size_t)pat * T + growq) * 256 + h * 64 + part * 16;
    { v4u w0, w1; w0.x = pk2(w[0], w[1]); w0.y = pk2(w[2], w[3]); w0.z = pk2(w[4], w[5]); w0.w = pk2(w[6], w[7]); w1.x = pk2(w[8], w[9]); w1.y = pk2(w[10], w[11]); w1.z = pk2(w[12], w[13]); w1.w = pk2(w[14], w[15]);
      *(v4u*)op = w0; *(v4u*)(op + 8) = w1; }
    if (part == 0) ((float*)(a.ws() + WS_LSE))[((size_t)pat * T + growq) * 4 + h] = M + __logf(l);
    __syncthreads();
}
typedef short s16x4_t __attribute__((ext_vector_type(4)));
typedef float f32x16_t __attribute__((ext_vector_type(16)));
typedef float f32x2_t __attribute__((ext_vector_type(2)));
typedef __bf16 bf16x2_t __attribute__((ext_vector_type(2)));
DI unsigned cvtpk(float lo, float hi) { f32x2_t v = {lo, hi}; bf16x2_t b = __builtin_convertvector(v, bf16x2_t); return __builtin_bit_cast(unsigned, b); }
DI s16x4_t ldtr(const LAS char* p) { return __builtin_bit_cast(s16x4_t, __builtin_amdgcn_ds_read_tr16_b64_v4i16((LAS s16x4_t*)p)); }
DI int crow16(int r, int hh) { return (r & 3) + 8 * (r >> 2) + 4 * hh; }
struct AttnUnitId { int pat, b, h, dil, r, u; };
DI AttnUnitId attn_decode(int unit) { AttnUnitId d; d.pat = unit >> 9; const int rem = unit & 511; d.b = rem >> 8; d.h = (rem >> 6) & 3; const int cu = rem & 63;
    d.dil = d.pat == 0 ? 1 : (d.pat == 1 ? 4 : 16); const int upc = 64 / d.dil; d.r = cu / upc; d.u = cu % upc; return d; }
DI unsigned attn_issue_kv(const bf16* proj, const AttnUnitId& d, int tid, v4u (&kv)[6], v4u (&vv)[6]) {
    const int kc0 = 256 * d.u - 128 + (tid >> 3);
    const bf16* p0 = proj + ((size_t)d.b * SEQ + (size_t)d.r) * NPROJ + C_KA + d.h * 64 + (tid & 7) * 8;
    unsigned mask = 0u;
#pragma unroll
    for (int it = 0; it < 6; ++it) { const int kc = kc0 + 64 * it, kcc = kc < 0 ? 0 : kc; mask |= (kc >= 0 ? 1u : 0u) << it;
        const bf16* p = p0 + (size_t)(kcc * d.dil) * NPROJ; kv[it] = *(const v4u*)p; vv[it] = *(const v4u*)(p + (C_VA - C_KA)); }
    return mask;
}
template <class F> DI void attn_run(const KArgs& a, LAS char* lds, int nun, const F& unit_of, int tid) {
    asm volatile("" : "+v"(tid));
    if (nun <= 0) return;
    constexpr int RS = 144;
    LAS char* KL = lds; LAS char* VL = lds + 384 * RS;
    const bf16* proj = (const bf16*)(a.ws() + WS_PROJ);
    const int w = tid >> 6, lane = tid & 63, ql = lane & 31, hh = lane >> 5;
    const int q4 = (lane & 15) >> 2, p4 = lane & 3, blk = (lane >> 4) & 1;
    AttnUnitId d = attn_decode(unit_of(0));
    v4u kv[6], vv[6];
    unsigned kvmask = attn_issue_kv(proj, d, tid, kv, vv);
    bf16x8_t qn[4];
    { const size_t grow = (size_t)d.b * SEQ + (size_t)(256 * d.u + 32 * w + ql) * d.dil + d.r;
#pragma unroll
      for (int s = 0; s < 4; ++s) qn[s] = *(const bf16x8_t*)(proj + grow * NPROJ + C_QA + d.h * 64 + 16 * s + 8 * hh); }
    for (int k = 0; k < nun; ++k) {
#pragma unroll
        for (int it = 0; it < 6; ++it) { const int c = tid + 512 * it, row = c >> 3, ch = c & 7; const bool ok = (kvmask >> it) & 1u; const v4u z4 = (v4u){0u, 0u, 0u, 0u};
            *(LAS v4u*)(KL + row * RS + ch * 16) = ok ? kv[it] : z4; *(LAS v4u*)(VL + row * RS + ch * 16) = ok ? vv[it] : z4; }
        const AttnUnitId dc = d; const size_t growc = (size_t)d.b * SEQ + (size_t)(256 * d.u + 32 * w + ql) * d.dil + d.r;
        bf16x8_t qc[4];
#pragma unroll
        for (int s = 0; s < 4; ++s) qc[s] = qn[s];
        __syncthreads();
        d = attn_decode(unit_of(k + 1 < nun ? k + 1 : k)); kvmask = attn_issue_kv(proj, d, tid, kv, vv);
        { const size_t grow = (size_t)d.b * SEQ + (size_t)(256 * d.u + 32 * w + ql) * d.dil + d.r;
#pragma unroll
          for (int s = 0; s < 4; ++s) qn[s] = *(const bf16x8_t*)(proj + grow * NPROJ + C_QA + d.h * 64 + 16 * s + 8 * hh); }
        f32x16_t p[5];
#pragma unroll
        for (int kt = 0; kt < 5; ++kt) {
#pragma unroll
            for (int e = 0; e < 16; ++e) p[kt][e] = 0.f;
#pragma unroll
            for (int s = 0; s < 4; ++s) { const bf16x8_t kf = *(const LAS bf16x8_t*)(KL + (32 * w + 32 * kt + ql) * RS + 32 * s + 16 * hh); p[kt] = __builtin_amdgcn_mfma_f32_32x32x16_bf16(kf, qc[s], p[kt], 0, 0, 0); } }
        const int kc0 = 256 * dc.u + 32 * w - 128;
        float m = -INFINITY;
#pragma unroll
        for (int kt = 0; kt < 5; ++kt)
#pragma unroll
            for (int e = 0; e < 16; ++e) { const int c = crow16(e, hh);
                bool valid;
                if (kt == 0) valid = (c >= ql) && (kc0 >= 0); else if (kt == 4) valid = (c <= ql); else valid = (kc0 + 32 * kt >= 0);
                p[kt][e] = valid ? p[kt][e] : -INFINITY; m = fmaxf(m, p[kt][e]); }
        m = fmaxf(m, __shfl_xor(m, 32));
        float l = 0.f;
#pragma unroll
        for (int kt = 0; kt < 5; ++kt)
#pragma unroll
            for (int e = 0; e < 16; ++e) { const float pe = __builtin_amdgcn_exp2f(p[kt][e] - m); p[kt][e] = pe; l += pe; }
        l += __shfl_xor(l, 32);
        f32x16_t o[2];
#pragma unroll
        for (int e = 0; e < 16; ++e) { o[0][e] = 0.f; o[1][e] = 0.f; }
#pragma unroll
        for (int kt = 0; kt < 5; ++kt)
#pragma unroll
            for (int s = 0; s < 2; ++s) {
                v4u pw; pw.x = cvtpk(p[kt][8 * s], p[kt][8 * s + 1]); pw.y = cvtpk(p[kt][8 * s + 2], p[kt][8 * s + 3]); pw.z = cvtpk(p[kt][8 * s + 4], p[kt][8 * s + 5]); pw.w = cvtpk(p[kt][8 * s + 6], p[kt][8 * s + 7]);
                const bf16x8_t pb = __builtin_bit_cast(bf16x8_t, pw);
                const int row0 = 32 * w + 32 * kt + 16 * s + 4 * hh + q4;
#pragma unroll
                for (int db = 0; db < 2; ++db) { const LAS char* vp = VL + row0 * RS + (32 * db + 16 * blk + 4 * p4) * 2;
                    const s16x4_t lo = ldtr(vp), hi = ldtr(vp + 8 * RS);
                    const bf16x8_t af = __builtin_shufflevector(lo, hi, 0, 1, 2, 3, 4, 5, 6, 7);
                    o[db] = __builtin_amdgcn_mfma_f32_32x32x16_bf16(af, pb, o[db], 0, 0, 0); } }
        const float il = 1.0f / l;
        bf16* op = (bf16*)(a.ws() + WS_ATTP) + ((size_t)dc.pat * T + growc) * 256 + dc.h * 64;
#pragma unroll
        for (int db = 0; db < 2; ++db)
#pragma unroll
            for (int g = 0; g < 4; ++g) { v2u wv; wv.x = cvtpk(o[db][4 * g] * il, o[db][4 * g + 1] * il); wv.y = cvtpk(o[db][4 * g + 2] * il, o[db][4 * g + 3] * il);
                *(v2u*)(op + 32 * db + 8 * g + 4 * hh) = wv; }
        if (hh == 0) ((float*)(a.ws() + WS_LSE))[((size_t)dc.pat * T + growc) * 4 + dc.h] = (m + __log2f(l)) * 0.6931471805599453f;
        __syncthreads();
    }
}
DI void ret_load_rope_bf16(LAS char* dst, int rs, const bf16* proj, size_t grow0, int pos0, int col0, float scale, bool zeta, float lg, const float* tabR, int tid) {
    const int row = tid >> 2, qd = tid & 3;
    const bf16* src = proj + (grow0 + row) * NPROJ + col0;
    float own[16], par[16];
    { float t8[8]; unpack8(*(const v4u*)(src + qd * 16), t8);
#pragma unroll
      for (int e = 0; e < 8; ++e) own[e] = t8[e];
      unpack8(*(const v4u*)(src + qd * 16 + 8), t8);
#pragma unroll
      for (int e = 0; e < 8; ++e) own[8 + e] = t8[e];
      unpack8(*(const v4u*)(src + (qd ^ 2) * 16), t8);
#pragma unroll
      for (int e = 0; e < 8; ++e) par[e] = t8[e];
      unpack8(*(const v4u*)(src + (qd ^ 2) * 16 + 8), t8);
#pragma unroll
      for (int e = 0; e < 8; ++e) par[8 + e] = t8[e]; }
    const float* cs = tabR + ((size_t)(pos0 + row) * 32 + (qd & 1) * 16) * 2;
    float sc = scale; if (zeta) sc *= __expf(lg * (float)(127 - row));
    float o[16];
#pragma unroll
    for (int e = 0; e < 16; ++e) { const float c = cs[2 * e], s = cs[2 * e + 1]; o[e] = ((qd < 2) ? own[e] * c - par[e] * s : own[e] * c + par[e] * s) * sc; }
    v4u w0, w1; w0.x = pk2(o[0], o[1]); w0.y = pk2(o[2], o[3]); w0.z = pk2(o[4], o[5]); w0.w = pk2(o[6], o[7]); w1.x = pk2(o[8], o[9]); w1.y = pk2(o[10], o[11]); w1.z = pk2(o[12], o[13]); w1.w = pk2(o[14], o[15]);
    *(LAS v4u*)(dst + row * rs + qd * 32) = w0; *(LAS v4u*)(dst + row * rs + qd * 32 + 16) = w1;
}
constexpr int RKS = 144, RVS = 272;
DI void ret_kv_unit_mfma(const KArgs& a, LAS char* lds, int unit, int tid) {
    asm volatile("" : "+v"(tid));
    const int n = unit & 127, h = (unit >> 7) & 3, b = unit >> 9;
    LAS char* KL = lds; LAS char* VL = lds + 128 * RKS;
    const bf16* proj = (const bf16*)(a.ws() + WS_PROJ); const size_t grow0 = (size_t)b * SEQ + n * 128;
    const float lg = ret_loggamma(h);
    ret_load_rope_bf16(KL, RKS, proj, grow0, n * 128, C_KR + h * 64, 0.125f, true, lg, (const float*)(a.ws() + WS_TABR), tid);
    { const int row = tid >> 2, qq = tid & 3; const v4u* src = (const v4u*)(proj + (grow0 + row) * NPROJ + C_VR + h * 128 + qq * 32);
#pragma unroll
      for (int c = 0; c < 4; ++c) *(LAS v4u*)(VL + row * RVS + qq * 64 + c * 16) = src[c]; }
    __syncthreads();
    const int w = tid >> 6, lane = tid & 63, ql = lane & 31, hh = lane >> 5, q4 = (lane & 15) >> 2, p4 = lane & 3, blk = (lane >> 4) & 1;
    const int et = w >> 1, dt = w & 1;
    f32x16_t acc;
#pragma unroll
    for (int e = 0; e < 16; ++e) acc[e] = 0.f;
#pragma unroll
    for (int s = 0; s < 8; ++s) { const int row0 = 16 * s + 8 * hh + q4;
        const LAS char* vp = VL + row0 * RVS + (32 * et + 16 * blk + 4 * p4) * 2; const LAS char* kp = KL + row0 * RKS + (32 * dt + 16 * blk + 4 * p4) * 2;
        const s16x4_t alo = ldtr(vp), ahi = ldtr(vp + 4 * RVS), blo = ldtr(kp), bhi = ldtr(kp + 4 * RKS);
        const bf16x8_t af = __builtin_shufflevector(alo, ahi, 0, 1, 2, 3, 4, 5, 6, 7), bfr = __builtin_shufflevector(blo, bhi, 0, 1, 2, 3, 4, 5, 6, 7);
        acc = __builtin_amdgcn_mfma_f32_32x32x16_bf16(af, bfr, acc, 0, 0, 0); }
    float* kv = (float*)(a.ws() + WS_KV) + ((size_t)((b * 4 + h) * 128 + n)) * 8192;
#pragma unroll
    for (int e = 0; e < 16; ++e) kv[(32 * et + crow16(e, hh)) * 64 + 32 * dt + ql] = acc[e];
    __syncthreads();
}
struct RetRaw { v4u q[4], k[4], v[4], g[4]; f32x4 pv[4]; };
DI void ret_issue(const KArgs& a, int unit, int tid, RetRaw& r) {
    const int n = unit & 127, h = (unit >> 7) & 3, b = unit >> 9, row = tid >> 2, qd = tid & 3;
    const bf16* base = (const bf16*)(a.ws() + WS_PROJ) + ((size_t)b * SEQ + n * 128 + row) * NPROJ;
    const bf16* sq = base + C_QR + h * 64; const bf16* sk = base + C_KR + h * 64; const bf16* sv = base + C_VR + h * 128 + qd * 32;
    r.q[0] = *(const v4u*)(sq + qd * 16); r.q[1] = *(const v4u*)(sq + qd * 16 + 8); r.q[2] = *(const v4u*)(sq + (qd ^ 2) * 16); r.q[3] = *(const v4u*)(sq + (qd ^ 2) * 16 + 8);
    r.k[0] = *(const v4u*)(sk + qd * 16); r.k[1] = *(const v4u*)(sk + qd * 16 + 8); r.k[2] = *(const v4u*)(sk + (qd ^ 2) * 16); r.k[3] = *(const v4u*)(sk + (qd ^ 2) * 16 + 8);
#pragma unroll
    for (int c = 0; c < 4; ++c) { r.v[c] = *(const v4u*)(sv + 8 * c); r.g[c] = *(const v4u*)(base + C_GR + h * 128 + qd * 32 + 8 * c); }
    const f32x4* sp = (const f32x4*)((const float*)(a.ws() + WS_KV) + ((size_t)((b * 4 + h) * 128 + n)) * 8192 + row * 64 + qd * 16);
#pragma unroll
    for (int c = 0; c < 4; ++c) r.pv[c] = sp[c];
}
DI void ret_rope_store(LAS char* dst, const v4u (&raw)[4], const float* cs, int qd, float scale) {
    float own[16], par[16];
    { float t8[8]; unpack8(raw[0], t8);
#pragma unroll
      for (int e = 0; e < 8; ++e) own[e] = t8[e];
      unpack8(raw[1], t8);
#pragma unroll
      for (int e = 0; e < 8; ++e) own[8 + e] = t8[e];
      unpack8(raw[2], t8);
#pragma unroll
      for (int e = 0; e < 8; ++e) par[e] = t8[e];
      unpack8(raw[3], t8);
#pragma unroll
      for (int e = 0; e < 8; ++e) par[8 + e] = t8[e]; }
    float o[16];
#pragma unroll
    for (int e = 0; e < 16; ++e) { const float c = cs[2 * e], s = cs[2 * e + 1]; o[e] = ((qd < 2) ? own[e] * c - par[e] * s : own[e] * c + par[e] * s) * scale; }
    v4u w0, w1; w0.x = pk2(o[0], o[1]); w0.y = pk2(o[2], o[3]); w0.z = pk2(o[4], o[5]); w0.w = pk2(o[6], o[7]); w1.x = pk2(o[8], o[9]); w1.y = pk2(o[10], o[11]); w1.z = pk2(o[12], o[13]); w1.w = pk2(o[14], o[15]);
    *(LAS v4u*)dst = w0; *(LAS v4u*)(dst + 16) = w1;
}
template <class F> DI void ret_out_run(const KArgs& a, LAS char* lds, int layer, int nun, const F& unit_of, int tid) {
    asm volatile("" : "+v"(tid));
    if (nun <= 0) return;
    LAS char* QL = lds; LAS char* KL = lds + 128 * RKS; LAS char* VL = lds + 2 * 128 * RKS; LAS char* PL = VL + 128 * RVS; LAS float* ST = (LAS float*)(PL + 128 * RKS);
    const bf16* proj = (const bf16*)(a.ws() + WS_PROJ); const float* tabR = (const float*)(a.ws() + WS_TABR);
    const int w = tid >> 6, lane = tid & 63, ql = lane & 31, hh = lane >> 5, q4 = (lane & 15) >> 2, p4 = lane & 3, blk = (lane >> 4) & 1;
    const int ib = w >> 1, eh = w & 1, i = 32 * ib + ql, row = tid >> 2, qd = tid & 3;
    RetRaw raw; int unit = unit_of(0);
    ret_issue(a, unit, tid, raw);
    for (int kk = 0; kk < nun; ++kk) {
        const int n = unit & 127, h = (unit >> 7) & 3, b = unit >> 9; const size_t grow0 = (size_t)b * SEQ + n * 128; const float lg = ret_loggamma(h);
        { const float* cs = tabR + ((size_t)(n * 128 + row) * 32 + (qd & 1) * 16) * 2;
          ret_rope_store(QL + row * RKS + qd * 32, raw.q, cs, qd, 1.0f); ret_rope_store(KL + row * RKS + qd * 32, raw.k, cs, qd, 0.125f * __expf(-lg * (float)(row + 1)));
#pragma unroll
          for (int c = 0; c < 4; ++c) *(LAS v4u*)(VL + row * RVS + qd * 64 + c * 16) = raw.v[c];
          v4u w0, w1; w0.x = pk2(raw.pv[0].x, raw.pv[0].y); w0.y = pk2(raw.pv[0].z, raw.pv[0].w); w0.z = pk2(raw.pv[1].x, raw.pv[1].y); w0.w = pk2(raw.pv[1].z, raw.pv[1].w);
          w1.x = pk2(raw.pv[2].x, raw.pv[2].y); w1.y = pk2(raw.pv[2].z, raw.pv[2].w); w1.z = pk2(raw.pv[3].x, raw.pv[3].y); w1.w = pk2(raw.pv[3].z, raw.pv[3].w);
          *(LAS v4u*)(PL + row * RKS + qd * 32) = w0; *(LAS v4u*)(PL + row * RKS + qd * 32 + 16) = w1; }
        v4u gcur[4];
#pragma unroll
        for (int c = 0; c < 4; ++c) gcur[c] = raw.g[c];
        __syncthreads();
        unit = unit_of(kk + 1 < nun ? kk + 1 : kk); ret_issue(a, unit, tid, raw);
        bf16x8_t qf[4], qsf[4];
        { const float xi = __expf(lg * (float)(i + 1));
#pragma unroll
          for (int s = 0; s < 4; ++s) { qf[s] = *(const LAS bf16x8_t*)(QL + i * RKS + 32 * s + 16 * hh); float t8[8]; unpack8(__builtin_bit_cast(v4u, qf[s]), t8);
              v4u ww; ww.x = cvtpk(t8[0] * xi, t8[1] * xi); ww.y = cvtpk(t8[2] * xi, t8[3] * xi); ww.z = cvtpk(t8[4] * xi, t8[5] * xi); ww.w = cvtpk(t8[6] * xi, t8[7] * xi); qsf[s] = __builtin_bit_cast(bf16x8_t, ww); } }
        f32x16_t o[2];
#pragma unroll
        for (int e = 0; e < 16; ++e) { o[0][e] = 0.f; o[1][e] = 0.f; }
#pragma unroll
        for (int t = 0; t < 2; ++t)
#pragma unroll
            for (int s = 0; s < 4; ++s) { const bf16x8_t af = *(const LAS bf16x8_t*)(PL + (64 * eh + 32 * t + ql) * RKS + 32 * s + 16 * hh); o[t] = __builtin_amdgcn_mfma_f32_32x32x16_bf16(af, qsf[s], o[t], 0, 0, 0); }
        for (int jb = 0; jb <= ib; ++jb) {
            f32x16_t p;
#pragma unroll
            for (int e = 0; e < 16; ++e) p[e] = 0.f;
#pragma unroll
            for (int s = 0; s < 4; ++s) { const bf16x8_t kf = *(const LAS bf16x8_t*)(KL + (32 * jb + ql) * RKS + 32 * s + 16 * hh); p = __builtin_amdgcn_mfma_f32_32x32x16_bf16(kf, qsf[s], p, 0, 0, 0); }
            if (jb == ib) {
#pragma unroll
                for (int e = 0; e < 16; ++e) p[e] = (ql >= crow16(e, hh)) ? p[e] : 0.f; }
#pragma unroll
            for (int s2 = 0; s2 < 2; ++s2) {
                v4u pw; pw.x = cvtpk(p[8 * s2], p[8 * s2 + 1]); pw.y = cvtpk(p[8 * s2 + 2], p[8 * s2 + 3]); pw.z = cvtpk(p[8 * s2 + 4], p[8 * s2 + 5]); pw.w = cvtpk(p[8 * s2 + 6], p[8 * s2 + 7]);
                const bf16x8_t pb = __builtin_bit_cast(bf16x8_t, pw);
                const int row0 = 32 * jb + 16 * s2 + 4 * hh + q4;
#pragma unroll
                for (int t = 0; t < 2; ++t) { const LAS char* vp = VL + row0 * RVS + (64 * eh + 32 * t + 16 * blk + 4 * p4) * 2;
                    const s16x4_t lo = ldtr(vp), hi = ldtr(vp + 8 * RVS);
                    const bf16x8_t af = __builtin_shufflevector(lo, hi, 0, 1, 2, 3, 4, 5, 6, 7);
                    o[t] = __builtin_amdgcn_mfma_f32_32x32x16_bf16(af, pb, o[t], 0, 0, 0); } }
        }
        float s1 = 0.f, s2 = 0.f;
#pragma unroll
        for (int t = 0; t < 2; ++t)
#pragma unroll
            for (int e = 0; e < 16; ++e) { s1 += o[t][e]; s2 += o[t][e] * o[t][e]; }
        s1 += __shfl_xor(s1, 32); s2 += __shfl_xor(s2, 32);
        if (hh == 0) { ST[((ib * 2 + eh) * 32 + ql) * 2] = s1; ST[((ib * 2 + eh) * 32 + ql) * 2 + 1] = s2; }
        __syncthreads();
        const float t1 = ST[((ib * 2) * 32 + ql) * 2] + ST[((ib * 2 + 1) * 32 + ql) * 2], t2 = ST[((ib * 2) * 32 + ql) * 2 + 1] + ST[((ib * 2 + 1) * 32 + ql) * 2 + 1];
        const float mu = t1 * (1.f / 128.f), var = fmaxf(t2 * (1.f / 128.f) - mu * mu, 0.f), rstd = rsqrtf(var + 1e-5f);
#pragma unroll
        for (int t = 0; t < 2; ++t)
#pragma unroll
            for (int g4 = 0; g4 < 4; ++g4) { v2u yw; yw.x = cvtpk((o[t][4 * g4] - mu) * rstd, (o[t][4 * g4 + 1] - mu) * rstd); yw.y = cvtpk((o[t][4 * g4 + 2] - mu) * rstd, (o[t][4 * g4 + 3] - mu) * rstd);
                *(LAS v2u*)(VL + i * RVS + (64 * eh + 32 * t + 8 * g4 + 4 * hh) * 2) = yw; }
        __syncthreads();
        { const float* gn = a.in(I_GNG) + layer * 512 + h * 128 + qd * 32;
          bf16* op = (bf16*)(a.ws() + WS_XN) + (grow0 + row) * DM + 256 + h * 128 + qd * 32;
#pragma unroll
          for (int c = 0; c < 4; ++c) { float y8[8], g8[8], o8[8]; unpack8(*(const LAS v4u*)(VL + row * RVS + qd * 64 + c * 16), y8); unpack8(gcur[c], g8);
              const f32x4 n0 = *(const f32x4*)(gn + 8 * c), n1 = *(const f32x4*)(gn + 8 * c + 4); const float nn[8] = {n0.x, n0.y, n0.z, n0.w, n1.x, n1.y, n1.z, n1.w};
#pragma unroll
              for (int e = 0; e < 8; ++e) o8[e] = g8[e] * sigmoidf_(g8[e]) * y8[e] * nn[e];
              *(v4u*)(op + 8 * c) = pack8(o8); } }
        __syncthreads();
    }
}
template <int PARTS = 3> DI void ssm_out_unit(const KArgs& a, LAS char* lds, int layer, int unit, int tid) {
    asm volatile("" : "+v"(tid));
    const int chunk = unit & 127, b = unit >> 7, wave = __builtin_amdgcn_readfirstlane(tid >> 6), lane = tid & 63;
    constexpr int ZLD = 528;
    LAS char* ZS = lds; LAS char* XS = lds + 128 * ZLD + wave * (16 * SSM_XLD); LAS char* UWb = lds + 128 * ZLD + 8 * 16 * SSM_XLD + wave * 512;
    const float* sst = (const float*)(a.ws() + WS_SST);
    if (PARTS & 1) for (int gi = 0; gi < 2; ++gi) { const int g = wave + 8 * gi;
        const size_t so = (((size_t)(b * 128 + chunk)) * 1024 + g * 64 + lane) * 2; float hr = sst[so], hi = sst[so + 1];
        ssm_wave_chunk<true>(a, layer, b, chunk, g, XS, UWb, ZS, ZLD, hr, hi, lane); }
    __syncthreads();
    if (!(PARTS & 2)) return;
    const int ql = lane & 31, hh = lane >> 5, n = 32 * wave + ql;
    const bf16* glwt = (const bf16*)(a.ws() + WS_SSM + (size_t)layer * SSM_LAYER_BYTES + SSM_GLWT);
    bf16x8_t bfr[16];
#pragma unroll
    for (int s = 0; s < 16; ++s) bfr[s] = *(const bf16x8_t*)(glwt + (size_t)n * 256 + 16 * s + 8 * hh);
    const float bn = a.in(I_GLB)[layer * 256 + n];
    bf16* mixed = (bf16*)(a.ws() + WS_XN); const size_t grow0 = (size_t)b * SEQ + chunk * 128;
#pragma unroll 1
    for (int rt = 0; rt < 4; ++rt) { f32x16_t acc;
#pragma unroll
        for (int e = 0; e < 16; ++e) acc[e] = 0.f;
#pragma unroll
        for (int s = 0; s < 16; ++s) { const bf16x8_t af = *(const LAS bf16x8_t*)(ZS + (32 * rt + ql) * ZLD + (16 * s + 8 * hh) * 2); acc = __builtin_amdgcn_mfma_f32_32x32x16_bf16(af, bfr[s], acc, 0, 0, 0); }
#pragma unroll
        for (int e = 0; e < 16; ++e) { const int t = 32 * rt + crow16(e, hh); const float z = bf2f(*(const LAS bf16*)(ZS + t * ZLD + n * 2));
            mixed[(grow0 + t) * DM + 768 + n] = (bf16)f2bf(z * sigmoidf_(acc[e] + bn)); } }
    __syncthreads();
}
#ifndef MK_PER_PHASE
#define MK_PER_PHASE 0
#endif

#ifdef DIS_KV
#define TST_KV(x)
#else
#define TST_KV(x) x
#endif
#ifdef DIS_ATT
#define TST_ATT(x)
#else
#define TST_ATT(x) x
#endif
#ifdef DIS_RO
#define TST_RO(x)
#else
#define TST_RO(x) x
#endif
#ifdef DIS_SO
#define TST_SO(x)
#else
#define TST_SO(x) x
#endif
#ifdef DIS_PRO
#define EN_PRO 0
#else
#define EN_PRO 1
#endif
#ifdef DIS_INP
#define EN_INP 0
#else
#define EN_INP 1
#endif
#ifdef DIS_M1
#define EN_M1 0
#else
#define EN_M1 1
#endif
#ifdef DIS_M2
#define EN_M2 0
#else
#define EN_M2 1
#endif
#ifdef DIS_M3
#define EN_M3 0
#else
#define EN_M3 1
#endif
#ifdef DIS_WOUT
#define EN_WOUT 0
#else
#define EN_WOUT 1
#endif
#ifdef DIS_N2
#define EN_N2 0
#else
#define EN_N2 1
#endif
#ifdef DIS_FUP
#define EN_FUP 0
#else
#define EN_FUP 1
#endif
#ifdef DIS_FDN
#define EN_FDN 0
#else
#define EN_FDN 1
#endif
#ifdef DIS_N1
#define EN_N1 0
#else
#define EN_N1 1
#endif
#ifdef DIS_MUP
#define EN_MUP 0
#else
#define EN_MUP 1
#endif
#ifdef DIS_MDN
#define EN_MDN 0
#else
#define EN_MDN 1
#endif

#ifdef DUP_RO
#define PROBE_RO(x) x
#else
#define PROBE_RO(x)
#endif
#ifdef DUP_SO
#define PROBE_SO(x) x
#else
#define PROBE_SO(x)
#endif
#ifndef THIN_REPS
#define THIN_REPS 1
#endif
#ifndef EXTRA_BARS
#define EXTRA_BARS 0
#endif
#ifndef WOUT_REPS
#define WOUT_REPS 1
#endif
#ifndef FDN_REPS
#define FDN_REPS 1
#endif
#ifndef MDN_EPI
#define MDN_EPI pg8::EpiMoeDown
#endif
#ifndef MDN_REPS
#define MDN_REPS 1
#endif
#ifndef RO_REPS
#define RO_REPS 1
#endif
#ifndef INP_REPS
#define INP_REPS 1
#endif
#ifndef FUP_REPS
#define FUP_REPS 1
#endif
#ifndef MUP_REPS
#define MUP_REPS 1
#endif
#ifdef DUP_CONV
#define MOECONV_REPS 2
#else
#define MOECONV_REPS 1
#endif
#ifdef DUP_ATT
#define PROBE_ATT(x) x
#else
#define PROBE_ATT(x)
#endif
#ifdef DUP_KV
#define PROBE_KV(x) x
#else
#define PROBE_KV(x)
#endif
#ifndef ATT_REPS
#define ATT_REPS 1
#endif
#ifndef SO_PARTS
#define SO_PARTS 3
#endif
#ifndef ORDER_SPLIT
#define ORDER_SPLIT 1
#endif
#ifndef CONV_IN_WOUT
#define CONV_IN_WOUT 1
#endif
#define MOE_ITEM(d, it_) do { const int e = (it_) / 5376; int r = (it_) - e * 5376; \
                    if (r < 3584) { const int up = r / 1792; r -= up * 1792; const int kb = r / 112, nb = r % 112, n0 = 32 * nb; \
                        d.W = args.in(up ? I_MU : I_MG) + (size_t)e * DM * DFE; d.ldw = DFE; d.WT = (unsigned char*)(ws + WS_MGU) + (size_t)e * 2 * DFE * DM; d.ldo = DM; d.k0 = 64 * kb; d.n0 = n0; d.drow0 = (n0 >> 7) * 256 + (n0 & 127) + up * 128; d.scale = 32.0f; } \
                    else { r -= 3584; const int kb = r / 32, nb = r % 32; \
                        d.W = args.in(I_MD) + (size_t)e * DFE * DM; d.ldw = DM; d.WT = (unsigned char*)(ws + WS_MDN) + (size_t)e * DM * DFE; d.ldo = DFE; d.k0 = 64 * kb; d.n0 = 32 * nb; d.drow0 = 32 * nb; d.scale = 64.0f; } } while (0)
#define MOE_CONV() do { float* scr = (float*)(L + wave * 16384); constexpr int NIT_ = 8 * 5376; \
                for (int rep_ = 0; rep_ < MOECONV_REPS; ++rep_) \
                    for (int it = gw; it < NIT_; it += 2 * NGW) { const int it2 = (it + NGW < NIT_) ? it + NGW : it;     \
                        T8Item da, db; float va[32], vb[32]; MOE_ITEM(da, it); MOE_ITEM(db, it2); t8_load(va, da, lane); t8_load(vb, db, lane); \
                        t8_store(va, da, scr, lane); t8_store(vb, db, scr, lane); } } while (0)
constexpr int PH_PRO = 0, PH_L0 = 1, PH_PER_LAYER = 13, NPH = 1 + 2 * PH_PER_LAYER;
__global__ void __launch_bounds__(NWAVES * 64, 2) fwd_kernel(Args args_) {
    const KArgs args;
    extern __shared__ __attribute__((aligned(16))) unsigned char lds[];
    const int tid0 = threadIdx.x;
    const int wave0 = __builtin_amdgcn_readfirstlane(tid0 >> 6);
    const int G = gridDim.x, bx = blockIdx.x, NGW = G * NWAVES;
#define PHASE_IDS int wave = wave0; asm volatile("" : "+s"(wave)); unsigned z_ = 0u; asm volatile("" : "+v"(z_)); const int lane = (int)__builtin_amdgcn_mbcnt_hi(~0u, __builtin_amdgcn_mbcnt_lo(~0u, z_)); const int tid = wave * 64 + lane, gw = bx * NWAVES + wave; (void)tid; (void)gw
    unsigned char* ws = args.ws();
    unsigned* ctl = (unsigned*)(ws + WS_CTL);
    volatile LAS unsigned* MISC = (volatile LAS unsigned*)((LAS unsigned char*)lds + MISC_OFF);
    if (tid0 < 32) MISC[tid0] = 0u;
    __syncthreads();
    const int lo = args.ph_lo(), hi = args.ph_hi();
    XcdBarrier bar; bar.bar = ctl + CW_BAR; bar.x = 0; bar.st = nullptr;
    if (hi - lo > 1) bar = xcd_barrier_post(ctl + CW_BAR, MISC + 8, tid0 == 0);
#define IN(k) (lo <= (k) && (k) < hi)
#define SEAM(k) do { if ((k) + 1 < hi) { int w_ = wave0; asm volatile("" : "+s"(w_)); unsigned zz_ = 0u; asm volatile("" : "+v"(zz_)); const int l_ = (int)__builtin_amdgcn_mbcnt_hi(~0u, __builtin_amdgcn_mbcnt_lo(~0u, zz_)); xcd_barrier(bar, (w_ * 64 + l_) == 0); } } while (0)
    char* L = (char*)lds;
    LAS unsigned char* L3 = (LAS unsigned char*)lds;
    bf16* XN = (bf16*)(ws + WS_XN); bf16* PROJ = (bf16*)(ws + WS_PROJ);

    if (EN_PRO && IN(PH_PRO)) { PHASE_IDS; for (int rep_ = 0; rep_ < THIN_REPS; ++rep_) phase_prologue(args, L, gw, NGW, wave, lane); for (int xb_ = 0; xb_ < EXTRA_BARS; ++xb_) SEAM(PH_PRO); SEAM(PH_PRO); }

#define LAYER_BODY(layer) do { \
        const int base = PH_L0 + layer * PH_PER_LAYER; \
         \
        if (EN_INP && IN(base + 0)) { PHASE_IDS; \
            pg8::Gemm g{layer == 0 ? XN : (const bf16*)(ws + WS_XN2), (const bf16*)(ws + WS_WIN) + (size_t)layer * NPROJ * DM, T, NPROJ, DM, DM}; pg8::StaticOrder S; S.init(T, NPROJ, G, bx); \
            LAS float* RS = (LAS float*)((LAS char*)lds + 132096); if (layer == 1) build_rs(RS, S, (const float*)(ws + WS_SSQ), tid); \
            pg8::EpiBf16 E{PROJ, NPROJ, layer == 1 ? RS : (LAS float*)nullptr}; \
            for (int rep_ = 0; rep_ < INP_REPS; ++rep_) pg8::gemm_phase<pg8::EpiBf16, pg8::StaticOrder, true, true, false>(L3, g, S, E, tid); \
            SEAM(base + 0); \
        } \
         \
        if (EN_M1 && IN(base + 1)) { \
            \
          const int og_ = ORDER_SPLIT ? ((bx >> 3) & 1) : 0; \
          _Pragma("unroll 1") for (int s_ = 0; s_ < 3; ++s_) { const int part_ = og_ ? 2 - s_ : s_; \
           if (part_ == 0) { PHASE_IDS; \
            const float* tabA = (const float*)(ws + WS_TABA); \
            prep_phase(PROJ, args.in(I_QNG) + layer * 64, args.in(I_KNG) + layer * 64, tabA, gw, NGW, lane); \
           } else if (part_ == 1) { \
            { PHASE_IDS; TST_KV(for (int u = bx; u < 1024; u += G) ret_kv_unit_mfma(args, (LAS char*)lds, u, tid);) } \
            PROBE_KV({ PHASE_IDS; for (int u = bx; u < 1024; u += G) ret_kv_unit_mfma(args, (LAS char*)lds, u, tid); }) \
           } else { \
            for (int rep_ = 0; rep_ < THIN_REPS; ++rep_) { PHASE_IDS; for (int u = bx; u < 256; u += G) { const int chunk = u & 127, b = u >> 7; LAS char* XS = (LAS char*)lds + wave * (16 * SSM_XLD); LAS char* UWb = (LAS char*)lds + 8 * 16 * SSM_XLD + wave * 512; \
                for (int gi = 0; gi < 2; ++gi) { const int g = wave + 8 * gi; float hr = 0.f, hi_ = 0.f; \
                    ssm_wave_chunk<false>(args, layer, b, chunk, g, XS, UWb, XS, 0, hr, hi_, lane); \
                    float* sst = (float*)(ws + WS_SST) + (((size_t)(b * 128 + chunk)) * 1024 + g * 64 + lane) * 2; sst[0] = hr; sst[1] = hi_; } \
                __syncthreads(); } } \
           } \
           __syncthreads(); } \
            SEAM(base + 1); \
        } \
         \
        if (EN_M2 && IN(base + 2)) { PHASE_IDS; \
            for (int u = bx; u < 128; u += G) {                     \
                const int gid = u * 512 + tid, bh = gid >> 13, el = gid & 8191; const float cd = __expf(ret_loggamma(bh & 3) * 128.0f); \
                float* p = (float*)(ws + WS_KV) + (size_t)bh * 128 * 8192 + el; float st = 0.f; \
                for (int n0 = 0; n0 < 128; n0 += 32) { float x[32]; \
                    _Pragma("unroll") for (int k = 0; k < 32; ++k) x[k] = p[(size_t)(n0 + k) * 8192]; \
                    _Pragma("unroll") for (int k = 0; k < 32; ++k) { p[(size_t)(n0 + k) * 8192] = st; st = cd * st + x[k]; } } } \
            { const int idx = (G >= 128) ? (bx >= 128 ? bx - 128 : bx + G - 128) : bx; \
              for (int u = idx; u < 4; u += G) {                    \
                const int gid = u * 512 + tid, b = gid >> 10, gp = gid & 1023; \
                const float* sp = (const float*)(ws + WS_SSM + (size_t)layer * SSM_LAYER_BYTES); const float ar = sp[SSM_ABARL / 4 + 2 * gp], ai = sp[SSM_ABARL / 4 + 2 * gp + 1]; \
                float* p = (float*)(ws + WS_SST) + ((size_t)b * 128 * 1024 + gp) * 2; float cr = 0.f, ci = 0.f; \
                for (int c0 = 0; c0 < 128; c0 += 32) { f32x2_t xv[32]; \
                    _Pragma("unroll") for (int k = 0; k < 32; ++k) xv[k] = *(const f32x2_t*)(p + (size_t)(c0 + k) * 2048); \
                    _Pragma("unroll") for (int k = 0; k < 32; ++k) { f32x2_t o_; o_.x = cr; o_.y = ci; *(f32x2_t*)(p + (size_t)(c0 + k) * 2048) = o_; const float nr = ar * cr - ai * ci + xv[k].x, ni = ar * ci + ai * cr + xv[k].y; cr = nr; ci = ni; } } } } \
            { PHASE_IDS; \
              if (G == 256) { const int na = bx < 128 ? 5 : 7; const int bx_ = bx; \
                  attn_run(args, (LAS char*)lds, na, [bx_](int k) { return (k < 6) ? bx_ + 256 * k : (bx_ - 128) + 1280; }, tid); } \
              else { const int bx_ = bx, G_ = G; attn_run(args, (LAS char*)lds, (1536 - bx + G - 1) / G, [bx_, G_](int k) { return bx_ + G_ * k; }, tid); } } \
            SEAM(base + 2); \
        } \
         \
        if (EN_M3 && IN(base + 3)) { \
          const int og_ = ORDER_SPLIT ? ((bx >> 3) & 1) : 0; \
          _Pragma("unroll 1") for (int s_ = 0; s_ < 3; ++s_) { const int part_ = og_ ? 2 - s_ : s_; \
           if (part_ == 0) { PHASE_IDS; \
            { const bf16* attp = (const bf16*)(ws + WS_ATTP); const float* lse = (const float*)(ws + WS_LSE); const int h = lane >> 4, sub = lane & 15; \
              for (int rep_ = 0; rep_ < THIN_REPS; ++rep_) for (int t0 = gw; t0 < T; t0 += 4 * NGW) { \
                float ls[4][3]; v2u ow[4][3]; \
                _Pragma("unroll") for (int r = 0; r < 4; ++r) { const int t = t0 + r * NGW; if (t < T) { \
                    _Pragma("unroll") for (int p = 0; p < 3; ++p) { ls[r][p] = lse[((size_t)p * T + t) * 4 + h]; ow[r][p] = *(const v2u*)(attp + ((size_t)p * T + t) * 256 + h * 64 + sub * 4); } } } \
                _Pragma("unroll") for (int r = 0; r < 4; ++r) { const int t = t0 + r * NGW; if (t < T) { \
                    const float M = fmaxf(ls[r][0], fmaxf(ls[r][1], ls[r][2])); const float w0 = __expf(ls[r][0] - M), w1 = __expf(ls[r][1] - M), w2 = __expf(ls[r][2] - M); const float iw = 1.0f / (w0 + w1 + w2); \
                    const float r0 = (w0 * bflo(ow[r][0].x) + w1 * bflo(ow[r][1].x) + w2 * bflo(ow[r][2].x)) * iw, r1 = (w0 * bfhi(ow[r][0].x) + w1 * bfhi(ow[r][1].x) + w2 * bfhi(ow[r][2].x)) * iw; \
                    const float r2 = (w0 * bflo(ow[r][0].y) + w1 * bflo(ow[r][1].y) + w2 * bflo(ow[r][2].y)) * iw, r3 = (w0 * bfhi(ow[r][0].y) + w1 * bfhi(ow[r][1].y) + w2 * bfhi(ow[r][2].y)) * iw; \
                    v2u w; w.x = pk2(r0, r1); w.y = pk2(r2, r3); *(v2u*)(XN + (size_t)t * DM + h * 64 + sub * 4) = w; } } } } \
           } else if (part_ == 1) { \
            for (int rep_ = 0; rep_ < RO_REPS; ++rep_) { PHASE_IDS; const int bx_ = bx, G_ = G; ret_out_run(args, (LAS char*)lds, layer, (1024 - bx + G - 1) / G, [bx_, G_](int k) { return bx_ + G_ * k; }, tid); } \
           } else { \
            { PHASE_IDS; TST_SO(for (int u = bx; u < 256; u += G) ssm_out_unit(args, (LAS char*)lds, layer, u, tid);) } \
            PROBE_SO({ PHASE_IDS; for (int u = bx; u < 256; u += G) ssm_out_unit<SO_PARTS>(args, (LAS char*)lds, layer, u, tid); }) \
           } \
           __syncthreads(); } \
            SEAM(base + 3); \
        } \
         \
        if (EN_WOUT && IN(base + 4)) { \
              \
            const int cgrp = (bx >> 3) & 1; \
            if (CONV_IN_WOUT && layer == 1 && cgrp == 0) { PHASE_IDS; MOE_CONV(); __syncthreads(); } \
            { PHASE_IDS; \
            pg8::Gemm g{XN, (const bf16*)(ws + WS_WOUT) + (size_t)layer * DM * DM, T, DM, DM, DM}; pg8::StaticOrder S; S.init(T, DM, G, bx); \
            for (int rep_ = 0; rep_ < WOUT_REPS; ++rep_) { pg8::EpiResF32 E{(layer == 0 && rep_ == 0) ? args.in(I_X) : args.out(), args.out(), DM, rep_ == WOUT_REPS - 1 ? 1.0f : 0.0f, layer == 0 ? (bf16*)(ws + WS_XN2) : (bf16*)nullptr, args.in(I_N2G), (float*)(ws + WS_SSQ)}; \
            pg8::gemm_phase<pg8::EpiResF32, pg8::StaticOrder, true, true, false>(L3, g, S, E, tid); } } \
            if (CONV_IN_WOUT && layer == 1 && cgrp == 1) { PHASE_IDS; __syncthreads(); MOE_CONV(); } \
            SEAM(base + 4); \
        } \
         \
        if (EN_N2 && layer == 1 && IN(base + 5)) { PHASE_IDS; \
            const float* g2 = args.in(I_N2G) + layer * DM; \
            if (layer == 1) { \
                int* sel_e = (int*)(L + 140000); float* sel_g = (float*)(L + 141024); int* lpair = (int*)(L + 142176); int* lpbase = (int*)(L + 142432); \
                float rw[16][8]; \
        _Pragma("unroll") \
                for (int j = 0; j < 4; ++j) \
        _Pragma("unroll") \
                    for (int c = 0; c < 4; ++c) { const f32x4* rp = (const f32x4*)(args.in(I_RT) + (size_t)(4 * lane + c + 256 * j) * 8); const f32x4 r0 = rp[0], r1 = rp[1]; \
                        rw[j * 4 + c][0] = r0.x; rw[j * 4 + c][1] = r0.y; rw[j * 4 + c][2] = r0.z; rw[j * 4 + c][3] = r0.w; rw[j * 4 + c][4] = r1.x; rw[j * 4 + c][5] = r1.y; rw[j * 4 + c][6] = r1.z; rw[j * 4 + c][7] = r1.w; } \
                f32x4 gg2[4]; \
                _Pragma("unroll") for (int j = 0; j < 4; ++j) gg2[j] = ((const f32x4*)g2)[lane + 64 * j]; \
                for (int u = bx; u < T / 128; u += G) { \
                    if (tid < 64) lpair[tid] = 0; \
                    for (int rr = 0; rr < 16; rr += 2) { f32x4 v[2][4]; \
                        _Pragma("unroll") for (int q_ = 0; q_ < 2; ++q_) { const int m = u * 128 + wave * 16 + rr + q_; \
                            _Pragma("unroll") for (int j = 0; j < 4; ++j) v[q_][j] = ((const f32x4*)(args.out() + (size_t)m * DM))[lane + 64 * j]; } \
                        _Pragma("unroll") for (int q_ = 0; q_ < 2; ++q_) { const int rl = wave * 16 + rr + q_, m = u * 128 + rl; float ss = 0.f; \
                            _Pragma("unroll") for (int j = 0; j < 4; ++j) ss += (v[q_][j].x * v[q_][j].x + v[q_][j].y * v[q_][j].y) + (v[q_][j].z * v[q_][j].z + v[q_][j].w * v[q_][j].w); \
                            const float rs = rsqrtf(wave_sum(ss) * (1.f / DM) + 1e-6f); \
                            _Pragma("unroll") for (int j = 0; j < 4; ++j) { v[q_][j] = v[q_][j] * rs * gg2[j]; ((unsigned*)((unsigned char*)XN + (size_t)m * DM))[lane + 64 * j] = pg8::pk4_fp8(v[q_][j].x, v[q_][j].y, v[q_][j].z, v[q_][j].w); } \
                            float pl[8]; \
                            _Pragma("unroll") for (int e = 0; e < 8; ++e) { float s = 0.f; \
                                _Pragma("unroll") for (int j = 0; j < 4; ++j) s += v[q_][j].x * rw[j * 4 + 0][e] + v[q_][j].y * rw[j * 4 + 1][e] + v[q_][j].z * rw[j * 4 + 2][e] + v[q_][j].w * rw[j * 4 + 3][e]; \
                                pl[e] = s; } \
                            const bool b5 = (lane & 32) != 0, b4 = (lane & 16) != 0, b3 = (lane & 8) != 0; float w4[4], w2[2], w1; \
                            _Pragma("unroll") for (int k = 0; k < 4; ++k) { const float send = b5 ? pl[k] : pl[k + 4], keep = b5 ? pl[k + 4] : pl[k]; w4[k] = keep + __shfl_xor(send, 32); } \
                            _Pragma("unroll") for (int k = 0; k < 2; ++k) { const float send = b4 ? w4[k] : w4[k + 2], keep = b4 ? w4[k + 2] : w4[k]; w2[k] = keep + __shfl_xor(send, 16); } \
                            { const float send = b3 ? w2[0] : w2[1], keep = b3 ? w2[1] : w2[0]; w1 = keep + __shfl_xor(send, 8); } \
                            w1 += __shfl_xor(w1, 4); w1 += __shfl_xor(w1, 2); w1 += __shfl_xor(w1, 1); \
                            float lg[8]; \
                            _Pragma("unroll") for (int e = 0; e < 8; ++e) lg[e] = __builtin_bit_cast(float, __builtin_amdgcn_readlane(__builtin_bit_cast(int, w1), 8 * e)); \
                            int e0 = 0; float l0 = lg[0]; \
                            _Pragma("unroll") for (int e = 1; e < 8; ++e) if (lg[e] > l0) { l0 = lg[e]; e0 = e; } \
                            int e1 = -1; float l1 = -INFINITY; \
                            _Pragma("unroll") for (int e = 0; e < 8; ++e) if (e != e0 && lg[e] > l1) { l1 = lg[e]; e1 = e; } \
                            const float g0 = 1.0f / (1.0f + __expf(l1 - l0)); \
                            if (lane == 0) { sel_e[rl * 2] = e0; sel_e[rl * 2 + 1] = e1; sel_g[rl * 2] = g0; sel_g[rl * 2 + 1] = 1.0f - g0; } } } \
                    __syncthreads(); \
                    int pr = 0, ppos = 0; \
                    if (tid < 128) { pr = sel_e[tid * 2] * 8 + sel_e[tid * 2 + 1]; ppos = atomicAdd(&lpair[pr], 1); } \
                    __syncthreads(); \
                    if (tid < 64) lpbase[tid] = (int)__hip_atomic_fetch_add(ctl + CW_PAIRCNT + tid, (unsigned)lpair[tid], __ATOMIC_RELAXED, __HIP_MEMORY_SCOPE_AGENT); \
                    __syncthreads(); \
                    if (tid < 128) { v4u ti; ti.x = (unsigned)(sel_e[tid * 2] | (sel_e[tid * 2 + 1] << 8)); ti.y = (unsigned)(lpbase[pr] + ppos); ti.z = __float_as_uint(sel_g[tid * 2]); ti.w = __float_as_uint(sel_g[tid * 2 + 1]); \
                        ((v4u*)(ws + WS_TOKINFO))[u * 128 + tid] = ti; } \
                    __syncthreads(); \
                } \
                if (!CONV_IN_WOUT) { MOE_CONV(); } \
            } \
            SEAM(base + 5); \
        } \
        if (layer == 1 && IN(base + 6)) { PHASE_IDS; \
            int* sel_e = (int*)(L + 140000); float* sel_g = (float*)(L + 141024); int* lcnt = (int*)(L + 142048); int* lbase = (int*)(L + 142112); int* fl = (int*)(L + 142688); int* pc = (int*)(L + 142944); int* pa = (int*)(L + 143200); \
            int* tokmap = (int*)(ws + WS_MAPS); float* gatemap = (float*)(ws + WS_MAPS + 2 * MiB); \
            if (tid < 64) { pc[tid] = (int)__hip_atomic_load(ctl + CW_PAIRCNT + tid, __ATOMIC_RELAXED, __HIP_MEMORY_SCOPE_AGENT); fl[tid] = 0; } \
            __syncthreads(); \
            if (tid == 0) { int rsum = 0; \
                for (int i = 0; i < 8; ++i) { int a_ = 0; for (int j = 0; j < 8; ++j) a_ += pc[i * 8 + j]; pa[i] = a_; pa[8 + i] = a_ & 255; pa[16 + i] = -(a_ & 255); rsum += a_ & 255; } \
                for (int m_ = rsum >> 8; m_ > 0; --m_) { int best = -1, bv = -1; for (int i = 0; i < 8; ++i) if (pa[16 + i] <= 0 && pa[8 + i] > bv) { bv = pa[8 + i]; best = i; } if (best >= 0) pa[16 + best] = 256 - pa[8 + best]; } \
                for (int i = 0; i < 8; ++i) if (pa[16 + i] < 0) { int s_ = -pa[16 + i]; \
                    for (int j = 0; j < 8 && s_ > 0; ++j) if (j != i && pa[16 + j] > 0) { int x_ = s_ < pa[16 + j] ? s_ : pa[16 + j]; if (x_ > pc[i * 8 + j]) x_ = pc[i * 8 + j]; fl[i * 8 + j] = x_; s_ -= x_; pa[16 + j] -= x_; } } } \
            __syncthreads(); \
            for (int u = bx; u < T / 128; u += G) { \
                if (tid < 16) lcnt[tid] = 0; \
                if (tid < 128) { const v4u ti = ((const v4u*)(ws + WS_TOKINFO))[u * 128 + tid]; const int e0 = (int)(ti.x & 255u), e1 = (int)((ti.x >> 8) & 255u); const bool flip = (int)ti.y < fl[e0 * 8 + e1]; \
                    sel_e[tid * 2] = flip ? e1 : e0; sel_e[tid * 2 + 1] = flip ? e0 : e1; sel_g[tid * 2] = __uint_as_float(flip ? ti.w : ti.z); sel_g[tid * 2 + 1] = __uint_as_float(flip ? ti.z : ti.w); } \
                __syncthreads(); \
                int e = 0, posv = 0; const int rl = tid >> 1, r = tid & 1; \
                if (tid < 256) { e = sel_e[rl * 2 + r]; posv = atomicAdd(&lcnt[r * 8 + e], 1); } \
                __syncthreads(); \
                if (tid < 16) lbase[tid] = (int)__hip_atomic_fetch_add(ctl + CW_MOECNT + tid, (unsigned)lcnt[tid], __ATOMIC_RELAXED, __HIP_MEMORY_SCOPE_AGENT); \
                __syncthreads(); \
                if (tid < 256) { const int slot = lbase[r * 8 + e] + posv; tokmap[(size_t)(r * 8 + e) * 32768 + slot] = u * 128 + rl; gatemap[(size_t)(r * 8 + e) * 32768 + slot] = sel_g[rl * 2 + r]; } \
                __syncthreads(); \
            } \
            SEAM(base + 6); \
        } \
        if (layer == 0) { \
             \
            if (EN_FUP && IN(base + 6)) { PHASE_IDS; \
                pg8::Gemm g{(const bf16*)(ws + WS_XN2), (const bf16*)(ws + WS_FGU), T, 2 * DFF, DM, DM}; pg8::StaticOrder S; S.init(T, 2 * DFF, G, bx); \
                LAS float* RS = (LAS float*)((LAS char*)lds + 132096); build_rs(RS, S, (const float*)(ws + WS_SSQ), tid); \
                pg8::EpiSwiGLU E{(bf16*)(ws + WS_ACT), DFF, RS}; \
                for (int rep_ = 0; rep_ < FUP_REPS; ++rep_) pg8::gemm_phase<pg8::EpiSwiGLU, pg8::StaticOrder, true, true, false>(L3, g, S, E, tid); \
                SEAM(base + 6); \
            } \
            if (EN_FDN && IN(base + 7)) { PHASE_IDS; \
                pg8::Gemm g{(const bf16*)(ws + WS_ACT), (const bf16*)(ws + WS_FDN), T, DM, DFF, DFF}; pg8::StaticOrder S; S.init(T, DM, G, bx); \
                for (int rep_ = 0; rep_ < FDN_REPS; ++rep_) { pg8::EpiResF32 E{args.out(), args.out(), DM, rep_ == FDN_REPS - 1 ? 1.0f : 0.0f, (bf16*)(ws + WS_XN2), args.in(I_N1G) + DM, (float*)(ws + WS_SSQ)}; \
                pg8::gemm_phase<pg8::EpiResF32, pg8::StaticOrder, true, true, false>(L3, g, S, E, tid); } \
                SEAM(base + 7); \
            } \
        } else { \
             \
          \
        const int mgrp = (bx >> 3) & 1; \
        _Pragma("unroll 1") \
            for (int st = 0; st < 4; ++st) { \
                const bool is_up = (st == 0) || (st == 1 && mgrp == 0) || (st == 2 && mgrp == 1); const int r = (st == 0) ? 0 : (st == 3) ? 1 : (is_up ? 1 : 0); \
                const int* tokmap = (const int*)(ws + WS_MAPS) + (size_t)r * 8 * 32768; const float* gatemap = (const float*)(ws + WS_MAPS + 2 * MiB) + (size_t)r * 8 * 32768; \
                unsigned char* mact = ws + (r == 0 ? WS_MACT : WS_MACT2); \
                if (is_up) { if (EN_MUP && IN(base + 7)) { PHASE_IDS; \
                    pg8::Gemm g{XN, (const bf16*)(ws + WS_MGU), 0, 2 * DFE, DM, DM}; pg8::MoeOrder S; S.init_moe(ctl + CW_MOECNT + r * 8, tokmap, 2 * DFE, G, bx); S.build_ltab((LAS int*)((LAS char*)lds + 132096), tid); \
                    pg8::EpiSwiGLU8 E{mact, DFE, 1.0f / 32.0f, 4.0f}; \
                    for (int rep_ = 0; rep_ < MUP_REPS; ++rep_) pg8::gemm_phase<pg8::EpiSwiGLU8, pg8::MoeOrder, true, true, true, true>(L3, g, S, E, tid); \
                } } else { if (EN_MDN && IN(base + 7)) { PHASE_IDS; \
                    pg8::Gemm g{(const bf16*)mact, (const bf16*)(ws + WS_MDN), 0, DM, DFE, DFE}; pg8::MoeOrder S; S.init_moe(ctl + CW_MOECNT + r * 8, tokmap, DM, G, bx, r == 1 ? 128 : (1 << 20)); \
                    for (int rep_ = 0; rep_ < MDN_REPS; ++rep_) { MDN_EPI E{args.out(), DM, tokmap, gatemap, rep_ == MDN_REPS - 1 ? (1.0f / 256.0f) : 0.0f}; \
                    pg8::gemm_phase<MDN_EPI, pg8::MoeOrder, true, true, false, true>(L3, g, S, E, tid); } \
                    if (r == 1) { pg8::MoeOrder SA; SA.init_moe(ctl + CW_MOECNT + r * 8, tokmap, DM, G, bx); const int ntl = (SA.tiles() - 128) * 4; const int KS = ntl <= 18 ? 14 : 7;     \
                      pg8::MoeTailOrder ST; ST.init(&SA, G, bx, KS, DFE / KS, 32); \
                      pg8::Gemm gt{(const bf16*)mact, (const bf16*)(ws + WS_MDN), 0, DM, DFE / KS, DFE}; pg8::EpiPart EP{(float*)(ws + WS_XN)}; \
                      pg8::gemm_phase<pg8::EpiPart, pg8::MoeTailOrder, true, true, false, true>(L3, gt, ST, EP, tid); } \
                } } \
                __syncthreads(); \
                if (st != 1) SEAM(base + 7 + st); \
            } \
            { const int r = 1; const int* tokmap = (const int*)(ws + WS_MAPS) + (size_t)r * 8 * 32768; const float* gatemap = (const float*)(ws + WS_MAPS + 2 * MiB) + (size_t)r * 8 * 32768; \
                if (EN_MDN && IN(base + 12)) { PHASE_IDS; \
                    pg8::MoeOrder SA; SA.init_moe(ctl + CW_MOECNT + r * 8, tokmap, DM, G, bx); int ntl = (SA.tiles() - 128) * 4; ntl = ntl < 0 ? 0 : (ntl > 32 ? 32 : ntl); const int KS = ntl <= 18 ? 14 : 7; \
                    const float* part = (const float*)(ws + WS_XN); float* outp = args.out(); \
                    for (int gi = bx * 512 + tid; gi < ntl * 16384; gi += G * 512) { const int t = gi >> 14, row = (gi >> 6) & 255, c4 = gi & 63; \
                        pg8::Unit u; u.pm = 128 + (t >> 2); u.pn = t & 3; SA.decode(u); const int slot = u.r0 + row; \
                        if (slot < u.cn) { const int tk = tokmap[u.e * 32768 + slot]; const float gt_ = gatemap[u.e * 32768 + slot]; \
                            f32x4 s = (f32x4){0.f, 0.f, 0.f, 0.f}; \
                            for (int ks = 0; ks < KS; ++ks) s = s + *(const f32x4*)(part + (size_t)(t * KS + ks) * 65536 + row * 256 + c4 * 4); \
                            float* op = outp + (size_t)tk * DM + u.pn * 256 + c4 * 4; *(f32x4*)op = *(const f32x4*)op + s * (gt_ * (1.0f / 256.0f)); } } \
                    SEAM(base + 12); \
                } \
            } \
        } \
    } while (0)
    LAYER_BODY(0);
    LAYER_BODY(1);
#undef LAYER_BODY
#undef IN
#undef SEAM
}

extern "C" void kernel_launch(void* const* d_in, const int* in_sizes, int n_in, void* d_out, int out_size, void* d_ws, size_t ws_size, hipStream_t stream) {
    static int grid = 0;
    if (grid == 0) {
        if (n_in != 25 || in_sizes[0] != T * DM || out_size != T * DM || ws_size < WS_END) { fprintf(stderr, "kernel_launch: unexpected shapes (n_in %d, in0 %d, out %d, ws %zu); nothing launched\n", n_in, n_in > 0 ? in_sizes[0] : -1, out_size, ws_size); grid = -1; return; }
        int dev = 0, cus = 0, per_cu = 0;
        if (hipGetDevice(&dev) != hipSuccess || hipDeviceGetAttribute(&cus, hipDeviceAttributeMultiprocessorCount, dev) != hipSuccess) { grid = -1; return; }
        if (hipFuncSetAttribute((const void*)fwd_kernel, hipFuncAttributeMaxDynamicSharedMemorySize, LDS_BYTES) != hipSuccess) { fprintf(stderr, "kernel_launch: hipFuncSetAttribute failed\n"); grid = -1; return; }
        if (hipOccupancyMaxActiveBlocksPerMultiprocessor(&per_cu, (const void*)fwd_kernel, NWAVES * 64, LDS_BYTES) != hipSuccess || per_cu < 1) { fprintf(stderr, "kernel_launch: occupancy query reports %d blocks per CU\n", per_cu); }
        (void)hipGetLastError();
        grid = cus;
    }
    if (grid < 0) return;
    (void)hipMemsetAsync((char*)d_ws + WS_CTL, 0, CTL_ZERO_BYTES, stream);
    Args a{};
    for (int i = 0; i < 25; ++i) a.in[i] = (const float*)d_in[i];
    a.out = (float*)d_out; a.ws = (unsigned char*)d_ws;
#ifdef PRE_PH_HI
    a.ph_lo = 0; a.ph_hi = PRE_PH_HI; hipLaunchKernelGGL(fwd_kernel, dim3(grid), dim3(NWAVES * 64), LDS_BYTES, stream, a);
    (void)hipMemsetAsync((char*)d_ws + WS_CTL, 0, CTL_ZERO_BYTES, stream);
#endif
#if MK_PER_PHASE
    for (int p = 0; p < NPH; ++p) { if (p == PH_L0 + 6 + 3 || p == PH_L0 + 6 + 4) continue; a.ph_lo = p; a.ph_hi = p + 1; hipLaunchKernelGGL(fwd_kernel, dim3(grid), dim3(NWAVES * 64), LDS_BYTES, stream, a); }
#else
    a.ph_lo = 0; a.ph_hi = NPH; hipLaunchKernelGGL(fwd_kernel, dim3(grid), dim3(NWAVES * 64), LDS_BYTES, stream, a);
#ifdef EXTRA_PH_HI
    (void)hipMemsetAsync((char*)d_ws + WS_CTL, 0, CTL_ZERO_BYTES, stream); a.ph_lo = 0; a.ph_hi = EXTRA_PH_HI; hipLaunchKernelGGL(fwd_kernel, dim3(grid), dim3(NWAVES * 64), LDS_BYTES, stream, a);
#endif
#endif
}
```

```cpp
#include <hip/hip_runtime.h>
#include <cstdio>
#include <cstdint>
namespace pg8 {
#define PG8_LAS __attribute__((address_space(3)))
typedef unsigned short bf16_t;
typedef short bf16x8 __attribute__((ext_vector_type(8)));
typedef float f32x4 __attribute__((ext_vector_type(4)));
typedef unsigned u32x4 __attribute__((ext_vector_type(4)));
typedef int i32x4 __attribute__((ext_vector_type(4)));
constexpr int BM = 256, BK = 64, HALF = 128, HTB = HALF * BK * 2  , STAGE_BYTES = 8 * HTB, NXCD = 8, WGM = 8;

__host__ __device__ __forceinline__ int lds_byte(int r, int c) { const int st = (r >> 4) * 2 + (c >> 5), rr = r & 15, cc = c & 31, ob = rr * 64 + cc * 2; return st * 1024 + (ob ^ (((ob >> 9) & 1) << 5)); }
__host__ __device__ __forceinline__ void stage_rc(int b, int& R, int& C) { const int st = b / 1024, sb = b % 1024, swz = sb ^ (((sb >> 9) & 1) << 5); R = (st >> 1) * 16 + swz / 64; C = (st & 1) * 32 + (swz % 64) / 2; }
__host__ __device__ __forceinline__ int perm32(int rho) { const int n = rho >> 4, i = rho & 15; return 8 * (i >> 2) + 4 * n + (i & 3); }

struct Unit { int pm, pn, pb, e, r0, cn, koff, aux; };
struct Gemm { const bf16_t* A; const bf16_t* Bt; int M, N, K, ld; };

struct StaticOrder {
    int nM, nN, nwg, G, c;
    __host__ __device__ void init(int M, int N, int G_, int c_) { nM = M / BM; nN = N / BM; nwg = nM * nN; G = G_; c = c_; }
    __host__ __device__ bool next(int i, Unit& u) const {
        const long L = (long)i * G + c; if (L >= nwg) return false;
        int wgid = (int)L; { const int q = nwg / NXCD, r = nwg % NXCD, xcd = wgid % NXCD, off = wgid / NXCD; wgid = (xcd < r ? xcd * (q + 1) : r * (q + 1) + (xcd - r) * q) + off; }
        const int nig = WGM * nN, gid = wgid / nig, fm = gid * WGM, gsz = (nM - fm) < WGM ? (nM - fm) : WGM;
        u.pm = fm + ((wgid % nig) % gsz); u.pn = (wgid % nig) / gsz; u.pb = u.pn; u.e = 0; u.r0 = 0; u.cn = 0; u.koff = 0; u.aux = 0; return true;
    }
    __device__ __forceinline__ void a_ready(const Unit&) const {}
    __device__ __forceinline__ void done(const Unit&) const {}
    __device__ __forceinline__ int arow(const Unit&, int) const { return 0; }
};

__device__ __forceinline__ unsigned cvt_pk_bf16(float lo, float hi) { unsigned r; asm volatile("v_cvt_pk_bf16_f32 %0, %1, %2" : "=v"(r) : "v"(lo), "v"(hi)); return r; }

template <class Epi, class Sched, bool ALIGN_EPI = false, bool SP2 = false, bool GATHER = false, bool FP8 = false>
__device__ __forceinline__ void gemm_phase(PG8_LAS unsigned char* lds, const Gemm g, const Sched& S, const Epi& E, int tid) {
    asm volatile("" : "+v"(tid));
    const int wid = __builtin_amdgcn_readfirstlane(tid >> 6), lane = tid & 63, wr = wid >> 2, wc = wid & 3, fr = lane & 15, fq = lane >> 4;
    constexpr int ES = FP8 ? 1 : 2;
    const int K = g.ld, nt = (g.K * ES) / (BK * 2);
    unsigned voffA[2][2], voffN[2][2], voffB[2];
    const size_t kstep = (size_t)(BK * 2);
    const size_t hstep = (size_t)HALF * K * ES;
    const size_t tstep = 2 * hstep;
#pragma unroll
    for (int i = 0; i < 2; ++i) { int R, C; stage_rc(tid * 16 + i * 8192, R, C); const int Rb = Epi::PERM ? ((R & ~31) + perm32(R & 31)) : R;
        voffA[0][i] = (unsigned)(R * K * ES + C * 2); voffA[1][i] = voffA[0][i]; voffN[0][i] = voffA[0][i]; voffN[1][i] = voffA[0][i]; voffB[i] = (unsigned)(Rb * K * ES + C * 2); }
    const unsigned ldsw = (unsigned)wid * 1024u;
    const int aoff = lds_byte(wr * 64 + fr, fq * 8), boff = lds_byte(wc * 32 + fr, fq * 8);
#define PG8_SA(b, h) (((b) * 2 + (h)) * HTB)
#define PG8_SB(b, h) ((4 + (b) * 2 + (h)) * HTB)
#define PG8_STAGE(bufoff, gbase, voff) do { _Pragma("unroll") for (int _i = 0; _i < 2; ++_i) \
        __builtin_amdgcn_global_load_lds((const unsigned*)((const char*)(gbase) + (voff)[_i]), (PG8_LAS unsigned*)(lds + (bufoff) + ldsw + _i * 8192), 16, 0, 0); } while (0)
#define PG8_CAT8(x0, x1) __builtin_shufflevector(__builtin_bit_cast(i32x4, (x0)), __builtin_bit_cast(i32x4, (x1)), 0, 1, 2, 3, 4, 5, 6, 7)
#define PG8_STAGE_A(bufoff, gbase, h) do { if constexpr (GATHER) { PG8_STAGE(bufoff, gbase, voffA[h]); } else { PG8_STAGE(bufoff, (gbase) + (h) * hstep, voffA[0]); } } while (0)
#define PG8_LDA(dst, b, h) do { _Pragma("unroll") for (int m = 0; m < 4; ++m) { \
        if constexpr (FP8) { dst##8[m] = PG8_CAT8(*(const PG8_LAS bf16x8*)(lds + PG8_SA(b, h) + aoff + m * 2048), *(const PG8_LAS bf16x8*)(lds + PG8_SA(b, h) + aoff + m * 2048 + 1024)); } \
        else { _Pragma("unroll") for (int k = 0; k < 2; ++k) dst[m][k] = *(const PG8_LAS bf16x8*)(lds + PG8_SA(b, h) + aoff + m * 2048 + k * 1024); } } } while (0)
#define PG8_LDB(dst, b, h) do { _Pragma("unroll") for (int n = 0; n < 2; ++n) { \
        if constexpr (FP8) { dst##8[n] = PG8_CAT8(*(const PG8_LAS bf16x8*)(lds + PG8_SB(b, h) + boff + n * 2048), *(const PG8_LAS bf16x8*)(lds + PG8_SB(b, h) + boff + n * 2048 + 1024)); } \
        else { _Pragma("unroll") for (int k = 0; k < 2; ++k) dst[n][k] = *(const PG8_LAS bf16x8*)(lds + PG8_SB(b, h) + boff + n * 2048 + k * 1024); } } } while (0)
#define PG8_MMA(ai, bj, At, Bt) do { __builtin_amdgcn_s_setprio(1); \
        if constexpr (FP8) { _Pragma("unroll") for (int m = 0; m < 4; ++m) _Pragma("unroll") for (int n = 0; n < 2; ++n) \
            asm volatile("v_mfma_scale_f32_16x16x128_f8f6f4 %0, %1, %2, %0, %3, %3 op_sel_hi:[0,0,0]" : "+v"(acc[ai][bj][m][n]) : "v"(Bt##8[n]), "v"(At##8[m]), "v"(sc127)); } \
        else { _Pragma("unroll") for (int m = 0; m < 4; ++m) _Pragma("unroll") for (int n = 0; n < 2; ++n) _Pragma("unroll") for (int k = 0; k < 2; ++k) \
            acc[ai][bj][m][n] = __builtin_amdgcn_mfma_f32_16x16x32_bf16(Bt[n][k], At[m][k], acc[ai][bj][m][n], 0, 0, 0); } \
        __builtin_amdgcn_s_setprio(0); } while (0)
#define PG8_WAIT_V(n) asm volatile("s_waitcnt vmcnt(" #n ")" ::: "memory")
#define PG8_WAIT_L(n) asm volatile("s_waitcnt lgkmcnt(" #n ")" ::: "memory")
#define PG8_BAR __builtin_amdgcn_s_barrier()
#define PG8_SCHED __builtin_amdgcn_sched_barrier(0)
#define PG8_GOFF(vo, u) do { if constexpr (GATHER) { _Pragma("unroll") for (int _h = 0; _h < 2; ++_h) _Pragma("unroll") for (int _i = 0; _i < 2; ++_i) \
        { int _R, _C; stage_rc(tid * 16 + _i * 8192, _R, _C); vo[_h][_i] = (unsigned)S.arow((u), _h * HALF + _R) * (unsigned)(K * ES) + (unsigned)_C * 2u; } } } while (0)
    Unit cur, nxt; int ui = 0;
    if (!S.next(0, cur)) return;
    f32x4 acc[2][2][4][2];
#pragma unroll
    for (int a = 0; a < 2; ++a)
#pragma unroll
        for (int b = 0; b < 2; ++b)
#pragma unroll
            for (int m = 0; m < 4; ++m)
#pragma unroll
                for (int n = 0; n < 2; ++n) acc[a][b][m][n] = (f32x4){0.f, 0.f, 0.f, 0.f};
    bf16x8 At[4][2], B0[2][2], B1[2][2];
    typedef int i32x8 __attribute__((ext_vector_type(8))); i32x8 At8[4], B08[2], B18[2]; int sc127 = 127; asm volatile("" : "+v"(sc127));
    const char* cA = (const char*)g.A + (GATHER ? (size_t)0 : (size_t)cur.pm * tstep) + (size_t)cur.koff * ES; const char* cB = (const char*)g.Bt + (size_t)cur.pb * tstep + (size_t)cur.koff * ES;
    S.a_ready(cur);
    PG8_GOFF(voffA, cur);
    if constexpr (SP2) {
        PG8_STAGE(PG8_SB(0, 0), cB, voffB); PG8_STAGE(PG8_SB(0, 1), cB + hstep, voffB); PG8_STAGE_A(PG8_SA(0, 0), cA, 0); PG8_STAGE_A(PG8_SA(0, 1), cA, 1);
        if (wr == 1) PG8_BAR;
        PG8_WAIT_V(2); PG8_BAR;
        PG8_STAGE(PG8_SB(1, 0), cB + kstep, voffB); PG8_STAGE_A(PG8_SA(1, 0), cA + kstep, 0); PG8_STAGE(PG8_SB(1, 1), cB + hstep + kstep, voffB);
        PG8_WAIT_V(6); PG8_BAR;
    } else {
        PG8_STAGE(PG8_SB(0, 0), cB, voffB); PG8_STAGE_A(PG8_SA(0, 0), cA, 0); PG8_STAGE(PG8_SB(0, 1), cB + hstep, voffB); PG8_STAGE_A(PG8_SA(0, 1), cA, 1);
        if (wr == 1) PG8_BAR;
        PG8_WAIT_V(4); PG8_BAR;
        PG8_STAGE(PG8_SB(1, 0), cB + kstep, voffB); PG8_STAGE_A(PG8_SA(1, 0), cA + kstep, 0); PG8_STAGE(PG8_SB(1, 1), cB + hstep + kstep, voffB);
        PG8_WAIT_V(6); PG8_BAR;
    }
    for (;;) {
        const bool has_next = S.next(ui + 1, nxt);
        const char* nA = (has_next && !GATHER) ? (const char*)g.A + (size_t)nxt.pm * tstep + (size_t)nxt.koff * ES : cA; const char* nB = has_next ? (const char*)g.Bt + (size_t)nxt.pb * tstep + (size_t)nxt.koff * ES : cB;
        if constexpr (GATHER) { if (has_next) { PG8_GOFF(voffN, nxt); } else { _Pragma("unroll") for (int _h = 0; _h < 2; ++_h) _Pragma("unroll") for (int _i = 0; _i < 2; ++_i) voffN[_h][_i] = voffA[_h][_i]; } }
        for (int t = 0; t < nt; t += 2) {
            const bool last = (t == nt - 2);
            const char* a1 = cA + (size_t)(t + 1) * kstep;
            const char* a2 = last ? nA : cA + (size_t)(t + 2) * kstep; const char* b2 = last ? nB : cB + (size_t)(t + 2) * kstep;
            const char* a3 = a2 + kstep; const char* b3 = b2 + kstep;
            if (last && has_next) S.a_ready(nxt);
            if constexpr (SP2) {
            PG8_LDB(B0, 0, 0); PG8_LDB(B1, 0, 1); PG8_SCHED; PG8_LDA(At, 0, 0); PG8_STAGE_A(PG8_SA(1, 1), a1, 1);
            if constexpr (GATHER) { if (last) { _Pragma("unroll") for (int _h = 0; _h < 2; ++_h) _Pragma("unroll") for (int _i = 0; _i < 2; ++_i) voffA[_h][_i] = voffN[_h][_i]; } }
            PG8_WAIT_V(8); PG8_WAIT_L(0); PG8_BAR; PG8_MMA(0, 0, At, B0); PG8_MMA(0, 1, At, B1); PG8_BAR; PG8_SCHED;
            PG8_LDA(At, 0, 1); PG8_STAGE(PG8_SB(0, 0), b2, voffB); PG8_STAGE(PG8_SB(0, 1), b2 + hstep, voffB); PG8_STAGE_A(PG8_SA(0, 0), a2, 0);
            PG8_WAIT_V(8); PG8_WAIT_L(0); PG8_BAR; PG8_MMA(1, 0, At, B0); PG8_MMA(1, 1, At, B1); PG8_BAR; PG8_SCHED;
            PG8_LDB(B0, 1, 0); PG8_LDB(B1, 1, 1); PG8_SCHED; PG8_LDA(At, 1, 0); PG8_STAGE_A(PG8_SA(0, 1), a2, 1);
            PG8_WAIT_V(8); PG8_WAIT_L(0); PG8_BAR; PG8_MMA(0, 0, At, B0); PG8_MMA(0, 1, At, B1); PG8_BAR; PG8_SCHED;
            PG8_LDA(At, 1, 1); PG8_STAGE(PG8_SB(1, 0), b3, voffB); PG8_STAGE(PG8_SB(1, 1), b3 + hstep, voffB); PG8_STAGE_A(PG8_SA(1, 0), a3, 0);
            PG8_WAIT_V(8); PG8_WAIT_L(0); PG8_BAR; PG8_MMA(1, 0, At, B0); PG8_MMA(1, 1, At, B1); PG8_BAR; PG8_SCHED;
            } else {
            PG8_LDB(B0, 0, 0); PG8_SCHED; PG8_LDA(At, 0, 0); PG8_STAGE_A(PG8_SA(1, 1), a1, 1);
            if constexpr (GATHER) { if (last) { _Pragma("unroll") for (int _h = 0; _h < 2; ++_h) _Pragma("unroll") for (int _i = 0; _i < 2; ++_i) voffA[_h][_i] = voffN[_h][_i]; } }
            PG8_WAIT_L(8); PG8_BAR; PG8_WAIT_L(0); PG8_MMA(0, 0, At, B0); PG8_BAR; PG8_SCHED;
            PG8_LDB(B1, 0, 1); PG8_STAGE(PG8_SB(0, 0), b2, voffB);
            PG8_BAR; PG8_WAIT_L(0); PG8_MMA(0, 1, At, B1); PG8_BAR;
            PG8_LDA(At, 0, 1); PG8_STAGE_A(PG8_SA(0, 0), a2, 0);
            PG8_BAR; PG8_WAIT_L(0); PG8_MMA(1, 0, At, B0); PG8_BAR; PG8_SCHED;
            PG8_STAGE(PG8_SB(0, 1), b2 + hstep, voffB);
            PG8_WAIT_V(6); PG8_BAR; PG8_MMA(1, 1, At, B1); PG8_BAR;
            PG8_LDB(B0, 1, 0); PG8_SCHED; PG8_LDA(At, 1, 0); PG8_STAGE_A(PG8_SA(0, 1), a2, 1);
            PG8_WAIT_L(8); PG8_BAR; PG8_WAIT_L(0); PG8_MMA(0, 0, At, B0); PG8_BAR; PG8_SCHED;
            PG8_LDB(B1, 1, 1); PG8_STAGE(PG8_SB(1, 0), b3, voffB);
            PG8_BAR; PG8_WAIT_L(0); PG8_MMA(0, 1, At, B1); PG8_BAR;
            PG8_LDA(At, 1, 1); PG8_STAGE_A(PG8_SA(1, 0), a3, 0);
            PG8_BAR; PG8_WAIT_L(0); PG8_MMA(1, 0, At, B0); PG8_BAR; PG8_SCHED;
            PG8_STAGE(PG8_SB(1, 1), b3 + hstep, voffB);
            PG8_WAIT_V(6); PG8_BAR; PG8_MMA(1, 1, At, B1); PG8_BAR;
            }
        }
        if constexpr (FP8) asm volatile("s_nop 15\n\ts_nop 15" ::: "memory");
        if constexpr (ALIGN_EPI) { if (wr == 0) PG8_BAR; }
        E(acc, cur, wr, wc, fr, fq, ui); S.done(cur);
        if (!has_next) break;
#pragma unroll
        for (int a = 0; a < 2; ++a)
#pragma unroll
            for (int b = 0; b < 2; ++b)
#pragma unroll
                for (int m = 0; m < 4; ++m)
#pragma unroll
                    for (int n = 0; n < 2; ++n) acc[a][b][m][n] = (f32x4){0.f, 0.f, 0.f, 0.f};
        cur = nxt; cA = nA; cB = nB; ++ui;
        if constexpr (ALIGN_EPI) { if (wr == 1) PG8_BAR; }
    }
    PG8_WAIT_V(0);
    if constexpr (!ALIGN_EPI) { if (wr == 0) PG8_BAR; }
    PG8_BAR;
#undef PG8_SA
#undef PG8_SB
#undef PG8_STAGE
#undef PG8_STAGE_A
#undef PG8_LDA
#undef PG8_LDB
#undef PG8_MMA
#undef PG8_CAT8
#undef PG8_WAIT_V
#undef PG8_WAIT_L
#undef PG8_BAR
#undef PG8_SCHED
#undef PG8_GOFF
}
}
constexpr int BATCH = 2, SEQ = 16384, T = BATCH * SEQ, DM = 1024, NPROJ = 2560, DFF = 2816, NEXP = 8, DFE = 3584, DEPTH = 2;
constexpr int C_QA = 0, C_KA = 256, C_VA = 512, C_QR = 768, C_KR = 1024, C_VR = 1280, C_GR = 1792, C_US = 2304;
constexpr int NCHUNK = SEQ / 128;
constexpr int NWAVES = 8;
constexpr size_t MiB = 1u << 20;
constexpr size_t WS_CTL = 0, CTL_ZERO_BYTES = 1 * MiB;
constexpr size_t WS_TABA = 1 * MiB;
constexpr size_t WS_TABR = 2 * MiB;
constexpr size_t WS_SSM = 6 * MiB;
constexpr size_t SSM_LAYER_BYTES = 512 * 1024, SSM_ABAR = 0, SSM_ABARL = 8192, SSM_BMT = 16384, SSM_CMT = 81920, SSM_GLWT = 147456;
constexpr size_t WS_MAPS = 8 * MiB;
constexpr size_t WS_TOKINFO = 12 * MiB;
constexpr size_t WS_WIN = 8 * MiB;
constexpr size_t WS_WOUT = 18 * MiB;
constexpr size_t WS_FGU = 22 * MiB;
constexpr size_t WS_FDN = 33 * MiB;
constexpr size_t WS_XN = 40 * MiB;
constexpr size_t WS_PROJ = 104 * MiB;
constexpr size_t WS_ATTP = 264 * MiB;
constexpr size_t WS_LSE = 312 * MiB;
constexpr size_t WS_KV = 314 * MiB;
constexpr size_t WS_SST = 346 * MiB;
constexpr size_t WS_XN2 = 280 * MiB;
constexpr size_t WS_SSQ = 348 * MiB;
constexpr size_t WS_ACT = 104 * MiB;
constexpr size_t WS_MGU = 104 * MiB;
constexpr size_t WS_MDN = 216 * MiB;
constexpr size_t WS_MACT = 272 * MiB;
constexpr size_t WS_MACT2 = 391 * MiB;
constexpr size_t WS_END = 512 * MiB;
static_assert(WS_MACT + (size_t)135 * 256 * DFE <= WS_MACT2 && WS_MACT2 + (size_t)135 * 256 * DFE <= WS_END, "ws map");
constexpr int CW_BAR = 4096;
constexpr int CW_MOECNT = 16384;
constexpr int CW_PAIRCNT = 16384 + 64;
constexpr int SCR_BYTES = 155648;
constexpr int MISC_OFF = SCR_BYTES;
constexpr int LDS_BYTES = 159744;

#define GAS __attribute__((address_space(1)))
#define LAS __attribute__((address_space(3)))
typedef unsigned short bf16;
typedef unsigned v4u __attribute__((ext_vector_type(4)));
typedef unsigned v2u __attribute__((ext_vector_type(2)));
typedef float f32x4 __attribute__((ext_vector_type(4)));
typedef GAS unsigned gu32;
#define RLX_AGENT __ATOMIC_RELAXED, __HIP_MEMORY_SCOPE_AGENT
#define LDS_WAIT() asm volatile("s_waitcnt lgkmcnt(0)" ::: "memory")
#define VM_WAIT() asm volatile("s_waitcnt vmcnt(0)" ::: "memory")
#define DI __device__ __forceinline__
DI unsigned f2bf(float f) { unsigned u = __builtin_bit_cast(unsigned, f); return (u + 0x7fffu + ((u >> 16) & 1u)) >> 16; }
DI unsigned pk2(float lo, float hi) { return f2bf(lo) | (f2bf(hi) << 16); }
DI float bflo(unsigned w) { return __uint_as_float(w << 16); }
DI float bfhi(unsigned w) { return __uint_as_float(w & 0xffff0000u); }
DI float bf2f(bf16 h) { return __uint_as_float((unsigned)h << 16); }
DI float wave_sum(float v) {
#pragma unroll
    for (int o = 1; o < 64; o <<= 1) v += __shfl_xor(v, o);
    return v;
}
DI float sigmoidf_(float x) { return 1.f / (1.f + __expf(-x)); }
template <int CTRL> DI float dpp_f(float v) { return __builtin_bit_cast(float, __builtin_amdgcn_mov_dpp(__builtin_bit_cast(int, v), CTRL, 0xf, 0xf, true)); }
DI float qx1(float v) { return dpp_f<0xB1>(v); }
DI float qx2(float v) { return dpp_f<0x4E>(v); }
template <int P> DI float qbc(float v) { return dpp_f<P * 85>(v); }

#define XB_TMO      128
#define XB_XCNT(j)  (256  + 64 * (j))
#define XB_XSUB(j)  (1280 + 64 * (j))
#define XB_XGEN(j)  (2304 + 64 * (j))
#define XB_TOP      3328
#define XB_TOPGEN   3392
#define XCD_BAR_WORDS 3456
#define XB_SPIN_CAP (1u << 18)
DI unsigned xb_ld(unsigned* p)              { return __hip_atomic_load(p, __ATOMIC_RELAXED, __HIP_MEMORY_SCOPE_AGENT); }
DI unsigned xb_add(unsigned* p, unsigned v) { return __hip_atomic_fetch_add(p, v, __ATOMIC_RELAXED, __HIP_MEMORY_SCOPE_AGENT); }
DI unsigned xb_xcc_id() { return (unsigned)__builtin_amdgcn_s_getreg((3 << 11) | 20) & 0xFu; }
#define XB_SPIN(cond, bar) do { unsigned _sp = 0; while (cond) { __builtin_amdgcn_s_sleep(1); \
    if ((++_sp & 255u) == 0u) { if (xb_ld(&(bar)[XB_TMO])) break; if (_sp > XB_SPIN_CAP) { atomicAdd(&(bar)[XB_TMO], 1u); break; } } } } while (0)
struct XcdBarrier { unsigned* bar; unsigned x; volatile LAS unsigned* st; };
DI XcdBarrier xcd_barrier_post(unsigned* bar, volatile LAS unsigned* st, bool t0) {
    XcdBarrier b; b.bar = bar; b.x = xb_xcc_id(); b.st = st;
    if (t0) (void)xb_add(&bar[XB_XCNT(b.x)], 1u);
    return b;
}
DI void xcd_barrier_complete(unsigned* bar, unsigned x, unsigned& nloc, unsigned& nx) {
    const unsigned G = gridDim.x * gridDim.y * gridDim.z;
    unsigned sum, cnt, mine, sp = 0u;
    for (;;) {
        sum = 0u; cnt = 0u; mine = 0u;
#pragma unroll
        for (unsigned j = 0; j < 16; ++j) { const unsigned c = xb_ld(&bar[XB_XCNT(j)]); sum += c; cnt += (c > 0u) ? 1u : 0u; mine = (j == x) ? c : mine; }
        if (sum == G) break;
        __builtin_amdgcn_s_sleep(1);
        if ((++sp & 255u) == 0u) { if (xb_ld(&bar[XB_TMO])) break; if (sp > XB_SPIN_CAP) { atomicAdd(&bar[XB_TMO], 1u); break; } }
    }
    nloc = mine > 0u ? mine : 1u; nx = cnt > 0u ? cnt : 1u;
}
DI void xcd_barrier(const XcdBarrier& b, bool t0) {
    asm volatile("s_waitcnt vmcnt(0)" ::: "memory");
    __syncthreads();
    if (t0) {
        unsigned* bar = b.bar;
        __builtin_amdgcn_s_waitcnt(0);
        unsigned nloc = b.st[0], nx = b.st[1];
        if (nloc == 0u) { xcd_barrier_complete(bar, b.x, nloc, nx); b.st[0] = nloc; b.st[1] = nx; }
        const unsigned old = xb_add(&bar[XB_XSUB(b.x)], 1u);
        const unsigned gen = old / nloc;
        if (old + 1u == (gen + 1u) * nloc) {
            __builtin_amdgcn_fence(__ATOMIC_RELEASE, "agent");
            asm volatile("s_waitcnt vmcnt(0)" ::: "memory");
            const unsigned og = xb_add(&bar[XB_TOP], 1u);
            const unsigned tg = og / nx;
            if (og + 1u == (tg + 1u) * nx) xb_add(&bar[XB_TOPGEN], 1u);
            else XB_SPIN(xb_ld(&bar[XB_TOPGEN]) == tg, bar);
            __builtin_amdgcn_fence(__ATOMIC_ACQUIRE, "agent");
            xb_add(&bar[XB_XGEN(b.x)], 1u);
            asm volatile("s_waitcnt vmcnt(0)" ::: "memory");
        } else {
            XB_SPIN(xb_ld(&bar[XB_XGEN(b.x)]) == gen, bar);
            __builtin_amdgcn_fence(__ATOMIC_ACQUIRE, "agent");
            asm volatile("s_waitcnt vmcnt(0)" ::: "memory");
        }
    }
    __syncthreads();
}

namespace pg8 {
struct EpiBf16 {
    static constexpr bool PERM = true;
    bf16_t* O; int ldc; const PG8_LAS float* rs;
    __device__ __forceinline__ void operator()(const f32x4 (&acc)[2][2][4][2], const Unit& u, int wr, int wc, int fr, int fq, int ui) const {
        const int row0 = u.pm * BM + wr * 64 + fr, col0 = u.pn * BM + wc * 32 + 8 * fq;
#pragma unroll
        for (int ai = 0; ai < 2; ++ai)
#pragma unroll
            for (int m = 0; m < 4; ++m) { bf16_t* rowp = O + (size_t)(row0 + ai * HALF + m * 16) * ldc + col0; const float sc = rs ? rs[ui * 256 + ai * HALF + wr * 64 + m * 16 + fr] : 1.0f;
#pragma unroll
                for (int bj = 0; bj < 2; ++bj) { const f32x4 v0 = acc[ai][bj][m][0] * sc, v1 = acc[ai][bj][m][1] * sc;
                    u32x4 w; w.x = cvt_pk_bf16(v0[0], v0[1]); w.y = cvt_pk_bf16(v0[2], v0[3]); w.z = cvt_pk_bf16(v1[0], v1[1]); w.w = cvt_pk_bf16(v1[2], v1[3]);
                    *(u32x4*)(rowp + bj * HALF) = w; } }
    }
};
__device__ __forceinline__ float silu_mul(float g, float u) { return g * __builtin_amdgcn_rcpf(1.f + __expf(-g)) * u; }
struct EpiSwiGLU {
    static constexpr bool PERM = true;
    bf16_t* O; int ldc; const PG8_LAS float* rs;
    __device__ __forceinline__ void operator()(const f32x4 (&acc)[2][2][4][2], const Unit& u, int wr, int wc, int fr, int fq, int ui) const {
        const int row0 = u.pm * BM + wr * 64 + fr, col0 = u.pn * HALF + wc * 32 + 8 * fq;
#pragma unroll
        for (int ai = 0; ai < 2; ++ai)
#pragma unroll
            for (int m = 0; m < 4; ++m) { bf16_t* rowp = O + (size_t)(row0 + ai * HALF + m * 16) * ldc + col0;
                const float sc = rs ? rs[ui * 256 + ai * HALF + wr * 64 + m * 16 + fr] : 1.0f;
                const f32x4 g0 = acc[ai][0][m][0] * sc, g1 = acc[ai][0][m][1] * sc, u0 = acc[ai][1][m][0] * sc, u1 = acc[ai][1][m][1] * sc;
                u32x4 w; w.x = cvt_pk_bf16(silu_mul(g0[0], u0[0]), silu_mul(g0[1], u0[1])); w.y = cvt_pk_bf16(silu_mul(g0[2], u0[2]), silu_mul(g0[3], u0[3]));
                w.z = cvt_pk_bf16(silu_mul(g1[0], u1[0]), silu_mul(g1[1], u1[1])); w.w = cvt_pk_bf16(silu_mul(g1[2], u1[2]), silu_mul(g1[3], u1[3]));
                *(u32x4*)rowp = w; }
    }
};
__device__ __forceinline__ float clamp_fp8(float x) { return __builtin_amdgcn_fmed3f(x, -448.0f, 448.0f); }
__device__ __forceinline__ unsigned pk4_fp8(float a, float b, float c, float d) { a = clamp_fp8(a); b = clamp_fp8(b); c = clamp_fp8(c); d = clamp_fp8(d); int w = 0; w = __builtin_amdgcn_cvt_pk_fp8_f32(a, b, w, false); w = __builtin_amdgcn_cvt_pk_fp8_f32(c, d, w, true); return (unsigned)w; }
struct EpiSwiGLU8 {
    static constexpr bool PERM = true;
    unsigned char* O; int ldc; float gs, os;
    __device__ __forceinline__ void operator()(const f32x4 (&acc)[2][2][4][2], const Unit& u, int wr, int wc, int fr, int fq, int ui) const {
        const int row0 = u.pm * BM + wr * 64 + fr, col0 = u.pn * HALF + wc * 32 + 8 * fq;
#pragma unroll
        for (int ai = 0; ai < 2; ++ai)
#pragma unroll
            for (int m = 0; m < 4; ++m) { unsigned char* rowp = O + (size_t)(row0 + ai * HALF + m * 16) * ldc + col0;
                const f32x4 g0 = acc[ai][0][m][0] * gs, g1 = acc[ai][0][m][1] * gs, u0 = acc[ai][1][m][0] * (gs * os), u1 = acc[ai][1][m][1] * (gs * os);
                typedef unsigned u32x2 __attribute__((ext_vector_type(2))); u32x2 w;
                w.x = pk4_fp8(silu_mul(g0[0], u0[0]), silu_mul(g0[1], u0[1]), silu_mul(g0[2], u0[2]), silu_mul(g0[3], u0[3]));
                w.y = pk4_fp8(silu_mul(g1[0], u1[0]), silu_mul(g1[1], u1[1]), silu_mul(g1[2], u1[2]), silu_mul(g1[3], u1[3]));
                *(u32x2*)rowp = w; }
    }
};
struct EpiResF32 {
    static constexpr bool PERM = false;
    const float* res; float* out; int ldc; float sc; bf16_t* xr; const float* gain; float* ssq;
    __device__ __forceinline__ void operator()(const f32x4 (&acc)[2][2][4][2], const Unit& u, int wr, int wc, int fr, int fq, int ui) const {
        const int row0 = u.pm * BM + wr * 64 + fr, col0 = u.pn * BM + wc * 32 + 4 * fq;
        f32x4 gv[2][2];
        if (xr) {
#pragma unroll
            for (int bj = 0; bj < 2; ++bj)
#pragma unroll
                for (int n = 0; n < 2; ++n) gv[bj][n] = *(const f32x4*)(gain + col0 + bj * HALF + n * 16); }
#pragma unroll
        for (int ai = 0; ai < 2; ++ai) {
            f32x4 r[4][2][2];
#pragma unroll
            for (int m = 0; m < 4; ++m) { const size_t off = (size_t)(row0 + ai * HALF + m * 16) * ldc + col0;
#pragma unroll
                for (int bj = 0; bj < 2; ++bj)
#pragma unroll
                    for (int n = 0; n < 2; ++n) r[m][bj][n] = *(const f32x4*)(res + off + bj * HALF + n * 16); }
#pragma unroll
            for (int m = 0; m < 4; ++m) { const int row = row0 + ai * HALF + m * 16; const size_t off = (size_t)row * ldc + col0; float s = 0.f;
#pragma unroll
                for (int bj = 0; bj < 2; ++bj)
#pragma unroll
                    for (int n = 0; n < 2; ++n) { const f32x4 o = r[m][bj][n] + acc[ai][bj][m][n] * sc; *(f32x4*)(out + off + bj * HALF + n * 16) = o;
                        if (xr) { s += (o[0] * o[0] + o[1] * o[1]) + (o[2] * o[2] + o[3] * o[3]); const f32x4 y = o * gv[bj][n];
                            unsigned w0 = cvt_pk_bf16(y[0], y[1]), w1 = cvt_pk_bf16(y[2], y[3]); typedef unsigned u32x2 __attribute__((ext_vector_type(2))); *(u32x2*)(xr + off + bj * HALF + n * 16) = (u32x2){w0, w1}; } }
                if (xr) { s += __shfl_xor(s, 16); s += __shfl_xor(s, 32); if (fq == 0) ssq[(size_t)row * 16 + u.pn * 4 + wc] = s; } }
        }
    }
};
#ifndef MDN_ROWS
#define MDN_ROWS 4
#endif
struct EpiMoeDown {
    static constexpr bool PERM = false;
    float* out; int ldc; const int* tok; const float* gate; float sc;
    __device__ __forceinline__ void operator()(const f32x4 (&acc)[2][2][4][2], const Unit& u, int wr, int wc, int fr, int fq, int ui) const {
        const int col0 = u.pn * BM + wc * 32 + 4 * fq;
        int tk[2][4]; float gt[2][4];
#pragma unroll
        for (int ai = 0; ai < 2; ++ai)
#pragma unroll
            for (int m = 0; m < 4; ++m) { const int slot = u.r0 + ai * HALF + wr * 64 + m * 16 + fr, sl = slot < 32767 ? slot : 32767;
                tk[ai][m] = tok[u.e * 32768 + sl]; gt[ai][m] = gate[u.e * 32768 + sl]; }
#pragma unroll
        for (int ai = 0; ai < 2; ++ai)
#pragma unroll
            for (int m = 0; m < 4; ++m) { const bool ok = (u.r0 + ai * HALF + wr * 64 + m * 16 + fr) < u.cn; tk[ai][m] = ok ? tk[ai][m] : -1; gt[ai][m] = ok ? gt[ai][m] * sc : 0.f; }
#pragma unroll
        for (int ai = 0; ai < 2; ++ai)
#pragma unroll
            for (int mh = 0; mh < 4 / MDN_ROWS; ++mh) {
                f32x4 r[MDN_ROWS][2][2];
#pragma unroll
                for (int mm = 0; mm < MDN_ROWS; ++mm) { const int m = MDN_ROWS * mh + mm; const float* rowp = out + (size_t)(tk[ai][m] < 0 ? 0 : tk[ai][m]) * ldc + col0;
#pragma unroll
                    for (int bj = 0; bj < 2; ++bj)
#pragma unroll
                        for (int n = 0; n < 2; ++n) r[mm][bj][n] = *(const f32x4*)(rowp + bj * HALF + n * 16); }
#pragma unroll
                for (int mm = 0; mm < MDN_ROWS; ++mm) { const int m = MDN_ROWS * mh + mm; if (tk[ai][m] >= 0) { float* rowp = out + (size_t)tk[ai][m] * ldc + col0;
#pragma unroll
                    for (int bj = 0; bj < 2; ++bj)
#pragma unroll
                        for (int n = 0; n < 2; ++n) *(f32x4*)(rowp + bj * HALF + n * 16) = r[mm][bj][n] + acc[ai][bj][m][n] * gt[ai][m]; } }
            }
    }
};
struct EpiMoeDownA {
    static constexpr bool PERM = false;
    float* out; int ldc; const int* tok; const float* gate; float sc;
    __device__ __forceinline__ void operator()(const f32x4 (&acc)[2][2][4][2], const Unit& u, int wr, int wc, int fr, int fq, int ui) const {
        const int col0 = u.pn * BM + wc * 32 + 4 * fq;
        int tk[2][4]; float gt[2][4];
#pragma unroll
        for (int ai = 0; ai < 2; ++ai)
#pragma unroll
            for (int m = 0; m < 4; ++m) { const int slot = u.r0 + ai * HALF + wr * 64 + m * 16 + fr, sl = slot < 32767 ? slot : 32767;
                tk[ai][m] = tok[u.e * 32768 + sl]; gt[ai][m] = gate[u.e * 32768 + sl]; }
#pragma unroll
        for (int ai = 0; ai < 2; ++ai)
#pragma unroll
            for (int m = 0; m < 4; ++m) { const bool ok = (u.r0 + ai * HALF + wr * 64 + m * 16 + fr) < u.cn;
                if (ok) { typedef __attribute__((address_space(1))) float gfloat; gfloat* rowp = (gfloat*)(out + (size_t)tk[ai][m] * ldc + col0); const float g_ = gt[ai][m] * sc;
#pragma unroll
                    for (int bj = 0; bj < 2; ++bj)
#pragma unroll
                        for (int n = 0; n < 2; ++n)
#pragma unroll
                            for (int j = 0; j < 4; ++j) __builtin_amdgcn_global_atomic_fadd_f32(rowp + bj * HALF + n * 16 + j, acc[ai][bj][m][n][j] * g_); } }
    }
};
#define MO_T(c) (((c) + 255) >> 8)
struct MoeOrder : StaticOrder {
    int c0, c1, c2, c3, c4, c5, c6, c7; const int* tok; int nNl; const PG8_LAS int* ltab;
    __device__ __forceinline__ void init_moe(const unsigned* cnt, const int* tok_, int N, int G_, int c_, int tile_cap = 1 << 20) {
        tok = tok_; ltab = nullptr;
#define MO_LD(e) (int)__hip_atomic_load(cnt + e, __ATOMIC_RELAXED, __HIP_MEMORY_SCOPE_AGENT)
        c0 = MO_LD(0); c1 = MO_LD(1); c2 = MO_LD(2); c3 = MO_LD(3); c4 = MO_LD(4); c5 = MO_LD(5); c6 = MO_LD(6); c7 = MO_LD(7);
#undef MO_LD
        nNl = N / BM; const int nt_ = tiles(); init((nt_ < tile_cap ? nt_ : tile_cap) * BM, N, G_, c_);
    }
    __device__ __forceinline__ void decode(Unit& u) const {
        int e = 0, tb = 0, c = c0, acc = MO_T(c0);
#define MO_STEP(k, ck) if (u.pm >= acc) { e = k; tb = acc; c = ck; } acc += MO_T(ck);
        MO_STEP(1, c1) MO_STEP(2, c2) MO_STEP(3, c3) MO_STEP(4, c4) MO_STEP(5, c5) MO_STEP(6, c6) MO_STEP(7, c7)
#undef MO_STEP
        u.e = e; u.r0 = (u.pm - tb) * BM; u.cn = c; u.pb = e * nNl + u.pn;
    }
    __device__ __forceinline__ int tiles() const { return MO_T(c0) + MO_T(c1) + MO_T(c2) + MO_T(c3) + MO_T(c4) + MO_T(c5) + MO_T(c6) + MO_T(c7); }
    __device__ __forceinline__ bool next(int i, Unit& u) const {
        if (!StaticOrder::next(i, u)) return false;
        decode(u); u.aux = i; return true;
    }
    __device__ __forceinline__ int arow(const Unit& u, int R) const { if (ltab) return ltab[u.aux * 256 + R]; const int slot = u.r0 + R; return slot < u.cn ? tok[u.e * 32768 + slot] : 0; }
    __device__ __forceinline__ void build_ltab(PG8_LAS int* tab, int tid) { Unit u; for (int i = 0; next(i, u); ++i) if (tid < 256) { const int slot = u.r0 + tid; tab[i * 256 + tid] = slot < u.cn ? tok[u.e * 32768 + slot] : 0; }
        __syncthreads(); ltab = tab; }
};
#undef MO_T
struct MoeTailOrder {
    const MoeOrder* mo; int G, c, ntail, KS, kslice;
    __device__ __forceinline__ void init(const MoeOrder* mo_, int G_, int c_, int KS_, int kslice_, int max_tail) { mo = mo_; G = G_; c = c_; KS = KS_; kslice = kslice_; const int t = (mo_->tiles() - 128) * mo_->nNl; ntail = t < 0 ? 0 : (t > max_tail ? max_tail : t); }
    __device__ __forceinline__ bool next(int i, Unit& u) const {
        const int s = i * G + c; if (s >= ntail * KS) return false;
        const int t = s / KS, ks = s - t * KS; u.pm = 128 + t / mo->nNl; u.pn = t % mo->nNl; mo->decode(u); u.koff = ks * kslice; u.aux = s; return true;
    }
    __device__ __forceinline__ void a_ready(const Unit&) const {}
    __device__ __forceinline__ void done(const Unit&) const {}
    __device__ __forceinline__ int arow(const Unit&, int) const { return 0; }
};
struct EpiPart {
    static constexpr bool PERM = false;
    float* part;
    __device__ __forceinline__ void operator()(const f32x4 (&acc)[2][2][4][2], const Unit& u, int wr, int wc, int fr, int fq, int ui) const {
        float* base = part + (size_t)u.aux * 65536 + (size_t)(wr * 64 + fr) * 256 + wc * 32 + 4 * fq;
#pragma unroll
        for (int ai = 0; ai < 2; ++ai)
#pragma unroll
            for (int m = 0; m < 4; ++m)
#pragma unroll
                for (int bj = 0; bj < 2; ++bj)
#pragma unroll
                    for (int n = 0; n < 2; ++n) *(f32x4*)(base + (size_t)(ai * HALF + m * 16) * 256 + bj * HALF + n * 16) = acc[ai][bj][m][n];
    }
};
}
#include <cmath>
struct Args { const float* in[25]; float* out; unsigned char* ws; int ph_lo, ph_hi; };
struct KArgs {
    typedef const __attribute__((address_space(4))) char* kptr;
    DI kptr base() const { kptr p = (kptr)__builtin_amdgcn_kernarg_segment_ptr(); asm volatile("" : "+s"(p)); return p; }
    DI const float* in(int i) const { return *(const float* const __attribute__((address_space(4)))*)(base() + 8 * i); }
    DI float* out() const { return *(float* const __attribute__((address_space(4)))*)(base() + 200); }
    DI unsigned char* ws() const { return *(unsigned char* const __attribute__((address_space(4)))*)(base() + 208); }
    DI int ph_lo() const { return *(const int __attribute__((address_space(4)))*)(base() + 216); }
    DI int ph_hi() const { return *(const int __attribute__((address_space(4)))*)(base() + 220); }
};
static_assert(sizeof(Args) == 224, "Args layout");
enum { I_X = 0, I_N1G, I_WIN, I_QNG, I_KNG, I_GNG, I_ARE, I_AIM, I_BRE, I_BIM, I_CRE, I_CIM, I_SD, I_LDT, I_GLW, I_GLB, I_WOUT, I_N2G, I_FG, I_FU, I_FD, I_RT, I_MG, I_MU, I_MD };

DI void transpose_item(const float* W, int ldw, bf16* WT, int ldo, int k0, int n0, int drow0, float* scr, int lane) {
    float v[32];
    const float* src = W + (size_t)(k0 + (lane >> 5)) * ldw + n0 + (lane & 31);
#pragma unroll
    for (int i = 0; i < 32; ++i) v[i] = src[(size_t)(2 * i) * ldw];
#pragma unroll
    for (int i = 0; i < 32; ++i) scr[(2 * i + (lane >> 5)) * 33 + (lane & 31)] = v[i];
    LDS_WAIT(); asm volatile("" ::: "memory");
    const int c = lane & 7;
#pragma unroll
    for (int j = 0; j < 4; ++j) { const int n = (lane >> 3) + 8 * j; const float* s = scr + (8 * c) * 33 + n;
        v4u o; o.x = pk2(s[0 * 33], s[1 * 33]); o.y = pk2(s[2 * 33], s[3 * 33]); o.z = pk2(s[4 * 33], s[5 * 33]); o.w = pk2(s[6 * 33], s[7 * 33]);
        *(v4u*)(WT + (size_t)(drow0 + n) * ldo + k0 + 8 * c) = o; }
    LDS_WAIT(); asm volatile("" ::: "memory");
}
DI void rms_row(const float* xrow, const float* g, bf16* orow, int lane, f32x4 (&v)[4]) {
    const f32x4* xr = (const f32x4*)xrow + lane; float s = 0.f;
#pragma unroll
    for (int j = 0; j < 4; ++j) { v[j] = xr[64 * j]; s += (v[j].x * v[j].x + v[j].y * v[j].y) + (v[j].z * v[j].z + v[j].w * v[j].w); }
    const float rs = rsqrtf(wave_sum(s) * (1.f / DM) + 1e-6f);
    v2u* o8 = (v2u*)orow + lane;
#pragma unroll
    for (int j = 0; j < 4; ++j) { const f32x4 gg = ((const f32x4*)g)[lane + 64 * j]; v[j] = v[j] * rs * gg; v2u w; w.x = pk2(v[j].x, v[j].y); w.y = pk2(v[j].z, v[j].w); o8[64 * j] = w; }
}
DI void transpose_item8(const float* W, int ldw, unsigned char* WT, int ldo, int k0, int n0, int drow0, float scale, float* scr, int lane) {
    float v[32];
    const float* src = W + (size_t)(k0 + (lane >> 5)) * ldw + n0 + (lane & 31);
#pragma unroll
    for (int i = 0; i < 32; ++i) v[i] = src[(size_t)(2 * i) * ldw];
#pragma unroll
    for (int i = 0; i < 32; ++i) scr[(2 * i + (lane >> 5)) * 33 + (lane & 31)] = v[i] * scale;
    LDS_WAIT(); asm volatile("" ::: "memory");
    const int n = lane >> 1, hf = lane & 1; const float* s = scr + (32 * hf) * 33 + n;
    v4u o0, o1;
    o0.x = pg8::pk4_fp8(s[0 * 33], s[1 * 33], s[2 * 33], s[3 * 33]); o0.y = pg8::pk4_fp8(s[4 * 33], s[5 * 33], s[6 * 33], s[7 * 33]); o0.z = pg8::pk4_fp8(s[8 * 33], s[9 * 33], s[10 * 33], s[11 * 33]); o0.w = pg8::pk4_fp8(s[12 * 33], s[13 * 33], s[14 * 33], s[15 * 33]);
    o1.x = pg8::pk4_fp8(s[16 * 33], s[17 * 33], s[18 * 33], s[19 * 33]); o1.y = pg8::pk4_fp8(s[20 * 33], s[21 * 33], s[22 * 33], s[23 * 33]); o1.z = pg8::pk4_fp8(s[24 * 33], s[25 * 33], s[26 * 33], s[27 * 33]); o1.w = pg8::pk4_fp8(s[28 * 33], s[29 * 33], s[30 * 33], s[31 * 33]);
    unsigned char* dp = WT + (size_t)(drow0 + n) * ldo + k0 + 32 * hf;
    *(v4u*)dp = o0; *(v4u*)(dp + 16) = o1;
    LDS_WAIT(); asm volatile("" ::: "memory");
}
struct T8Item { const float* W; unsigned char* WT; int ldw, ldo, k0, n0, drow0; float scale; };
DI void t8_load(float (&v)[32], const T8Item& d, int lane) {
    const float* src = d.W + (size_t)(d.k0 + (lane >> 5)) * d.ldw + d.n0 + (lane & 31);
#pragma unroll
    for (int i = 0; i < 32; ++i) v[i] = src[(size_t)(2 * i) * d.ldw];
}
DI void t8_store(const float (&v)[32], const T8Item& d, float* scr, int lane) {
#pragma unroll
    for (int i = 0; i < 32; ++i) scr[(2 * i + (lane >> 5)) * 33 + (lane & 31)] = v[i] * d.scale;
    LDS_WAIT(); asm volatile("" ::: "memory");
    const int n = lane >> 1, hf = lane & 1; const float* s = scr + (32 * hf) * 33 + n;
    v4u o0, o1;
    o0.x = pg8::pk4_fp8(s[0 * 33], s[1 * 33], s[2 * 33], s[3 * 33]); o0.y = pg8::pk4_fp8(s[4 * 33], s[5 * 33], s[6 * 33], s[7 * 33]); o0.z = pg8::pk4_fp8(s[8 * 33], s[9 * 33], s[10 * 33], s[11 * 33]); o0.w = pg8::pk4_fp8(s[12 * 33], s[13 * 33], s[14 * 33], s[15 * 33]);
    o1.x = pg8::pk4_fp8(s[16 * 33], s[17 * 33], s[18 * 33], s[19 * 33]); o1.y = pg8::pk4_fp8(s[20 * 33], s[21 * 33], s[22 * 33], s[23 * 33]); o1.z = pg8::pk4_fp8(s[24 * 33], s[25 * 33], s[26 * 33], s[27 * 33]); o1.w = pg8::pk4_fp8(s[28 * 33], s[29 * 33], s[30 * 33], s[31 * 33]);
    unsigned char* dp = d.WT + (size_t)(d.drow0 + n) * d.ldo + d.k0 + 32 * hf;
    *(v4u*)dp = o0; *(v4u*)(dp + 16) = o1;
    LDS_WAIT(); asm volatile("" ::: "memory");
}
DI void rms_rows_phase(const float* x, const float* g, bf16* out, int gw, int NGW, int lane) {
    f32x4 gg[4];
#pragma unroll
    for (int j = 0; j < 4; ++j) gg[j] = ((const f32x4*)g)[lane + 64 * j];
    for (int m0 = gw; m0 < T; m0 += 4 * NGW) {
        f32x4 v[4][4];
#pragma unroll
        for (int r = 0; r < 4; ++r) { const int m = m0 + r * NGW; if (m < T) {
#pragma unroll
            for (int j = 0; j < 4; ++j) v[r][j] = ((const f32x4*)(x + (size_t)m * DM))[lane + 64 * j]; } }
#pragma unroll
        for (int r = 0; r < 4; ++r) { const int m = m0 + r * NGW; if (m < T) { float s = 0.f;
#pragma unroll
            for (int j = 0; j < 4; ++j) s += (v[r][j].x * v[r][j].x + v[r][j].y * v[r][j].y) + (v[r][j].z * v[r][j].z + v[r][j].w * v[r][j].w);
            const float rs = rsqrtf(wave_sum(s) * (1.f / DM) + 1e-6f); v2u* o8 = (v2u*)(out + (size_t)m * DM) + lane;
#pragma unroll
            for (int j = 0; j < 4; ++j) { const f32x4 y = v[r][j] * rs * gg[j]; v2u w; w.x = pk2(y.x, y.y); w.y = pk2(y.z, y.w); o8[64 * j] = w; } } }
    }
}
DI void unpack8(const v4u w, float (&x)[8]) { x[0] = bflo(w.x); x[1] = bfhi(w.x); x[2] = bflo(w.y); x[3] = bfhi(w.y); x[4] = bflo(w.z); x[5] = bfhi(w.z); x[6] = bflo(w.w); x[7] = bfhi(w.w); }
DI v4u pack8(const float (&x)[8]) { v4u w; w.x = pk2(x[0], x[1]); w.y = pk2(x[2], x[3]); w.z = pk2(x[4], x[5]); w.w = pk2(x[6], x[7]); return w; }

template <class Sched> DI void build_rs(LAS float* RS, const Sched& S, const float* ssq, int tid) {
    pg8::Unit u;
    for (int i = 0; S.next(i, u); ++i) if (tid < 256) { const f32x4* p = (const f32x4*)(ssq + ((size_t)u.pm * 256 + tid) * 16); const f32x4 a0 = p[0], a1 = p[1], a2 = p[2], a3 = p[3];
        const float s = ((a0.x + a0.y) + (a0.z + a0.w)) + ((a1.x + a1.y) + (a1.z + a1.w)) + ((a2.x + a2.y) + (a2.z + a2.w)) + ((a3.x + a3.y) + (a3.z + a3.w));
        RS[i * 256 + tid] = rsqrtf(s * (1.f / DM) + 1e-6f); }
    __syncthreads();
}
DI void phase_prologue(const KArgs& a, char* lds, int gw, int NGW, int wave, int lane) {
    unsigned char* ws = a.ws();
    float* scr = (float*)(lds + wave * 16384);
    constexpr int I_IN = 16 * 80, I_OUT = 16 * 32, I_G = 16 * 88, I_D = 44 * 32;
    constexpr int NIT = 2 * I_IN + 2 * I_OUT + 2 * I_G + I_D;
    for (int it = gw; it < NIT; it += NGW) {
        int r = it;
        if (r < 2 * I_IN) { const int l = r / I_IN; r -= l * I_IN; const int kb = r / 80, nb = r % 80;
            transpose_item(a.in(I_WIN) + (size_t)l * DM * NPROJ, NPROJ, (bf16*)(ws + WS_WIN) + (size_t)l * NPROJ * DM, DM, 64 * kb, 32 * nb, 32 * nb, scr, lane); continue; }
        r -= 2 * I_IN;
        if (r < 2 * I_OUT) { const int l = r / I_OUT; r -= l * I_OUT; const int kb = r / 32, nb = r % 32;
            transpose_item(a.in(I_WOUT) + (size_t)l * DM * DM, DM, (bf16*)(ws + WS_WOUT) + (size_t)l * DM * DM, DM, 64 * kb, 32 * nb, 32 * nb, scr, lane); continue; }
        r -= 2 * I_OUT;
        if (r < 2 * I_G) { const int up = r / I_G; r -= up * I_G; const int kb = r / 88, nb = r % 88, n0 = 32 * nb;
            transpose_item(a.in(up ? I_FU : I_FG), DFF, (bf16*)(ws + WS_FGU), DM, 64 * kb, n0, (n0 >> 7) * 256 + (n0 & 127) + up * 128, scr, lane); continue; }
        r -= 2 * I_G;
        { const int kb = r / 32, nb = r % 32; transpose_item(a.in(I_FD), DM, (bf16*)(ws + WS_FDN), DFF, 64 * kb, 32 * nb, 32 * nb, scr, lane); }
    }
    const int gt = gw * 64 + lane, NGT = NGW * 64;
    float* tabA = (float*)(ws + WS_TABA); float* tabR = (float*)(ws + WS_TABR);
    for (int i = gt; i < SEQ * 8; i += NGT) { const int pos = i >> 3, k = i & 7; const float inv = powf(500000.0f, -(float)k * 2.0f / 16.0f); const double ang = (double)((float)pos * inv);
        tabA[2 * i] = (float)cos(ang); tabA[2 * i + 1] = (float)sin(ang); }
    for (int i = gt; i < SEQ * 32; i += NGT) { const int pos = i >> 5, k = i & 31; const float inv = powf(10000.0f, -(float)k * 2.0f / 64.0f); const double ang = (double)((float)pos * inv);
        tabR[2 * i] = (float)cos(ang); tabR[2 * i + 1] = (float)sin(ang); }
    for (int i = gt; i < DEPTH * 16 * 64; i += NGT) { const int l = i >> 10, gp = i & 1023, gI = gp >> 6;
        float* base = (float*)(ws + WS_SSM + (size_t)l * SSM_LAYER_BYTES);
        const float dt = expf(a.in(I_LDT)[l * 16 + gI]), lr = a.in(I_ARE)[i], li = a.in(I_AIM)[i];
        const float mag = expf(lr * dt), ang = li * dt; const float ar = mag * cosf(ang), ai = mag * sinf(ang);
        const float den = lr * lr + li * li, nr = ar - 1.0f, ni = ai; const float fre = (nr * lr + ni * li) / den, fim = (ni * lr - nr * li) / den;
        bf16* bmt = (bf16*)((char*)base + SSM_BMT) + ((size_t)gI * 128 + (gp & 63)) * 16;
        for (int c = 0; c < 16; ++c) { const float br = a.in(I_BRE)[(size_t)i * 16 + c], bi = a.in(I_BIM)[(size_t)i * 16 + c]; bmt[c] = (bf16)f2bf(0.5f * (fre * br - fim * bi)); bmt[64 * 16 + c] = (bf16)f2bf(0.5f * (fre * bi + fim * br)); }
        bf16* cmt = (bf16*)((char*)base + SSM_CMT) + (size_t)gI * 16 * 128 + 2 * (gp & 63);
        for (int c = 0; c < 16; ++c) { cmt[c * 128] = (bf16)f2bf(a.in(I_CRE)[((size_t)(l * 16 + gI) * 16 + c) * 64 + (gp & 63)]); cmt[c * 128 + 1] = (bf16)f2bf(-a.in(I_CIM)[((size_t)(l * 16 + gI) * 16 + c) * 64 + (gp & 63)]); }
        base[SSM_ABAR / 4 + 2 * gp] = ar; base[SSM_ABAR / 4 + 2 * gp + 1] = ai;
        float pr = ar, pi = ai;
        for (int k = 0; k < 7; ++k) { const float t0 = pr * pr - pi * pi, t1 = 2.0f * pr * pi; pr = t0; pi = t1; }
        base[SSM_ABARL / 4 + 2 * gp] = pr; base[SSM_ABARL / 4 + 2 * gp + 1] = pi; }
    for (int i = gt; i < DEPTH * 65536; i += NGT) { const int l = i >> 16, n = (i >> 8) & 255, k = i & 255;
        ((bf16*)(ws + WS_SSM + (size_t)l * SSM_LAYER_BYTES + SSM_GLWT))[n * 256 + k] = (bf16)f2bf(a.in(I_GLW)[(size_t)l * 65536 + k * 256 + n]); }
    rms_rows_phase(a.in(I_X), a.in(I_N1G), (bf16*)(ws + WS_XN), gw, NGW, lane);
}

DI void prep_phase(bf16* proj, const float* qg, const float* kg, const float* tabA, int gw, int NGW, int lane) {
    const int vec = lane >> 3, sub = lane & 7;
    const int coff = (vec < 4 ? C_QA + vec * 64 : C_KA + (vec - 4) * 64) + sub * 8;
    float g[8];
    { const f32x4* gp = (const f32x4*)((vec < 4 ? qg : kg) + sub * 8); const f32x4 g0 = gp[0], g1 = gp[1]; g[0] = g0.x; g[1] = g0.y; g[2] = g0.z; g[3] = g0.w; g[4] = g1.x; g[5] = g1.y; g[6] = g1.z; g[7] = g1.w; }
    const float qs = vec < 4 ? 0.125f * 1.4426950408889634f : 1.0f;
    for (int t0 = gw; t0 < T; t0 += 4 * NGW) {
        v4u raw[4]; f32x4 cs[4][4];
#pragma unroll
        for (int r = 0; r < 4; ++r) { const int t = t0 + r * NGW; if (t < T) { raw[r] = *(const v4u*)(proj + (size_t)t * NPROJ + coff); const f32x4* cp = (const f32x4*)(tabA + (size_t)(t & (SEQ - 1)) * 16);
#pragma unroll
            for (int c = 0; c < 4; ++c) cs[r][c] = cp[c]; } }
#pragma unroll
        for (int r = 0; r < 4; ++r) { const int t = t0 + r * NGW; if (t < T) {
            float x[8]; unpack8(raw[r], x);
            float ss = 0.f;
#pragma unroll
            for (int e = 0; e < 8; ++e) ss += x[e] * x[e];
            ss += __shfl_xor(ss, 1); ss += __shfl_xor(ss, 2); ss += __shfl_xor(ss, 4);
            const float rs = rsqrtf(ss * (1.f / 64.f) + 1e-6f);
#pragma unroll
            for (int e = 0; e < 8; ++e) x[e] = x[e] * rs * g[e];
            const float cc[8] = {cs[r][0].x, cs[r][0].z, cs[r][1].x, cs[r][1].z, cs[r][2].x, cs[r][2].z, cs[r][3].x, cs[r][3].z};
            const float sn[8] = {cs[r][0].y, cs[r][0].w, cs[r][1].y, cs[r][1].w, cs[r][2].y, cs[r][2].w, cs[r][3].y, cs[r][3].w};
#pragma unroll
            for (int e = 0; e < 8; ++e) { const float o = __shfl_xor(x[e], 1);
                if (sub == 0) x[e] = x[e] * cc[e] - o * sn[e]; else if (sub == 1) x[e] = x[e] * cc[e] + o * sn[e]; }
#pragma unroll
            for (int e = 0; e < 8; ++e) x[e] *= qs;
            *(v4u*)(proj + (size_t)t * NPROJ + coff) = pack8(x); } }
    }
}
DI void ret_load_rope(float* dst, int ld, const bf16* proj, size_t grow0, int pos0, int col0, float scale, bool zeta, float lg, const float* tabR, int tid) {
    const int row = tid >> 2, qd = tid & 3;
    const bf16* src = proj + (grow0 + row) * NPROJ + col0;
    float own[16], par[16];
    { float t8[8]; unpack8(*(const v4u*)(src + qd * 16), t8);
#pragma unroll
      for (int e = 0; e < 8; ++e) own[e] = t8[e];
      unpack8(*(const v4u*)(src + qd * 16 + 8), t8);
#pragma unroll
      for (int e = 0; e < 8; ++e) own[8 + e] = t8[e];
      unpack8(*(const v4u*)(src + (qd ^ 2) * 16), t8);
#pragma unroll
      for (int e = 0; e < 8; ++e) par[e] = t8[e];
      unpack8(*(const v4u*)(src + (qd ^ 2) * 16 + 8), t8);
#pragma unroll
      for (int e = 0; e < 8; ++e) par[8 + e] = t8[e]; }
    const float* cs = tabR + ((size_t)(pos0 + row) * 32 + (qd & 1) * 16) * 2;
    float sc = scale; if (zeta) sc *= __expf(lg * (float)(127 - row));
    float* d = dst + row * ld + qd * 16;
#pragma unroll
    for (int e = 0; e < 16; ++e) { const float c = cs[2 * e], s = cs[2 * e + 1]; const float r = (qd < 2) ? own[e] * c - par[e] * s : own[e] * c + par[e] * s; d[e] = r * sc; }
}
DI float ret_loggamma(int h) { return log1pf(-exp2f(-5.0f - (float)h)); }

DI void ret_kv_unit(const KArgs& a, char* lds, int unit, int tid) {
    asm volatile("" : "+v"(tid));
    const int n = unit & 127, h = (unit >> 7) & 3, b = unit >> 9;
    float* KS = (float*)lds; float* VS = (float*)(lds + 32768);
    const bf16* proj = (const bf16*)(a.ws() + WS_PROJ); const size_t grow0 = (size_t)b * SEQ + n * 128;
    const float lg = ret_loggamma(h);
    ret_load_rope(KS, 64, proj, grow0, n * 128, C_KR + h * 64, 0.125f, true, lg, (const float*)(a.ws() + WS_TABR), tid);
    { const int row = tid >> 2, q = tid & 3; const bf16* src = proj + (grow0 + row) * NPROJ + C_VR + h * 128 + q * 32; float* d = VS + row * 128 + q * 32;
#pragma unroll
      for (int c = 0; c < 4; ++c) { float t8[8]; unpack8(*(const v4u*)(src + 8 * c), t8);
#pragma unroll
          for (int e = 0; e < 8; ++e) d[8 * c + e] = t8[e]; } }
    __syncthreads();
    const int e = tid & 127, dq = tid >> 7;
    float acc[16];
#pragma unroll
    for (int c = 0; c < 16; ++c) acc[c] = 0.f;
    for (int j = 0; j < 128; ++j) { const float vv = VS[j * 128 + e]; const f32x4* kk = (const f32x4*)(KS + j * 64 + dq * 16);
#pragma unroll
        for (int c = 0; c < 4; ++c) { const f32x4 k4 = kk[c]; acc[4 * c] += vv * k4.x; acc[4 * c + 1] += vv * k4.y; acc[4 * c + 2] += vv * k4.z; acc[4 * c + 3] += vv * k4.w; } }
    float* kv = (float*)(a.ws() + WS_KV) + ((size_t)((b * 4 + h) * 128 + n)) * 8192;
#pragma unroll
    for (int c = 0; c < 16; ++c) kv[(dq * 16 + c) * 128 + e] = acc[c];
    __syncthreads();
}
typedef short bf16x8_t __attribute__((ext_vector_type(8)));
typedef float f32x4_t __attribute__((ext_vector_type(4)));
typedef float f32x2_t __attribute__((ext_vector_type(2)));
constexpr int SSM_XLD = 528;
template <bool EMIT> DI void ssm_wave_chunk(const KArgs& a, int layer, int b, int chunk, int g, LAS char* XS  , LAS char* UWb  , LAS char* ZS, int zld  , float& hr, float& hi, int lane) {
    const bf16* proj = (const bf16*)(a.ws() + WS_PROJ); const size_t grow0 = (size_t)b * SEQ + chunk * 128;
    const char* sp = (const char*)(a.ws() + WS_SSM + (size_t)layer * SSM_LAYER_BYTES);
    const int l15 = lane & 15, l4 = lane >> 4;
    const bf16x8_t zero8 = (bf16x8_t){0, 0, 0, 0, 0, 0, 0, 0};
    bf16x8_t bmf[8];
#pragma unroll
    for (int nt = 0; nt < 8; ++nt) bmf[nt] = *(const bf16x8_t*)(sp + SSM_BMT + (((size_t)g * 128 + 16 * nt + l15) * 16 + 8 * (l4 & 1)) * 2);
    bf16x8_t cmf[4]; float dsk = 0.f;
    if (EMIT) {
#pragma unroll
        for (int s = 0; s < 4; ++s) cmf[s] = *(const bf16x8_t*)(sp + SSM_CMT + (((size_t)g * 16 + l15) * 128 + 32 * s + 8 * l4) * 2);
        dsk = a.in(I_SD)[layer * 256 + g * 16 + l15];
    }
    const float ar = ((const float*)(sp + SSM_ABAR))[2 * (g * 64 + lane)], ai = ((const float*)(sp + SSM_ABAR))[2 * (g * 64 + lane) + 1];
    const bf16* usrc = proj + (grow0 + ((lane & 31) >> 1)) * NPROJ + C_US + g * 16 + (lane & 1) * 8;
    v4u unext = *(const v4u*)usrc;
    f32x2_t hv = (f32x2_t){hr, hi}; const f32x2_t a_rr = (f32x2_t){ar, ar}, a_ii = (f32x2_t){-ai, ai};
    for (int blk = 0; blk < 8; ++blk) {
        if (lane < 32) *(LAS v4u*)(UWb + lane * 16) = unext;
        unext = *(const v4u*)(usrc + (size_t)(16 * (blk < 7 ? blk + 1 : 7)) * NPROJ);
        LDS_WAIT(); asm volatile("" ::: "memory");
        const bf16x8_t uf = *(const LAS bf16x8_t*)(UWb + l15 * 32 + (l4 & 1) * 16);
        f32x4_t dx[8];
#pragma unroll
        for (int nt = 0; nt < 8; ++nt) dx[nt] = __builtin_amdgcn_mfma_f32_16x16x32_bf16(uf, bmf[nt], (f32x4_t){0.f, 0.f, 0.f, 0.f}, 0, 0, 0);
        asm volatile("" : "+v"(dx[0]), "+v"(dx[1]), "+v"(dx[2]), "+v"(dx[3]), "+v"(dx[4]), "+v"(dx[5]), "+v"(dx[6]), "+v"(dx[7]) : "v"(uf));
#pragma unroll
        for (int nt = 0; nt < 8; ++nt)
#pragma unroll
            for (int r = 0; r < 4; ++r) *(LAS float*)(XS + (4 * l4 + r) * SSM_XLD + (16 * nt + l15) * 4) = dx[nt][r];
        asm volatile("" :: "v"(bmf[0]), "v"(bmf[1]), "v"(bmf[2]), "v"(bmf[3]), "v"(bmf[4]), "v"(bmf[5]), "v"(bmf[6]), "v"(bmf[7]));
        LDS_WAIT(); asm volatile("" ::: "memory");
        float xr_[16], xi_[16];
#pragma unroll
        for (int tt = 0; tt < 16; ++tt) { xr_[tt] = *(const LAS float*)(XS + tt * SSM_XLD + lane * 4); xi_[tt] = *(const LAS float*)(XS + tt * SSM_XLD + 256 + lane * 4); }
        asm volatile("" ::: "memory");
#pragma unroll
        for (int tt = 0; tt < 16; ++tt) { const f32x2_t xv = (f32x2_t){xr_[tt], xi_[tt]};
            hv = __builtin_elementwise_fma(a_rr, hv, __builtin_elementwise_fma(a_ii, __builtin_shufflevector(hv, hv, 1, 0), xv)); const float hr = hv.x, hi = hv.y;
            if (EMIT) *(LAS unsigned*)(XS + tt * SSM_XLD + lane * 4) = pg8::cvt_pk_bf16(hr, hi); }
        if (EMIT) {
            LDS_WAIT(); asm volatile("" ::: "memory");
            f32x4_t y = (f32x4_t){0.f, 0.f, 0.f, 0.f};
#pragma unroll
            for (int s = 0; s < 4; ++s) { const bf16x8_t hf = *(const LAS bf16x8_t*)(XS + l15 * SSM_XLD + (32 * s + 8 * l4) * 2); y = __builtin_amdgcn_mfma_f32_16x16x32_bf16(hf, cmf[s], y, 0, 0, 0); asm volatile("" : "+v"(y) : "v"(hf), "v"(cmf[s])); }

#pragma unroll
            for (int r = 0; r < 4; ++r) { const int t = 4 * l4 + r; const float uv = bf2f(*(const LAS bf16*)(UWb + t * 32 + l15 * 2)); const float yv = y[r] + dsk * uv;
                const float z = yv * sigmoidf_(1.5957691216057308f * (yv + 0.044715f * yv * yv * yv));
                *(LAS bf16*)(ZS + (16 * blk + t) * zld + (g * 16 + l15) * 2) = (bf16)f2bf(z); }
        }
        LDS_WAIT(); asm volatile("" ::: "memory");
    }
    hr = hv.x; hi = hv.y;
}
DI void attn_unit(const KArgs& a, char* lds, int unit, int tid) {
    asm volatile("" : "+v"(tid));
    const int pat = unit >> 10, rem = unit & 1023, b = rem >> 9, h = (rem >> 7) & 3, rn = rem & 127;
    const int dil = pat == 0 ? 1 : (pat == 1 ? 4 : 16), nbk = 128 / dil;
    const int n = rn % nbk, r = rn / nbk;
    constexpr int LDK = 68;
    float* KS = (float*)lds; float* VS = (float*)(lds + 256 * LDK * 4);
    const bf16* proj = (const bf16*)(a.ws() + WS_PROJ);
    { const int j = tid >> 1, half = tid & 1; const int l = 128 * (n - 1) + j; float* kd = KS + j * LDK + half * 32; float* vd = VS + j * LDK + half * 32;
      if (l >= 0) { const size_t grow = (size_t)b * SEQ + (size_t)l * dil + r; const bf16* ks = proj + grow * NPROJ + C_KA + h * 64 + half * 32; const bf16* vs = proj + grow * NPROJ + C_VA + h * 64 + half * 32;
#pragma unroll
          for (int c = 0; c < 4; ++c) { float t8[8]; unpack8(*(const v4u*)(ks + 8 * c), t8);
#pragma unroll
              for (int e = 0; e < 8; ++e) kd[8 * c + e] = t8[e];
              unpack8(*(const v4u*)(vs + 8 * c), t8);
#pragma unroll
              for (int e = 0; e < 8; ++e) vd[8 * c + e] = t8[e]; }
      } else {
#pragma unroll
          for (int e = 0; e < 32; ++e) { kd[e] = 0.f; vd[e] = 0.f; } } }
    __syncthreads();
    const int qi = tid >> 2, part = tid & 3;
    const size_t growq = (size_t)b * SEQ + (size_t)(128 * n + qi) * dil + r;
    float q[64];
    { const bf16* qs = proj + growq * NPROJ + C_QA + h * 64;
#pragma unroll
      for (int c = 0; c < 8; ++c) { float t8[8]; unpack8(*(const v4u*)(qs + 8 * c), t8);
#pragma unroll
          for (int e = 0; e < 8; ++e) q[8 * c + e] = t8[e]; } }
    float m = -INFINITY, l = 0.f, o[64];
#pragma unroll
    for (int e = 0; e < 64; ++e) o[e] = 0.f;
    for (int jj = 0; jj < 33; ++jj) {
        const int j = qi + 4 * jj + part;
        const bool valid = (j <= qi + 128) && (n > 0 || j >= 128);
        if (valid) {
            const f32x4* kr = (const f32x4*)(KS + j * LDK); float s = 0.f;
#pragma unroll
            for (int c = 0; c < 16; ++c) { const f32x4 k4 = kr[c]; s += q[4 * c] * k4.x + q[4 * c + 1] * k4.y + q[4 * c + 2] * k4.z + q[4 * c + 3] * k4.w; }
            const float mn = fmaxf(m, s), sc = __expf(m - mn), p = __expf(s - mn);
            l = l * sc + p; m = mn;
            const f32x4* vr = (const f32x4*)(VS + j * LDK);
#pragma unroll
            for (int c = 0; c < 16; ++c) { const f32x4 v4 = vr[c]; o[4 * c] = o[4 * c] * sc + p * v4.x; o[4 * c + 1] = o[4 * c + 1] * sc + p * v4.y; o[4 * c + 2] = o[4 * c + 2] * sc + p * v4.z; o[4 * c + 3] = o[4 * c + 3] * sc + p * v4.w; }
        }
    }
    float M = fmaxf(m, qx1(m)); M = fmaxf(M, qx2(M));
    const float f = (m == -INFINITY) ? 0.f : __expf(m - M);
    l *= f; l += qx1(l); l += qx2(l);
    const float il = 1.0f / l;
#pragma unroll
    for (int e = 0; e < 64; ++e) { float t = o[e] * f; t += qx1(t); t += qx2(t); o[e] = t * il; }
    float w[16];
#pragma unroll
    for (int e = 0; e < 16; ++e) w[e] = part == 0 ? o[e] : (part == 1 ? o[16 + e] : (part == 2 ? o[32 + e] : o[48 + e]));
    bf16* op = (bf16*)(a.ws() + WS_ATTP) + ((size_t)pat * T + growq) * 256 + h * 64 + part * 16;
    { v4u w0, w1; w0.x = pk2(w[0], w[1]); w0.y = pk2(w[2], w[3]); w0.z = pk2(w[4], w[5]); w0.w = pk2(w[6], w[7]); w1.x = pk2(w[8], w[9]); w1.y = pk2(w[10], w[11]); w1.z = pk2(w[12], w[13]); w1.w = pk2(w[14], w[15]);
      *(v4u*)op = w0; *(v4u*)(op + 8) = w1; }
    if (part == 0) ((float*)(a.ws() + WS_LSE))[((size_t)pat * T + growq) * 4 + h] = M + __logf(l);
    __syncthreads();
}
typedef short s16x4_t __attribute__((ext_vector_type(4)));
typedef float f32x16_t __attribute__((ext_vector_type(16)));
typedef __bf16 bf16x2_t __attribute__((ext_vector_type(2)));
DI unsigned cvtpk(float lo, float hi) { f32x2_t v = {lo, hi}; bf16x2_t b = __builtin_convertvector(v, bf16x2_t); return __builtin_bit_cast(unsigned, b); }
DI s16x4_t ldtr(const LAS char* p) { return __builtin_bit_cast(s16x4_t, __builtin_amdgcn_ds_read_tr16_b64_v4i16((LAS s16x4_t*)p)); }
DI int crow16(int r, int hh) { return (r & 3) + 8 * (r >> 2) + 4 * hh; }
struct AttnUnitId { int pat, b, h, dil, r, u; };
DI AttnUnitId attn_decode(int unit) { AttnUnitId d; d.pat = unit >> 9; const int rem = unit & 511; d.b = rem >> 8; d.h = (rem >> 6) & 3; const int cu = rem & 63;
    d.dil = d.pat == 0 ? 1 : (d.pat == 1 ? 4 : 16); const int upc = 64 / d.dil; d.r = cu / upc; d.u = cu % upc; return d; }
DI unsigned attn_issue_kv(const bf16* proj, const AttnUnitId& d, int tid, v4u (&kv)[6], v4u (&vv)[6]) {
    const int kc0 = 256 * d.u - 128 + (tid >> 3);
    const bf16* p0 = proj + ((size_t)d.b * SEQ + (size_t)d.r) * NPROJ + C_KA + d.h * 64 + (tid & 7) * 8;
    unsigned mask = 0u;
#pragma unroll
    for (int it = 0; it < 6; ++it) { const int kc = kc0 + 64 * it, kcc = kc < 0 ? 0 : kc; mask |= (kc >= 0 ? 1u : 0u) << it;
        const bf16* p = p0 + (size_t)(kcc * d.dil) * NPROJ; kv[it] = *(const v4u*)p; vv[it] = *(const v4u*)(p + (C_VA - C_KA)); }
    return mask;
}
template <class F> DI void attn_run(const KArgs& a, LAS char* lds, int nun, const F& unit_of, int tid) {
    asm volatile("" : "+v"(tid));
    if (nun <= 0) return;
    constexpr int RS = 144;
    LAS char* KL = lds; LAS char* VL = lds + 384 * RS;
    const bf16* proj = (const bf16*)(a.ws() + WS_PROJ);
    const int w = tid >> 6, lane = tid & 63, ql = lane & 31, hh = lane >> 5;
    const int q4 = (lane & 15) >> 2, p4 = lane & 3, blk = (lane >> 4) & 1;
    AttnUnitId d = attn_decode(unit_of(0));
    v4u kv[6], vv[6];
    unsigned kvmask = attn_issue_kv(proj, d, tid, kv, vv);
    bf16x8_t qn[4];
    { const size_t grow = (size_t)d.b * SEQ + (size_t)(256 * d.u + 32 * w + ql) * d.dil + d.r;
#pragma unroll
      for (int s = 0; s < 4; ++s) qn[s] = *(const bf16x8_t*)(proj + grow * NPROJ + C_QA + d.h * 64 + 16 * s + 8 * hh); }
    for (int k = 0; k < nun; ++k) {
#pragma unroll
        for (int it = 0; it < 6; ++it) { const int c = tid + 512 * it, row = c >> 3, ch = c & 7; const bool ok = (kvmask >> it) & 1u; const v4u z4 = (v4u){0u, 0u, 0u, 0u};
            *(LAS v4u*)(KL + row * RS + ch * 16) = ok ? kv[it] : z4; *(LAS v4u*)(VL + row * RS + ch * 16) = ok ? vv[it] : z4; }
        const AttnUnitId dc = d; const size_t growc = (size_t)d.b * SEQ + (size_t)(256 * d.u + 32 * w + ql) * d.dil + d.r;
        bf16x8_t qc[4];
#pragma unroll
        for (int s = 0; s < 4; ++s) qc[s] = qn[s];
        __syncthreads();
        d = attn_decode(unit_of(k + 1 < nun ? k + 1 : k)); kvmask = attn_issue_kv(proj, d, tid, kv, vv);
        { const size_t grow = (size_t)d.b * SEQ + (size_t)(256 * d.u + 32 * w + ql) * d.dil + d.r;
#pragma unroll
          for (int s = 0; s < 4; ++s) qn[s] = *(const bf16x8_t*)(proj + grow * NPROJ + C_QA + d.h * 64 + 16 * s + 8 * hh); }
        f32x16_t p[5];
#pragma unroll
        for (int kt = 0; kt < 5; ++kt) {
#pragma unroll
            for (int e = 0; e < 16; ++e) p[kt][e] = 0.f;
#pragma unroll
            for (int s = 0; s < 4; ++s) { const bf16x8_t kf = *(const LAS bf16x8_t*)(KL + (32 * w + 32 * kt + ql) * RS + 32 * s + 16 * hh); p[kt] = __builtin_amdgcn_mfma_f32_32x32x16_bf16(kf, qc[s], p[kt], 0, 0, 0); } }
        const int kc0 = 256 * dc.u + 32 * w - 128;
        float m = -INFINITY;
#pragma unroll
        for (int kt = 0; kt < 5; ++kt)
#pragma unroll
            for (int e = 0; e < 16; ++e) { const int c = crow16(e, hh);
                bool valid;
                if (kt == 0) valid = (c >= ql) && (kc0 >= 0); else if (kt == 4) valid = (c <= ql); else valid = (kc0 + 32 * kt >= 0);
                p[kt][e] = valid ? p[kt][e] : -INFINITY; m = fmaxf(m, p[kt][e]); }
        m = fmaxf(m, __shfl_xor(m, 32));
        float l = 0.f;
#pragma unroll
        for (int kt = 0; kt < 5; ++kt)
#pragma unroll
            for (int e = 0; e < 16; ++e) { const float pe = __builtin_amdgcn_exp2f(p[kt][e] - m); p[kt][e] = pe; l += pe; }
        l += __shfl_xor(l, 32);
        f32x16_t o[2];
#pragma unroll
        for (int e = 0; e < 16; ++e) { o[0][e] = 0.f; o[1][e] = 0.f; }
#pragma unroll
        for (int kt = 0; kt < 5; ++kt)
#pragma unroll
            for (int s = 0; s < 2; ++s) {
                v4u pw; pw.x = cvtpk(p[kt][8 * s], p[kt][8 * s + 1]); pw.y = cvtpk(p[kt][8 * s + 2], p[kt][8 * s + 3]); pw.z = cvtpk(p[kt][8 * s + 4], p[kt][8 * s + 5]); pw.w = cvtpk(p[kt][8 * s + 6], p[kt][8 * s + 7]);
                const bf16x8_t pb = __builtin_bit_cast(bf16x8_t, pw);
                const int row0 = 32 * w + 32 * kt + 16 * s + 4 * hh + q4;
#pragma unroll
                for (int db = 0; db < 2; ++db) { const LAS char* vp = VL + row0 * RS + (32 * db + 16 * blk + 4 * p4) * 2;
                    const s16x4_t lo = ldtr(vp), hi = ldtr(vp + 8 * RS);
                    const bf16x8_t af = __builtin_shufflevector(lo, hi, 0, 1, 2, 3, 4, 5, 6, 7);
                    o[db] = __builtin_amdgcn_mfma_f32_32x32x16_bf16(af, pb, o[db], 0, 0, 0); } }
        const float il = 1.0f / l;
        bf16* op = (bf16*)(a.ws() + WS_ATTP) + ((size_t)dc.pat * T + growc) * 256 + dc.h * 64;
#pragma unroll
        for (int db = 0; db < 2; ++db)
#pragma unroll
            for (int g = 0; g < 4; ++g) { v2u wv; wv.x = cvtpk(o[db][4 * g] * il, o[db][4 * g + 1] * il); wv.y = cvtpk(o[db][4 * g + 2] * il, o[db][4 * g + 3] * il);
                *(v2u*)(op + 32 * db + 8 * g + 4 * hh) = wv; }
        if (hh == 0) ((float*)(a.ws() + WS_LSE))[((size_t)dc.pat * T + growc) * 4 + dc.h] = (m + __log2f(l)) * 0.6931471805599453f;
        __syncthreads();
    }
}
DI void ret_load_rope_bf16(LAS char* dst, int rs, const bf16* proj, size_t grow0, int pos0, int col0, float scale, bool zeta, float lg, const float* tabR, int tid) {
    const int row = tid >> 2, qd = tid & 3;
    const bf16* src = proj + (grow0 + row) * NPROJ + col0;
    float own[16], par[16];
    { float t8[8]; unpack8(*(const v4u*)(src + qd * 16), t8);
#pragma unroll
      for (int e = 0; e < 8; ++e) own[e] = t8[e];
      unpack8(*(const v4u*)(src + qd * 16 + 8), t8);
#pragma unroll
      for (int e = 0; e < 8; ++e) own[8 + e] = t8[e];
      unpack8(*(const v4u*)(src + (qd ^ 2) * 16), t8);
#pragma unroll
      for (int e = 0; e < 8; ++e) par[e] = t8[e];
      unpack8(*(const v4u*)(src + (qd ^ 2) * 16 + 8), t8);
#pragma unroll
      for (int e = 0; e < 8; ++e) par[8 + e] = t8[e]; }
    const float* cs = tabR + ((size_t)(pos0 + row) * 32 + (qd & 1) * 16) * 2;
    float sc = scale; if (zeta) sc *= __expf(lg * (float)(127 - row));
    float o[16];
#pragma unroll
    for (int e = 0; e < 16; ++e) { const float c = cs[2 * e], s = cs[2 * e + 1]; o[e] = ((qd < 2) ? own[e] * c - par[e] * s : own[e] * c + par[e] * s) * sc; }
    v4u w0, w1; w0.x = pk2(o[0], o[1]); w0.y = pk2(o[2], o[3]); w0.z = pk2(o[4], o[5]); w0.w = pk2(o[6], o[7]); w1.x = pk2(o[8], o[9]); w1.y = pk2(o[10], o[11]); w1.z = pk2(o[12], o[13]); w1.w = pk2(o[14], o[15]);
    *(LAS v4u*)(dst + row * rs + qd * 32) = w0; *(LAS v4u*)(dst + row * rs + qd * 32 + 16) = w1;
}
constexpr int RKS = 144, RVS = 272;
DI void ret_kv_unit_mfma(const KArgs& a, LAS char* lds, int unit, int tid) {
    asm volatile("" : "+v"(tid));
    const int n = unit & 127, h = (unit >> 7) & 3, b = unit >> 9;
    LAS char* KL = lds; LAS char* VL = lds + 128 * RKS;
    const bf16* proj = (const bf16*)(a.ws() + WS_PROJ); const size_t grow0 = (size_t)b * SEQ + n * 128;
    const float lg = ret_loggamma(h);
    ret_load_rope_bf16(KL, RKS, proj, grow0, n * 128, C_KR + h * 64, 0.125f, true, lg, (const float*)(a.ws() + WS_TABR), tid);
    { const int row = tid >> 2, qq = tid & 3; const v4u* src = (const v4u*)(proj + (grow0 + row) * NPROJ + C_VR + h * 128 + qq * 32);
#pragma unroll
      for (int c = 0; c < 4; ++c) *(LAS v4u*)(VL + row * RVS + qq * 64 + c * 16) = src[c]; }
    __syncthreads();
    const int w = tid >> 6, lane = tid & 63, ql = lane & 31, hh = lane >> 5, q4 = (lane & 15) >> 2, p4 = lane & 3, blk = (lane >> 4) & 1;
    const int et = w >> 1, dt = w & 1;
    f32x16_t acc;
#pragma unroll
    for (int e = 0; e < 16; ++e) acc[e] = 0.f;
#pragma unroll
    for (int s = 0; s < 8; ++s) { const int row0 = 16 * s + 8 * hh + q4;
        const LAS char* vp = VL + row0 * RVS + (32 * et + 16 * blk + 4 * p4) * 2; const LAS char* kp = KL + row0 * RKS + (32 * dt + 16 * blk + 4 * p4) * 2;
        const s16x4_t alo = ldtr(vp), ahi = ldtr(vp + 4 * RVS), blo = ldtr(kp), bhi = ldtr(kp + 4 * RKS);
        const bf16x8_t af = __builtin_shufflevector(alo, ahi, 0, 1, 2, 3, 4, 5, 6, 7), bfr = __builtin_shufflevector(blo, bhi, 0, 1, 2, 3, 4, 5, 6, 7);
        acc = __builtin_amdgcn_mfma_f32_32x32x16_bf16(af, bfr, acc, 0, 0, 0); }
    float* kv = (float*)(a.ws() + WS_KV) + ((size_t)((b * 4 + h) * 128 + n)) * 8192;
#pragma unroll
    for (int e = 0; e < 16; ++e) kv[(32 * et + crow16(e, hh)) * 64 + 32 * dt + ql] = acc[e];
    __syncthreads();
}
struct RetRaw { v4u q[4], k[4], v[4], g[4]; f32x4 pv[4]; };
DI void ret_issue(const KArgs& a, int unit, int tid, RetRaw& r) {
    const int n = unit & 127, h = (unit >> 7) & 3, b = unit >> 9, row = tid >> 2, qd = tid & 3;
    const bf16* base = (const bf16*)(a.ws() + WS_PROJ) + ((size_t)b * SEQ + n * 128 + row) * NPROJ;
    const bf16* sq = base + C_QR + h * 64; const bf16* sk = base + C_KR + h * 64; const bf16* sv = base + C_VR + h * 128 + qd * 32;
    r.q[0] = *(const v4u*)(sq + qd * 16); r.q[1] = *(const v4u*)(sq + qd * 16 + 8); r.q[2] = *(const v4u*)(sq + (qd ^ 2) * 16); r.q[3] = *(const v4u*)(sq + (qd ^ 2) * 16 + 8);
    r.k[0] = *(const v4u*)(sk + qd * 16); r.k[1] = *(const v4u*)(sk + qd * 16 + 8); r.k[2] = *(const v4u*)(sk + (qd ^ 2) * 16); r.k[3] = *(const v4u*)(sk + (qd ^ 2) * 16 + 8);
#pragma unroll
    for (int c = 0; c < 4; ++c) { r.v[c] = *(const v4u*)(sv + 8 * c); r.g[c] = *(const v4u*)(base + C_GR + h * 128 + qd * 32 + 8 * c); }
    const f32x4* sp = (const f32x4*)((const float*)(a.ws() + WS_KV) + ((size_t)((b * 4 + h) * 128 + n)) * 8192 + row * 64 + qd * 16);
#pragma unroll
    for (int c = 0; c < 4; ++c) r.pv[c] = sp[c];
}
DI void ret_rope_store(LAS char* dst, const v4u (&raw)[4], const float* cs, int qd, float scale) {
    float own[16], par[16];
    { float t8[8]; unpack8(raw[0], t8);
#pragma unroll
      for (int e = 0; e < 8; ++e) own[e] = t8[e];
      unpack8(raw[1], t8);
#pragma unroll
      for (int e = 0; e < 8; ++e) own[8 + e] = t8[e];
      unpack8(raw[2], t8);
#pragma unroll
      for (int e = 0; e < 8; ++e) par[e] = t8[e];
      unpack8(raw[3], t8);
#pragma unroll
      for (int e = 0; e < 8; ++e) par[8 + e] = t8[e]; }
    float o[16];
#pragma unroll
    for (int e = 0; e < 16; ++e) { const float c = cs[2 * e], s = cs[2 * e + 1]; o[e] = ((qd < 2) ? own[e] * c - par[e] * s : own[e] * c + par[e] * s) * scale; }
    v4u w0, w1; w0.x = pk2(o[0], o[1]); w0.y = pk2(o[2], o[3]); w0.z = pk2(o[4], o[5]); w0.w = pk2(o[6], o[7]); w1.x = pk2(o[8], o[9]); w1.y = pk2(o[10], o[11]); w1.z = pk2(o[12], o[13]); w1.w = pk2(o[14], o[15]);
    *(LAS v4u*)dst = w0; *(LAS v4u*)(dst + 16) = w1;
}
template <class F> DI void ret_out_run(const KArgs& a, LAS char* lds, int layer, int nun, const F& unit_of, int tid) {
    asm volatile("" : "+v"(tid));
    if (nun <= 0) return;
    LAS char* QL = lds; LAS char* KL = lds + 128 * RKS; LAS char* VL = lds + 2 * 128 * RKS; LAS char* PL = VL + 128 * RVS; LAS float* ST = (LAS float*)(PL + 128 * RKS);
    const bf16* proj = (const bf16*)(a.ws() + WS_PROJ); const float* tabR = (const float*)(a.ws() + WS_TABR);
    const int w = tid >> 6, lane = tid & 63, ql = lane & 31, hh = lane >> 5, q4 = (lane & 15) >> 2, p4 = lane & 3, blk = (lane >> 4) & 1;
    const int ib = w >> 1, eh = w & 1, i = 32 * ib + ql, row = tid >> 2, qd = tid & 3;
    RetRaw raw; int unit = unit_of(0);
    ret_issue(a, unit, tid, raw);
    for (int kk = 0; kk < nun; ++kk) {
        const int n = unit & 127, h = (unit >> 7) & 3, b = unit >> 9; const size_t grow0 = (size_t)b * SEQ + n * 128; const float lg = ret_loggamma(h);
        { const float* cs = tabR + ((size_t)(n * 128 + row) * 32 + (qd & 1) * 16) * 2;
          ret_rope_store(QL + row * RKS + qd * 32, raw.q, cs, qd, 1.0f); ret_rope_store(KL + row * RKS + qd * 32, raw.k, cs, qd, 0.125f * __expf(-lg * (float)(row + 1)));
#pragma unroll
          for (int c = 0; c < 4; ++c) *(LAS v4u*)(VL + row * RVS + qd * 64 + c * 16) = raw.v[c];
          v4u w0, w1; w0.x = pk2(raw.pv[0].x, raw.pv[0].y); w0.y = pk2(raw.pv[0].z, raw.pv[0].w); w0.z = pk2(raw.pv[1].x, raw.pv[1].y); w0.w = pk2(raw.pv[1].z, raw.pv[1].w);
          w1.x = pk2(raw.pv[2].x, raw.pv[2].y); w1.y = pk2(raw.pv[2].z, raw.pv[2].w); w1.z = pk2(raw.pv[3].x, raw.pv[3].y); w1.w = pk2(raw.pv[3].z, raw.pv[3].w);
          *(LAS v4u*)(PL + row * RKS + qd * 32) = w0; *(LAS v4u*)(PL + row * RKS + qd * 32 + 16) = w1; }
        v4u gcur[4];
#pragma unroll
        for (int c = 0; c < 4; ++c) gcur[c] = raw.g[c];
        __syncthreads();
        unit = unit_of(kk + 1 < nun ? kk + 1 : kk); ret_issue(a, unit, tid, raw);
        bf16x8_t qf[4], qsf[4];
        { const float xi = __expf(lg * (float)(i + 1));
#pragma unroll
          for (int s = 0; s < 4; ++s) { qf[s] = *(const LAS bf16x8_t*)(QL + i * RKS + 32 * s + 16 * hh); float t8[8]; unpack8(__builtin_bit_cast(v4u, qf[s]), t8);
              v4u ww; ww.x = cvtpk(t8[0] * xi, t8[1] * xi); ww.y = cvtpk(t8[2] * xi, t8[3] * xi); ww.z = cvtpk(t8[4] * xi, t8[5] * xi); ww.w = cvtpk(t8[6] * xi, t8[7] * xi); qsf[s] = __builtin_bit_cast(bf16x8_t, ww); } }
        f32x16_t o[2];
#pragma unroll
        for (int e = 0; e < 16; ++e) { o[0][e] = 0.f; o[1][e] = 0.f; }
#pragma unroll
        for (int t = 0; t < 2; ++t)
#pragma unroll
            for (int s = 0; s < 4; ++s) { const bf16x8_t af = *(const LAS bf16x8_t*)(PL + (64 * eh + 32 * t + ql) * RKS + 32 * s + 16 * hh); o[t] = __builtin_amdgcn_mfma_f32_32x32x16_bf16(af, qsf[s], o[t], 0, 0, 0); }
        for (int jb = 0; jb <= ib; ++jb) {
            f32x16_t p;
#pragma unroll
            for (int e = 0; e < 16; ++e) p[e] = 0.f;
#pragma unroll
            for (int s = 0; s < 4; ++s) { const bf16x8_t kf = *(const LAS bf16x8_t*)(KL + (32 * jb + ql) * RKS + 32 * s + 16 * hh); p = __builtin_amdgcn_mfma_f32_32x32x16_bf16(kf, qsf[s], p, 0, 0, 0); }
            if (jb == ib) {
#pragma unroll
                for (int e = 0; e < 16; ++e) p[e] = (ql >= crow16(e, hh)) ? p[e] : 0.f; }
#pragma unroll
            for (int s2 = 0; s2 < 2; ++s2) {
                v4u pw; pw.x = cvtpk(p[8 * s2], p[8 * s2 + 1]); pw.y = cvtpk(p[8 * s2 + 2], p[8 * s2 + 3]); pw.z = cvtpk(p[8 * s2 + 4], p[8 * s2 + 5]); pw.w = cvtpk(p[8 * s2 + 6], p[8 * s2 + 7]);
                const bf16x8_t pb = __builtin_bit_cast(bf16x8_t, pw);
                const int row0 = 32 * jb + 16 * s2 + 4 * hh + q4;
#pragma unroll
                for (int t = 0; t < 2; ++t) { const LAS char* vp = VL + row0 * RVS + (64 * eh + 32 * t + 16 * blk + 4 * p4) * 2;
                    const s16x4_t lo = ldtr(vp), hi = ldtr(vp + 8 * RVS);
                    const bf16x8_t af = __builtin_shufflevector(lo, hi, 0, 1, 2, 3, 4, 5, 6, 7);
                    o[t] = __builtin_amdgcn_mfma_f32_32x32x16_bf16(af, pb, o[t], 0, 0, 0); } }
        }
        float s1 = 0.f, s2 = 0.f;
#pragma unroll
        for (int t = 0; t < 2; ++t)
#pragma unroll
            for (int e = 0; e < 16; ++e) { s1 += o[t][e]; s2 += o[t][e] * o[t][e]; }
        s1 += __shfl_xor(s1, 32); s2 += __shfl_xor(s2, 32);
        if (hh == 0) { ST[((ib * 2 + eh) * 32 + ql) * 2] = s1; ST[((ib * 2 + eh) * 32 + ql) * 2 + 1] = s2; }
        __syncthreads();
        const float t1 = ST[((ib * 2) * 32 + ql) * 2] + ST[((ib * 2 + 1) * 32 + ql) * 2], t2 = ST[((ib * 2) * 32 + ql) * 2 + 1] + ST[((ib * 2 + 1) * 32 + ql) * 2 + 1];
        const float mu = t1 * (1.f / 128.f), var = fmaxf(t2 * (1.f / 128.f) - mu * mu, 0.f), rstd = rsqrtf(var + 1e-5f);
#pragma unroll
        for (int t = 0; t < 2; ++t)
#pragma unroll
            for (int g4 = 0; g4 < 4; ++g4) { v2u yw; yw.x = cvtpk((o[t][4 * g4] - mu) * rstd, (o[t][4 * g4 + 1] - mu) * rstd); yw.y = cvtpk((o[t][4 * g4 + 2] - mu) * rstd, (o[t][4 * g4 + 3] - mu) * rstd);
                *(LAS v2u*)(VL + i * RVS + (64 * eh + 32 * t + 8 * g4 + 4 * hh) * 2) = yw; }
        __syncthreads();
        { const float* gn = a.in(I_GNG) + layer * 512 + h * 128 + qd * 32;
          bf16* op = (bf16*)(a.ws() + WS_XN) + (grow0 + row) * DM + 256 + h * 128 + qd * 32;
#pragma unroll
          for (int c = 0; c < 4; ++c) { float y8[8], g8[8], o8[8]; unpack8(*(const LAS v4u*)(VL + row * RVS + qd * 64 + c * 16), y8); unpack8(gcur[c], g8);
              const f32x4 n0 = *(const f32x4*)(gn + 8 * c), n1 = *(const f32x4*)(gn + 8 * c + 4); const float nn[8] = {n0.x, n0.y, n0.z, n0.w, n1.x, n1.y, n1.z, n1.w};
#pragma unroll
              for (int e = 0; e < 8; ++e) o8[e] = g8[e] * sigmoidf_(g8[e]) * y8[e] * nn[e];
              *(v4u*)(op + 8 * c) = pack8(o8); } }
        __syncthreads();
    }
}
template <int PARTS = 3> DI void ssm_out_unit(const KArgs& a, LAS char* lds, int layer, int unit, int tid) {
    asm volatile("" : "+v"(tid));
    const int chunk = unit & 127, b = unit >> 7, wave = __builtin_amdgcn_readfirstlane(tid >> 6), lane = tid & 63;
    constexpr int ZLD = 528;
    LAS char* ZS = lds; LAS char* XS = lds + 128 * ZLD + wave * (16 * SSM_XLD); LAS char* UWb = lds + 128 * ZLD + 8 * 16 * SSM_XLD + wave * 512;
    const float* sst = (const float*)(a.ws() + WS_SST);
    if (PARTS & 1) for (int gi = 0; gi < 2; ++gi) { const int g = wave + 8 * gi;
        const size_t so = (((size_t)(b * 128 + chunk)) * 1024 + g * 64 + lane) * 2; float hr = sst[so], hi = sst[so + 1];
        ssm_wave_chunk<true>(a, layer, b, chunk, g, XS, UWb, ZS, ZLD, hr, hi, lane); }
    __syncthreads();
    if (!(PARTS & 2)) return;
    const int ql = lane & 31, hh = lane >> 5, n = 32 * wave + ql;
    const bf16* glwt = (const bf16*)(a.ws() + WS_SSM + (size_t)layer * SSM_LAYER_BYTES + SSM_GLWT);
    bf16x8_t bfr[16];
#pragma unroll
    for (int s = 0; s < 16; ++s) bfr[s] = *(const bf16x8_t*)(glwt + (size_t)n * 256 + 16 * s + 8 * hh);
    const float bn = a.in(I_GLB)[layer * 256 + n];
    bf16* mixed = (bf16*)(a.ws() + WS_XN); const size_t grow0 = (size_t)b * SEQ + chunk * 128;
#pragma unroll 1
    for (int rt = 0; rt < 4; ++rt) { f32x16_t acc;
#pragma unroll
        for (int e = 0; e < 16; ++e) acc[e] = 0.f;
#pragma unroll
        for (int s = 0; s < 16; ++s) { const bf16x8_t af = *(const LAS bf16x8_t*)(ZS + (32 * rt + ql) * ZLD + (16 * s + 8 * hh) * 2); acc = __builtin_amdgcn_mfma_f32_32x32x16_bf16(af, bfr[s], acc, 0, 0, 0); }
#pragma unroll
        for (int e = 0; e < 16; ++e) { const int t = 32 * rt + crow16(e, hh); const float z = bf2f(*(const LAS bf16*)(ZS + t * ZLD + n * 2));
            mixed[(grow0 + t) * DM + 768 + n] = (bf16)f2bf(z * sigmoidf_(acc[e] + bn)); } }
    __syncthreads();
}
#ifndef MK_PER_PHASE
#define MK_PER_PHASE 0
#endif

#ifdef DIS_KV
#define TST_KV(x)
#else
#define TST_KV(x) x
#endif
#ifdef DIS_ATT
#define TST_ATT(x)
#else
#define TST_ATT(x) x
#endif
#ifdef DIS_RO
#define TST_RO(x)
#else
#define TST_RO(x) x
#endif
#ifdef DIS_SO
#define TST_SO(x)
#else
#define TST_SO(x) x
#endif
#ifdef DIS_PRO
#define EN_PRO 0
#else
#define EN_PRO 1
#endif
#ifdef DIS_INP
#define EN_INP 0
#else
#define EN_INP 1
#endif
#ifdef DIS_M1
#define EN_M1 0
#else
#define EN_M1 1
#endif
#ifdef DIS_M2
#define EN_M2 0
#else
#define EN_M2 1
#endif
#ifdef DIS_M3
#define EN_M3 0
#else
#define EN_M3 1
#endif
#ifdef DIS_WOUT
#define EN_WOUT 0
#else
#define EN_WOUT 1
#endif
#ifdef DIS_N2
#define EN_N2 0
#else
#define EN_N2 1
#endif
#ifdef DIS_FUP
#define EN_FUP 0
#else
#define EN_FUP 1
#endif
#ifdef DIS_FDN
#define EN_FDN 0
#else
#define EN_FDN 1
#endif
#ifdef DIS_N1
#define EN_N1 0
#else
#define EN_N1 1
#endif
#ifdef DIS_MUP
#define EN_MUP 0
#else
#define EN_MUP 1
#endif
#ifdef DIS_MDN
#define EN_MDN 0
#else
#define EN_MDN 1
#endif

#ifdef DUP_RO
#define PROBE_RO(x) x
#else
#define PROBE_RO(x)
#endif
#ifdef DUP_SO
#define PROBE_SO(x) x
#else
#define PROBE_SO(x)
#endif
#ifndef THIN_REPS
#define THIN_REPS 1
#endif
#ifndef EXTRA_BARS
#define EXTRA_BARS 0
#endif
#ifndef WOUT_REPS
#define WOUT_REPS 1
#endif
#ifndef FDN_REPS
#define FDN_REPS 1
#endif
#ifndef MDN_EPI
#define MDN_EPI pg8::EpiMoeDown
#endif
#ifndef MDN_REPS
#define MDN_REPS 1
#endif
#ifndef RO_REPS
#define RO_REPS 1
#endif
#ifndef INP_REPS
#define INP_REPS 1
#endif
#ifndef FUP_REPS
#define FUP_REPS 1
#endif
#ifndef MUP_REPS
#define MUP_REPS 1
#endif
#ifdef DUP_CONV
#define MOECONV_REPS 2
#else
#define MOECONV_REPS 1
#endif
#ifdef DUP_ATT
#define PROBE_ATT(x) x
#else
#define PROBE_ATT(x)
#endif
#ifdef DUP_KV
#define PROBE_KV(x) x
#else
#define PROBE_KV(x)
#endif
#ifndef ATT_REPS
#define ATT_REPS 1
#endif
#ifndef SO_PARTS
#define SO_PARTS 3
#endif
#ifndef ORDER_SPLIT
#define ORDER_SPLIT 1
#endif
#ifndef CONV_IN_WOUT
#define CONV_IN_WOUT 1
#endif
#define MOE_ITEM(d, it_) do { const int e = (it_) / 5376; int r = (it_) - e * 5376; \
                    if (r < 3584) { const int up = r / 1792; r -= up * 1792; const int kb = r / 112, nb = r % 112, n0 = 32 * nb; \
                        d.W = args.in(up ? I_MU : I_MG) + (size_t)e * DM * DFE; d.ldw = DFE; d.WT = (unsigned char*)(ws + WS_MGU) + (size_t)e * 2 * DFE * DM; d.ldo = DM; d.k0 = 64 * kb; d.n0 = n0; d.drow0 = (n0 >> 7) * 256 + (n0 & 127) + up * 128; d.scale = 32.0f; } \
                    else { r -= 3584; const int kb = r / 32, nb = r % 32; \
                        d.W = args.in(I_MD) + (size_t)e * DFE * DM; d.ldw = DM; d.WT = (unsigned char*)(ws + WS_MDN) + (size_t)e * DM * DFE; d.ldo = DFE; d.k0 = 64 * kb; d.n0 = 32 * nb; d.drow0 = 32 * nb; d.scale = 64.0f; } } while (0)
#define MOE_CONV() do { float* scr = (float*)(L + wave * 16384); constexpr int NIT_ = 8 * 5376; \
                for (int rep_ = 0; rep_ < MOECONV_REPS; ++rep_) \
                    for (int it = gw; it < NIT_; it += 2 * NGW) { const int it2 = (it + NGW < NIT_) ? it + NGW : it;     \
                        T8Item da, db; float va[32], vb[32]; MOE_ITEM(da, it); MOE_ITEM(db, it2); t8_load(va, da, lane); t8_load(vb, db, lane); \
                        t8_store(va, da, scr, lane); t8_store(vb, db, scr, lane); } } while (0)
constexpr int PH_PRO = 0, PH_L0 = 1, PH_PER_LAYER = 13, NPH = 1 + 2 * PH_PER_LAYER;
__global__ void __launch_bounds__(NWAVES * 64, 2) fwd_kernel(Args args_) {
    const KArgs args;
    extern __shared__ __attribute__((aligned(16))) unsigned char lds[];
    const int tid0 = threadIdx.x;
    const int wave0 = __builtin_amdgcn_readfirstlane(tid0 >> 6);
    const int G = gridDim.x, bx = blockIdx.x, NGW = G * NWAVES;
#define PHASE_IDS int wave = wave0; asm volatile("" : "+s"(wave)); unsigned z_ = 0u; asm volatile("" : "+v"(z_)); const int lane = (int)__builtin_amdgcn_mbcnt_hi(~0u, __builtin_amdgcn_mbcnt_lo(~0u, z_)); const int tid = wave * 64 + lane, gw = bx * NWAVES + wave; (void)tid; (void)gw
    unsigned char* ws = args.ws();
    unsigned* ctl = (unsigned*)(ws + WS_CTL);
    volatile LAS unsigned* MISC = (volatile LAS unsigned*)((LAS unsigned char*)lds + MISC_OFF);
    if (tid0 < 32) MISC[tid0] = 0u;
    __syncthreads();
    const int lo = args.ph_lo(), hi = args.ph_hi();
    XcdBarrier bar; bar.bar = ctl + CW_BAR; bar.x = 0; bar.st = nullptr;
    if (hi - lo > 1) bar = xcd_barrier_post(ctl + CW_BAR, MISC + 8, tid0 == 0);
#define IN(k) (lo <= (k) && (k) < hi)
#define SEAM(k) do { if ((k) + 1 < hi) { int w_ = wave0; asm volatile("" : "+s"(w_)); unsigned zz_ = 0u; asm volatile("" : "+v"(zz_)); const int l_ = (int)__builtin_amdgcn_mbcnt_hi(~0u, __builtin_amdgcn_mbcnt_lo(~0u, zz_)); xcd_barrier(bar, (w_ * 64 + l_) == 0); } } while (0)
    char* L = (char*)lds;
    LAS unsigned char* L3 = (LAS unsigned char*)lds;
    bf16* XN = (bf16*)(ws + WS_XN); bf16* PROJ = (bf16*)(ws + WS_PROJ);

    if (EN_PRO && IN(PH_PRO)) { PHASE_IDS; for (int rep_ = 0; rep_ < THIN_REPS; ++rep_) phase_prologue(args, L, gw, NGW, wave, lane); for (int xb_ = 0; xb_ < EXTRA_BARS; ++xb_) SEAM(PH_PRO); SEAM(PH_PRO); }

#define LAYER_BODY(layer) do { \
        const int base = PH_L0 + layer * PH_PER_LAYER; \
         \
        if (EN_INP && IN(base + 0)) { PHASE_IDS; \
            pg8::Gemm g{layer == 0 ? XN : (const bf16*)(ws + WS_XN2), (const bf16*)(ws + WS_WIN) + (size_t)layer * NPROJ * DM, T, NPROJ, DM, DM}; pg8::StaticOrder S; S.init(T, NPROJ, G, bx); \
            LAS float* RS = (LAS float*)((LAS char*)lds + 132096); if (layer == 1) build_rs(RS, S, (const float*)(ws + WS_SSQ), tid); \
            pg8::EpiBf16 E{PROJ, NPROJ, layer == 1 ? RS : (LAS float*)nullptr}; \
            for (int rep_ = 0; rep_ < INP_REPS; ++rep_) pg8::gemm_phase<pg8::EpiBf16, pg8::StaticOrder, true, true, false>(L3, g, S, E, tid); \
            SEAM(base + 0); \
        } \
         \
        if (EN_M1 && IN(base + 1)) { \
            \
          const int og_ = ORDER_SPLIT ? ((bx >> 3) & 1) : 0; \
          _Pragma("unroll 1") for (int s_ = 0; s_ < 3; ++s_) { const int part_ = og_ ? 2 - s_ : s_; \
           if (part_ == 0) { PHASE_IDS; \
            const float* tabA = (const float*)(ws + WS_TABA); \
            prep_phase(PROJ, args.in(I_QNG) + layer * 64, args.in(I_KNG) + layer * 64, tabA, gw, NGW, lane); \
           } else if (part_ == 1) { \
            { PHASE_IDS; TST_KV(for (int u = bx; u < 1024; u += G) ret_kv_unit_mfma(args, (LAS char*)lds, u, tid);) } \
            PROBE_KV({ PHASE_IDS; for (int u = bx; u < 1024; u += G) ret_kv_unit_mfma(args, (LAS char*)lds, u, tid); }) \
           } else { \
            for (int rep_ = 0; rep_ < THIN_REPS; ++rep_) { PHASE_IDS; for (int u = bx; u < 256; u += G) { const int chunk = u & 127, b = u >> 7; LAS char* XS = (LAS char*)lds + wave * (16 * SSM_XLD); LAS char* UWb = (LAS char*)lds + 8 * 16 * SSM_XLD + wave * 512; \
                for (int gi = 0; gi < 2; ++gi) { const int g = wave + 8 * gi; float hr = 0.f, hi_ = 0.f; \
                    ssm_wave_chunk<false>(args, layer, b, chunk, g, XS, UWb, XS, 0, hr, hi_, lane); \
                    float* sst = (float*)(ws + WS_SST) + (((size_t)(b * 128 + chunk)) * 1024 + g * 64 + lane) * 2; sst[0] = hr; sst[1] = hi_; } \
                __syncthreads(); } } \
           } \
           __syncthreads(); } \
            SEAM(base + 1); \
        } \
         \
        if (EN_M2 && IN(base + 2)) { PHASE_IDS; \
            for (int u = bx; u < 128; u += G) {                     \
                const int gid = u * 512 + tid, bh = gid >> 13, el = gid & 8191; const float cd = __expf(ret_loggamma(bh & 3) * 128.0f); \
                float* p = (float*)(ws + WS_KV) + (size_t)bh * 128 * 8192 + el; float st = 0.f; \
                for (int n0 = 0; n0 < 128; n0 += 32) { float x[32]; \
                    _Pragma("unroll") for (int k = 0; k < 32; ++k) x[k] = p[(size_t)(n0 + k) * 8192]; \
                    _Pragma("unroll") for (int k = 0; k < 32; ++k) { p[(size_t)(n0 + k) * 8192] = st; st = cd * st + x[k]; } } } \
            { const int idx = (G >= 128) ? (bx >= 128 ? bx - 128 : bx + G - 128) : bx; \
              for (int u = idx; u < 4; u += G) {                    \
                const int gid = u * 512 + tid, b = gid >> 10, gp = gid & 1023; \
                const float* sp = (const float*)(ws + WS_SSM + (size_t)layer * SSM_LAYER_BYTES); const float ar = sp[SSM_ABARL / 4 + 2 * gp], ai = sp[SSM_ABARL / 4 + 2 * gp + 1]; \
                float* p = (float*)(ws + WS_SST) + ((size_t)b * 128 * 1024 + gp) * 2; float cr = 0.f, ci = 0.f; \
                for (int c0 = 0; c0 < 128; c0 += 32) { f32x2_t xv[32]; \
                    _Pragma("unroll") for (int k = 0; k < 32; ++k) xv[k] = *(const f32x2_t*)(p + (size_t)(c0 + k) * 2048); \
                    _Pragma("unroll") for (int k = 0; k < 32; ++k) { f32x2_t o_; o_.x = cr; o_.y = ci; *(f32x2_t*)(p + (size_t)(c0 + k) * 2048) = o_; const float nr = ar * cr - ai * ci + xv[k].x, ni = ar * ci + ai * cr + xv[k].y; cr = nr; ci = ni; } } } } \
            { PHASE_IDS; \
              if (G == 256) { const int na = bx < 128 ? 5 : 7; const int bx_ = bx; \
                  attn_run(args, (LAS char*)lds, na, [bx_](int k) { return (k < 6) ? bx_ + 256 * k : (bx_ - 128) + 1280; }, tid); } \
              else { const int bx_ = bx, G_ = G; attn_run(args, (LAS char*)lds, (1536 - bx + G - 1) / G, [bx_, G_](int k) { return bx_ + G_ * k; }, tid); } } \
            SEAM(base + 2); \
        } \
         \
        if (EN_M3 && IN(base + 3)) { \
          const int og_ = ORDER_SPLIT ? ((bx >> 3) & 1) : 0; \
          _Pragma("unroll 1") for (int s_ = 0; s_ < 3; ++s_) { const int part_ = og_ ? 2 - s_ : s_; \
           if (part_ == 0) { PHASE_IDS; \
            { const bf16* attp = (const bf16*)(ws + WS_ATTP); const float* lse = (const float*)(ws + WS_LSE); const int h = lane >> 4, sub = lane & 15; \
              for (int rep_ = 0; rep_ < THIN_REPS; ++rep_) for (int t0 = gw; t0 < T; t0 += 4 * NGW) { \
                float ls[4][3]; v2u ow[4][3]; \
                _Pragma("unroll") for (int r = 0; r < 4; ++r) { const int t = t0 + r * NGW; if (t < T) { \
                    _Pragma("unroll") for (int p = 0; p < 3; ++p) { ls[r][p] = lse[((size_t)p * T + t) * 4 + h]; ow[r][p] = *(const v2u*)(attp + ((size_t)p * T + t) * 256 + h * 64 + sub * 4); } } } \
                _Pragma("unroll") for (int r = 0; r < 4; ++r) { const int t = t0 + r * NGW; if (t < T) { \
                    const float M = fmaxf(ls[r][0], fmaxf(ls[r][1], ls[r][2])); const float w0 = __expf(ls[r][0] - M), w1 = __expf(ls[r][1] - M), w2 = __expf(ls[r][2] - M); const float iw = 1.0f / (w0 + w1 + w2); \
                    const float r0 = (w0 * bflo(ow[r][0].x) + w1 * bflo(ow[r][1].x) + w2 * bflo(ow[r][2].x)) * iw, r1 = (w0 * bfhi(ow[r][0].x) + w1 * bfhi(ow[r][1].x) + w2 * bfhi(ow[r][2].x)) * iw; \
                    const float r2 = (w0 * bflo(ow[r][0].y) + w1 * bflo(ow[r][1].y) + w2 * bflo(ow[r][2].y)) * iw, r3 = (w0 * bfhi(ow[r][0].y) + w1 * bfhi(ow[r][1].y) + w2 * bfhi(ow[r][2].y)) * iw; \
                    v2u w; w.x = pk2(r0, r1); w.y = pk2(r2, r3); *(v2u*)(XN + (size_t)t * DM + h * 64 + sub * 4) = w; } } } } \
           } else if (part_ == 1) { \
            for (int rep_ = 0; rep_ < RO_REPS; ++rep_) { PHASE_IDS; const int bx_ = bx, G_ = G; ret_out_run(args, (LAS char*)lds, layer, (1024 - bx + G - 1) / G, [bx_, G_](int k) { return bx_ + G_ * k; }, tid); } \
           } else { \
            { PHASE_IDS; TST_SO(for (int u = bx; u < 256; u += G) ssm_out_unit(args, (LAS char*)lds, layer, u, tid);) } \
            PROBE_SO({ PHASE_IDS; for (int u = bx; u < 256; u += G) ssm_out_unit<SO_PARTS>(args, (LAS char*)lds, layer, u, tid); }) \
           } \
           __syncthreads(); } \
            SEAM(base + 3); \
        } \
         \
        if (EN_WOUT && IN(base + 4)) { \
              \
            const int cgrp = (bx >> 3) & 1; \
            if (CONV_IN_WOUT && layer == 1 && cgrp == 0) { PHASE_IDS; MOE_CONV(); __syncthreads(); } \
            { PHASE_IDS; \
            pg8::Gemm g{XN, (const bf16*)(ws + WS_WOUT) + (size_t)layer * DM * DM, T, DM, DM, DM}; pg8::StaticOrder S; S.init(T, DM, G, bx); \
            for (int rep_ = 0; rep_ < WOUT_REPS; ++rep_) { pg8::EpiResF32 E{(layer == 0 && rep_ == 0) ? args.in(I_X) : args.out(), args.out(), DM, rep_ == WOUT_REPS - 1 ? 1.0f : 0.0f, layer == 0 ? (bf16*)(ws + WS_XN2) : (bf16*)nullptr, args.in(I_N2G), (float*)(ws + WS_SSQ)}; \
            pg8::gemm_phase<pg8::EpiResF32, pg8::StaticOrder, true, true, false>(L3, g, S, E, tid); } } \
            if (CONV_IN_WOUT && layer == 1 && cgrp == 1) { PHASE_IDS; __syncthreads(); MOE_CONV(); } \
            SEAM(base + 4); \
        } \
         \
        if (EN_N2 && layer == 1 && IN(base + 5)) { PHASE_IDS; \
            const float* g2 = args.in(I_N2G) + layer * DM; \
            if (layer == 1) { \
                int* sel_e = (int*)(L + 140000); float* sel_g = (float*)(L + 141024); int* lpair = (int*)(L + 142176); int* lpbase = (int*)(L + 142432); \
                float rw[16][8]; \
        _Pragma("unroll") \
                for (int j = 0; j < 4; ++j) \
        _Pragma("unroll") \
                    for (int c = 0; c < 4; ++c) { const f32x4* rp = (const f32x4*)(args.in(I_RT) + (size_t)(4 * lane + c + 256 * j) * 8); const f32x4 r0 = rp[0], r1 = rp[1]; \
                        rw[j * 4 + c][0] = r0.x; rw[j * 4 + c][1] = r0.y; rw[j * 4 + c][2] = r0.z; rw[j * 4 + c][3] = r0.w; rw[j * 4 + c][4] = r1.x; rw[j * 4 + c][5] = r1.y; rw[j * 4 + c][6] = r1.z; rw[j * 4 + c][7] = r1.w; } \
                f32x4 gg2[4]; \
                _Pragma("unroll") for (int j = 0; j < 4; ++j) gg2[j] = ((const f32x4*)g2)[lane + 64 * j]; \
                for (int u = bx; u < T / 128; u += G) { \
                    if (tid < 64) lpair[tid] = 0; \
                    for (int rr = 0; rr < 16; rr += 2) { f32x4 v[2][4]; \
                        _Pragma("unroll") for (int q_ = 0; q_ < 2; ++q_) { const int m = u * 128 + wave * 16 + rr + q_; \
                            _Pragma("unroll") for (int j = 0; j < 4; ++j) v[q_][j] = ((const f32x4*)(args.out() + (size_t)m * DM))[lane + 64 * j]; } \
                        _Pragma("unroll") for (int q_ = 0; q_ < 2; ++q_) { const int rl = wave * 16 + rr + q_, m = u * 128 + rl; float ss = 0.f; \
                            _Pragma("unroll") for (int j = 0; j < 4; ++j) ss += (v[q_][j].x * v[q_][j].x + v[q_][j].y * v[q_][j].y) + (v[q_][j].z * v[q_][j].z + v[q_][j].w * v[q_][j].w); \
                            const float rs = rsqrtf(wave_sum(ss) * (1.f / DM) + 1e-6f); \
                            _Pragma("unroll") for (int j = 0; j < 4; ++j) { v[q_][j] = v[q_][j] * rs * gg2[j]; ((unsigned*)((unsigned char*)XN + (size_t)m * DM))[lane + 64 * j] = pg8::pk4_fp8(v[q_][j].x, v[q_][j].y, v[q_][j].z, v[q_][j].w); } \
                            float pl[8]; \
                            _Pragma("unroll") for (int e = 0; e < 8; ++e) { float s = 0.f; \
                                _Pragma("unroll") for (int j = 0; j < 4; ++j) s += v[q_][j].x * rw[j * 4 + 0][e] + v[q_][j].y * rw[j * 4 + 1][e] + v[q_][j].z * rw[j * 4 + 2][e] + v[q_][j].w * rw[j * 4 + 3][e]; \
                                pl[e] = s; } \
                            const bool b5 = (lane & 32) != 0, b4 = (lane & 16) != 0, b3 = (lane & 8) != 0; float w4[4], w2[2], w1; \
                            _Pragma("unroll") for (int k = 0; k < 4; ++k) { const float send = b5 ? pl[k] : pl[k + 4], keep = b5 ? pl[k + 4] : pl[k]; w4[k] = keep + __shfl_xor(send, 32); } \
                            _Pragma("unroll") for (int k = 0; k < 2; ++k) { const float send = b4 ? w4[k] : w4[k + 2], keep = b4 ? w4[k + 2] : w4[k]; w2[k] = keep + __shfl_xor(send, 16); } \
                            { const float send = b3 ? w2[0] : w2[1], keep = b3 ? w2[1] : w2[0]; w1 = keep + __shfl_xor(send, 8); } \
                            w1 += __shfl_xor(w1, 4); w1 += __shfl_xor(w1, 2); w1 += __shfl_xor(w1, 1); \
                            float lg[8]; \
                            _Pragma("unroll") for (int e = 0; e < 8; ++e) lg[e] = __builtin_bit_cast(float, __builtin_amdgcn_readlane(__builtin_bit_cast(int, w1), 8 * e)); \
                            int e0 = 0; float l0 = lg[0]; \
                            _Pragma("unroll") for (int e = 1; e < 8; ++e) if (lg[e] > l0) { l0 = lg[e]; e0 = e; } \
                            int e1 = -1; float l1 = -INFINITY; \
                            _Pragma("unroll") for (int e = 0; e < 8; ++e) if (e != e0 && lg[e] > l1) { l1 = lg[e]; e1 = e; } \
                            const float g0 = 1.0f / (1.0f + __expf(l1 - l0)); \
                            if (lane == 0) { sel_e[rl * 2] = e0; sel_e[rl * 2 + 1] = e1; sel_g[rl * 2] = g0; sel_g[rl * 2 + 1] = 1.0f - g0; } } } \
                    __syncthreads(); \
                    int pr = 0, ppos = 0; \
                    if (tid < 128) { pr = sel_e[tid * 2] * 8 + sel_e[tid * 2 + 1]; ppos = atomicAdd(&lpair[pr], 1); } \
                    __syncthreads(); \
                    if (tid < 64) lpbase[tid] = (int)__hip_atomic_fetch_add(ctl + CW_PAIRCNT + tid, (unsigned)lpair[tid], __ATOMIC_RELAXED, __HIP_MEMORY_SCOPE_AGENT); \
                    __syncthreads(); \
                    if (tid < 128) { v4u ti; ti.x = (unsigned)(sel_e[tid * 2] | (sel_e[tid * 2 + 1] << 8)); ti.y = (unsigned)(lpbase[pr] + ppos); ti.z = __float_as_uint(sel_g[tid * 2]); ti.w = __float_as_uint(sel_g[tid * 2 + 1]); \
                        ((v4u*)(ws + WS_TOKINFO))[u * 128 + tid] = ti; } \
                    __syncthreads(); \
                } \
                if (!CONV_IN_WOUT) { MOE_CONV(); } \
            } \
            SEAM(base + 5); \
        } \
        if (layer == 1 && IN(base + 6)) { PHASE_IDS; \
            int* sel_e = (int*)(L + 140000); float* sel_g = (float*)(L + 141024); int* lcnt = (int*)(L + 142048); int* lbase = (int*)(L + 142112); int* fl = (int*)(L + 142688); int* pc = (int*)(L + 142944); int* pa = (int*)(L + 143200); \
            int* tokmap = (int*)(ws + WS_MAPS); float* gatemap = (float*)(ws + WS_MAPS + 2 * MiB); \
            if (tid < 64) { pc[tid] = (int)__hip_atomic_load(ctl + CW_PAIRCNT + tid, __ATOMIC_RELAXED, __HIP_MEMORY_SCOPE_AGENT); fl[tid] = 0; } \
            __syncthreads(); \
            if (tid == 0) { int rsum = 0; \
                for (int i = 0; i < 8; ++i) { int a_ = 0; for (int j = 0; j < 8; ++j) a_ += pc[i * 8 + j]; pa[i] = a_; pa[8 + i] = a_ & 255; pa[16 + i] = -(a_ & 255); rsum += a_ & 255; } \
                for (int m_ = rsum >> 8; m_ > 0; --m_) { int best = -1, bv = -1; for (int i = 0; i < 8; ++i) if (pa[16 + i] <= 0 && pa[8 + i] > bv) { bv = pa[8 + i]; best = i; } if (best >= 0) pa[16 + best] = 256 - pa[8 + best]; } \
                for (int i = 0; i < 8; ++i) if (pa[16 + i] < 0) { int s_ = -pa[16 + i]; \
                    for (int j = 0; j < 8 && s_ > 0; ++j) if (j != i && pa[16 + j] > 0) { int x_ = s_ < pa[16 + j] ? s_ : pa[16 + j]; if (x_ > pc[i * 8 + j]) x_ = pc[i * 8 + j]; fl[i * 8 + j] = x_; s_ -= x_; pa[16 + j] -= x_; } } } \
            __syncthreads(); \
            for (int u = bx; u < T / 128; u += G) { \
                if (tid < 16) lcnt[tid] = 0; \
                if (tid < 128) { const v4u ti = ((const v4u*)(ws + WS_TOKINFO))[u * 128 + tid]; const int e0 = (int)(ti.x & 255u), e1 = (int)((ti.x >> 8) & 255u); const bool flip = (int)ti.y < fl[e0 * 8 + e1]; \
                    sel_e[tid * 2] = flip ? e1 : e0; sel_e[tid * 2 + 1] = flip ? e0 : e1; sel_g[tid * 2] = __uint_as_float(flip ? ti.w : ti.z); sel_g[tid * 2 + 1] = __uint_as_float(flip ? ti.z : ti.w); } \
                __syncthreads(); \
                int e = 0, posv = 0; const int rl = tid >> 1, r = tid & 1; \
                if (tid < 256) { e = sel_e[rl * 2 + r]; posv = atomicAdd(&lcnt[r * 8 + e], 1); } \
                __syncthreads(); \
                if (tid < 16) lbase[tid] = (int)__hip_atomic_fetch_add(ctl + CW_MOECNT + tid, (unsigned)lcnt[tid], __ATOMIC_RELAXED, __HIP_MEMORY_SCOPE_AGENT); \
                __syncthreads(); \
                if (tid < 256) { const int slot = lbase[r * 8 + e] + posv; tokmap[(size_t)(r * 8 + e) * 32768 + slot] = u * 128 + rl; gatemap[(size_t)(r * 8 + e) * 32768 + slot] = sel_g[rl * 2 + r]; } \
                __syncthreads(); \
            } \
            SEAM(base + 6); \
        } \
        if (layer == 0) { \
             \
            if (EN_FUP && IN(base + 6)) { PHASE_IDS; \
                pg8::Gemm g{(const bf16*)(ws + WS_XN2), (const bf16*)(ws + WS_FGU), T, 2 * DFF, DM, DM}; pg8::StaticOrder S; S.init(T, 2 * DFF, G, bx); \
                LAS float* RS = (LAS float*)((LAS char*)lds + 132096); build_rs(RS, S, (const float*)(ws + WS_SSQ), tid); \
                pg8::EpiSwiGLU E{(bf16*)(ws + WS_ACT), DFF, RS}; \
                for (int rep_ = 0; rep_ < FUP_REPS; ++rep_) pg8::gemm_phase<pg8::EpiSwiGLU, pg8::StaticOrder, true, true, false>(L3, g, S, E, tid); \
                SEAM(base + 6); \
            } \
            if (EN_FDN && IN(base + 7)) { PHASE_IDS; \
                pg8::Gemm g{(const bf16*)(ws + WS_ACT), (const bf16*)(ws + WS_FDN), T, DM, DFF, DFF}; pg8::StaticOrder S; S.init(T, DM, G, bx); \
                for (int rep_ = 0; rep_ < FDN_REPS; ++rep_) { pg8::EpiResF32 E{args.out(), args.out(), DM, rep_ == FDN_REPS - 1 ? 1.0f : 0.0f, (bf16*)(ws + WS_XN2), args.in(I_N1G) + DM, (float*)(ws + WS_SSQ)}; \
                pg8::gemm_phase<pg8::EpiResF32, pg8::StaticOrder, true, true, false>(L3, g, S, E, tid); } \
                SEAM(base + 7); \
            } \
        } else { \
             \
          \
        const int mgrp = (bx >> 3) & 1; \
        _Pragma("unroll 1") \
            for (int st = 0; st < 4; ++st) { \
                const bool is_up = (st == 0) || (st == 1 && mgrp == 0) || (st == 2 && mgrp == 1); const int r = (st == 0) ? 0 : (st == 3) ? 1 : (is_up ? 1 : 0); \
                const int* tokmap = (const int*)(ws + WS_MAPS) + (size_t)r * 8 * 32768; const float* gatemap = (const float*)(ws + WS_MAPS + 2 * MiB) + (size_t)r * 8 * 32768; \
                unsigned char* mact = ws + (r == 0 ? WS_MACT : WS_MACT2); \
                if (is_up) { if (EN_MUP && IN(base + 7)) { PHASE_IDS; \
                    pg8::Gemm g{XN, (const bf16*)(ws + WS_MGU), 0, 2 * DFE, DM, DM}; pg8::MoeOrder S; S.init_moe(ctl + CW_MOECNT + r * 8, tokmap, 2 * DFE, G, bx); S.build_ltab((LAS int*)((LAS char*)lds + 132096), tid); \
                    pg8::EpiSwiGLU8 E{mact, DFE, 1.0f / 32.0f, 4.0f}; \
                    for (int rep_ = 0; rep_ < MUP_REPS; ++rep_) pg8::gemm_phase<pg8::EpiSwiGLU8, pg8::MoeOrder, true, true, true, true>(L3, g, S, E, tid); \
                } } else { if (EN_MDN && IN(base + 7)) { PHASE_IDS; \
                    pg8::Gemm g{(const bf16*)mact, (const bf16*)(ws + WS_MDN), 0, DM, DFE, DFE}; pg8::MoeOrder S; S.init_moe(ctl + CW_MOECNT + r * 8, tokmap, DM, G, bx, r == 1 ? 128 : (1 << 20)); \
                    for (int rep_ = 0; rep_ < MDN_REPS; ++rep_) { MDN_EPI E{args.out(), DM, tokmap, gatemap, rep_ == MDN_REPS - 1 ? (1.0f / 256.0f) : 0.0f}; \
                    pg8::gemm_phase<MDN_EPI, pg8::MoeOrder, true, true, false, true>(L3, g, S, E, tid); } \
                    if (r == 1) { pg8::MoeOrder SA; SA.init_moe(ctl + CW_MOECNT + r * 8, tokmap, DM, G, bx); const int ntl = (SA.tiles() - 128) * 4; const int KS = ntl <= 18 ? 14 : 7;     \
                      pg8::MoeTailOrder ST; ST.init(&SA, G, bx, KS, DFE / KS, 32); \
                      pg8::Gemm gt{(const bf16*)mact, (const bf16*)(ws + WS_MDN), 0, DM, DFE / KS, DFE}; pg8::EpiPart EP{(float*)(ws + WS_XN)}; \
                      pg8::gemm_phase<pg8::EpiPart, pg8::MoeTailOrder, true, true, false, true>(L3, gt, ST, EP, tid); } \
                } } \
                __syncthreads(); \
                if (st != 1) SEAM(base + 7 + st); \
            } \
            { const int r = 1; const int* tokmap = (const int*)(ws + WS_MAPS) + (size_t)r * 8 * 32768; const float* gatemap = (const float*)(ws + WS_MAPS + 2 * MiB) + (size_t)r * 8 * 32768; \
                if (EN_MDN && IN(base + 12)) { PHASE_IDS; \
                    pg8::MoeOrder SA; SA.init_moe(ctl + CW_MOECNT + r * 8, tokmap, DM, G, bx); int ntl = (SA.tiles() - 128) * 4; ntl = ntl < 0 ? 0 : (ntl > 32 ? 32 : ntl); const int KS = ntl <= 18 ? 14 : 7; \
                    const float* part = (const float*)(ws + WS_XN); float* outp = args.out(); \
                    for (int gi = bx * 512 + tid; gi < ntl * 16384; gi += G * 512) { const int t = gi >> 14, row = (gi >> 6) & 255, c4 = gi & 63; \
                        pg8::Unit u; u.pm = 128 + (t >> 2); u.pn = t & 3; SA.decode(u); const int slot = u.r0 + row; \
                        if (slot < u.cn) { const int tk = tokmap[u.e * 32768 + slot]; const float gt_ = gatemap[u.e * 32768 + slot]; \
                            f32x4 s = (f32x4){0.f, 0.f, 0.f, 0.f}; \
                            for (int ks = 0; ks < KS; ++ks) s = s + *(const f32x4*)(part + (size_t)(t * KS + ks) * 65536 + row * 256 + c4 * 4); \
                            float* op = outp + (size_t)tk * DM + u.pn * 256 + c4 * 4; *(f32x4*)op = *(const f32x4*)op + s * (gt_ * (1.0f / 256.0f)); } } \
                    SEAM(base + 12); \
                } \
            } \
        } \
    } while (0)
    LAYER_BODY(0);
    LAYER_BODY(1);
#undef LAYER_BODY
#undef IN
#undef SEAM
}

extern "C" void kernel_launch(void* const* d_in, const int* in_sizes, int n_in, void* d_out, int out_size, void* d_ws, size_t ws_size, hipStream_t stream) {
    static int grid = 0;
    if (grid == 0) {
        if (n_in != 25 || in_sizes[0] != T * DM || out_size != T * DM || ws_size < WS_END) { fprintf(stderr, "kernel_launch: unexpected shapes (n_in %d, in0 %d, out %d, ws %zu); nothing launched\n", n_in, n_in > 0 ? in_sizes[0] : -1, out_size, ws_size); grid = -1; return; }
        int dev = 0, cus = 0, per_cu = 0;
        if (hipGetDevice(&dev) != hipSuccess || hipDeviceGetAttribute(&cus, hipDeviceAttributeMultiprocessorCount, dev) != hipSuccess) { grid = -1; return; }
        if (hipFuncSetAttribute((const void*)fwd_kernel, hipFuncAttributeMaxDynamicSharedMemorySize, LDS_BYTES) != hipSuccess) { fprintf(stderr, "kernel_launch: hipFuncSetAttribute failed\n"); grid = -1; return; }
        if (hipOccupancyMaxActiveBlocksPerMultiprocessor(&per_cu, (const void*)fwd_kernel, NWAVES * 64, LDS_BYTES) != hipSuccess || per_cu < 1) { fprintf(stderr, "kernel_launch: occupancy query reports %d blocks per CU\n", per_cu); }
        (void)hipGetLastError();
        grid = cus;
    }
    if (grid < 0) return;
    (void)hipMemsetAsync((char*)d_ws + WS_CTL, 0, CTL_ZERO_BYTES, stream);
    Args a{};
    for (int i = 0; i < 25; ++i) a.in[i] = (const float*)d_in[i];
    a.out = (float*)d_out; a.ws = (unsigned char*)d_ws;
#if MK_PER_PHASE
    for (int p = 0; p < NPH; ++p) { if (p == PH_L0 + 6 + 3 || p == PH_L0 + 6 + 4) continue; a.ph_lo = p; a.ph_hi = p + 1; hipLaunchKernelGGL(fwd_kernel, dim3(grid), dim3(NWAVES * 64), LDS_BYTES, stream, a); }
#else
    a.ph_lo = 0; a.ph_hi = NPH; hipLaunchKernelGGL(fwd_kernel, dim3(grid), dim3(NWAVES * 64), LDS_BYTES, stream, a);
#endif
}
```

```cpp
#include <hip/hip_runtime.h>
#include <cstdio>
#include <cstdint>
namespace pg8 {
#define PG8_LAS __attribute__((address_space(3)))
typedef unsigned short bf16_t;
typedef short bf16x8 __attribute__((ext_vector_type(8)));
typedef float f32x4 __attribute__((ext_vector_type(4)));
typedef unsigned u32x4 __attribute__((ext_vector_type(4)));
typedef int i32x4 __attribute__((ext_vector_type(4)));
constexpr int BM = 256, BK = 64, HALF = 128, HTB = HALF * BK * 2  , STAGE_BYTES = 8 * HTB, NXCD = 8, WGM = 8;

__host__ __device__ __forceinline__ int lds_byte(int r, int c) { const int st = (r >> 4) * 2 + (c >> 5), rr = r & 15, cc = c & 31, ob = rr * 64 + cc * 2; return st * 1024 + (ob ^ (((ob >> 9) & 1) << 5)); }
__host__ __device__ __forceinline__ void stage_rc(int b, int& R, int& C) { const int st = b / 1024, sb = b % 1024, swz = sb ^ (((sb >> 9) & 1) << 5); R = (st >> 1) * 16 + swz / 64; C = (st & 1) * 32 + (swz % 64) / 2; }
__host__ __device__ __forceinline__ int perm32(int rho) { const int n = rho >> 4, i = rho & 15; return 8 * (i >> 2) + 4 * n + (i & 3); }

struct Unit { int pm, pn, pb, e, r0, cn, koff, aux; };
struct Gemm { const bf16_t* A; const bf16_t* Bt; int M, N, K, ld; };

struct StaticOrder {
    int nM, nN, nwg, G, c;
    __host__ __device__ void init(int M, int N, int G_, int c_) { nM = M / BM; nN = N / BM; nwg = nM * nN; G = G_; c = c_; }
    __host__ __device__ bool next(int i, Unit& u) const {
        const long L = (long)i * G + c; if (L >= nwg) return false;
        int wgid = (int)L; { const int q = nwg / NXCD, r = nwg % NXCD, xcd = wgid % NXCD, off = wgid / NXCD; wgid = (xcd < r ? xcd * (q + 1) : r * (q + 1) + (xcd - r) * q) + off; }
        const int nig = WGM * nN, gid = wgid / nig, fm = gid * WGM, gsz = (nM - fm) < WGM ? (nM - fm) : WGM;
        u.pm = fm + ((wgid % nig) % gsz); u.pn = (wgid % nig) / gsz; u.pb = u.pn; u.e = 0; u.r0 = 0; u.cn = 0; u.koff = 0; u.aux = 0; return true;
    }
    __device__ __forceinline__ void a_ready(const Unit&) const {}
    __device__ __forceinline__ void done(const Unit&) const {}
    __device__ __forceinline__ int arow(const Unit&, int) const { return 0; }
};

__device__ __forceinline__ unsigned cvt_pk_bf16(float lo, float hi) { unsigned r; asm volatile("v_cvt_pk_bf16_f32 %0, %1, %2" : "=v"(r) : "v"(lo), "v"(hi)); return r; }

template <class Epi, class Sched, bool ALIGN_EPI = false, bool SP2 = false, bool GATHER = false, bool FP8 = false>
__device__ __forceinline__ void gemm_phase(PG8_LAS unsigned char* lds, const Gemm g, const Sched& S, const Epi& E, int tid) {
    asm volatile("" : "+v"(tid));
    const int wid = __builtin_amdgcn_readfirstlane(tid >> 6), lane = tid & 63, wr = wid >> 2, wc = wid & 3, fr = lane & 15, fq = lane >> 4;
    constexpr int ES = FP8 ? 1 : 2;
    const int K = g.ld, nt = (g.K * ES) / (BK * 2);
    unsigned voffA[2][2], voffN[2][2], voffB[2];
    const size_t kstep = (size_t)(BK * 2);
    const size_t hstep = (size_t)HALF * K * ES;
    const size_t tstep = 2 * hstep;
#pragma unroll
    for (int i = 0; i < 2; ++i) { int R, C; stage_rc(tid * 16 + i * 8192, R, C); const int Rb = Epi::PERM ? ((R & ~31) + perm32(R & 31)) : R;
        voffA[0][i] = (unsigned)(R * K * ES + C * 2); voffA[1][i] = voffA[0][i]; voffN[0][i] = voffA[0][i]; voffN[1][i] = voffA[0][i]; voffB[i] = (unsigned)(Rb * K * ES + C * 2); }
    const unsigned ldsw = (unsigned)wid * 1024u;
    const int aoff = lds_byte(wr * 64 + fr, fq * 8), boff = lds_byte(wc * 32 + fr, fq * 8);
#define PG8_SA(b, h) (((b) * 2 + (h)) * HTB)
#define PG8_SB(b, h) ((4 + (b) * 2 + (h)) * HTB)
#define PG8_STAGE(bufoff, gbase, voff) do { _Pragma("unroll") for (int _i = 0; _i < 2; ++_i) \
        __builtin_amdgcn_global_load_lds((const unsigned*)((const char*)(gbase) + (voff)[_i]), (PG8_LAS unsigned*)(lds + (bufoff) + ldsw + _i * 8192), 16, 0, 0); } while (0)
#define PG8_CAT8(x0, x1) __builtin_shufflevector(__builtin_bit_cast(i32x4, (x0)), __builtin_bit_cast(i32x4, (x1)), 0, 1, 2, 3, 4, 5, 6, 7)
#define PG8_STAGE_A(bufoff, gbase, h) do { if constexpr (GATHER) { PG8_STAGE(bufoff, gbase, voffA[h]); } else { PG8_STAGE(bufoff, (gbase) + (h) * hstep, voffA[0]); } } while (0)
#define PG8_LDA(dst, b, h) do { _Pragma("unroll") for (int m = 0; m < 4; ++m) { \
        if constexpr (FP8) { dst##8[m] = PG8_CAT8(*(const PG8_LAS bf16x8*)(lds + PG8_SA(b, h) + aoff + m * 2048), *(const PG8_LAS bf16x8*)(lds + PG8_SA(b, h) + aoff + m * 2048 + 1024)); } \
        else { _Pragma("unroll") for (int k = 0; k < 2; ++k) dst[m][k] = *(const PG8_LAS bf16x8*)(lds + PG8_SA(b, h) + aoff + m * 2048 + k * 1024); } } } while (0)
#define PG8_LDB(dst, b, h) do { _Pragma("unroll") for (int n = 0; n < 2; ++n) { \
        if constexpr (FP8) { dst##8[n] = PG8_CAT8(*(const PG8_LAS bf16x8*)(lds + PG8_SB(b, h) + boff + n * 2048), *(const PG8_LAS bf16x8*)(lds + PG8_SB(b, h) + boff + n * 2048 + 1024)); } \
        else { _Pragma("unroll") for (int k = 0; k < 2; ++k) dst[n][k] = *(const PG8_LAS bf16x8*)(lds + PG8_SB(b, h) + boff + n * 2048 + k * 1024); } } } while (0)
#define PG8_MMA(ai, bj, At, Bt) do { __builtin_amdgcn_s_setprio(1); \
        if constexpr (FP8) { _Pragma("unroll") for (int m = 0; m < 4; ++m) _Pragma("unroll") for (int n = 0; n < 2; ++n) \
            asm volatile("v_mfma_scale_f32_16x16x128_f8f6f4 %0, %1, %2, %0, %3, %3 op_sel_hi:[0,0,0]" : "+v"(acc[ai][bj][m][n]) : "v"(Bt##8[n]), "v"(At##8[m]), "v"(sc127)); } \
        else { _Pragma("unroll") for (int m = 0; m < 4; ++m) _Pragma("unroll") for (int n = 0; n < 2; ++n) _Pragma("unroll") for (int k = 0; k < 2; ++k) \
            acc[ai][bj][m][n] = __builtin_amdgcn_mfma_f32_16x16x32_bf16(Bt[n][k], At[m][k], acc[ai][bj][m][n], 0, 0, 0); } \
        __builtin_amdgcn_s_setprio(0); } while (0)
#define PG8_WAIT_V(n) asm volatile("s_waitcnt vmcnt(" #n ")" ::: "memory")
#define PG8_WAIT_L(n) asm volatile("s_waitcnt lgkmcnt(" #n ")" ::: "memory")
#define PG8_BAR __builtin_amdgcn_s_barrier()
#define PG8_SCHED __builtin_amdgcn_sched_barrier(0)
#define PG8_GOFF(vo, u) do { if constexpr (GATHER) { _Pragma("unroll") for (int _h = 0; _h < 2; ++_h) _Pragma("unroll") for (int _i = 0; _i < 2; ++_i) \
        { int _R, _C; stage_rc(tid * 16 + _i * 8192, _R, _C); vo[_h][_i] = (unsigned)S.arow((u), _h * HALF + _R) * (unsigned)(K * ES) + (unsigned)_C * 2u; } } } while (0)
    Unit cur, nxt; int ui = 0;
    if (!S.next(0, cur)) return;
    f32x4 acc[2][2][4][2];
#pragma unroll
    for (int a = 0; a < 2; ++a)
#pragma unroll
        for (int b = 0; b < 2; ++b)
#pragma unroll
            for (int m = 0; m < 4; ++m)
#pragma unroll
                for (int n = 0; n < 2; ++n) acc[a][b][m][n] = (f32x4){0.f, 0.f, 0.f, 0.f};
    bf16x8 At[4][2], B0[2][2], B1[2][2];
    typedef int i32x8 __attribute__((ext_vector_type(8))); i32x8 At8[4], B08[2], B18[2]; int sc127 = 127; asm volatile("" : "+v"(sc127));
    const char* cA = (const char*)g.A + (GATHER ? (size_t)0 : (size_t)cur.pm * tstep) + (size_t)cur.koff * ES; const char* cB = (const char*)g.Bt + (size_t)cur.pb * tstep + (size_t)cur.koff * ES;
    S.a_ready(cur);
    PG8_GOFF(voffA, cur);
    if constexpr (SP2) {
        PG8_STAGE(PG8_SB(0, 0), cB, voffB); PG8_STAGE(PG8_SB(0, 1), cB + hstep, voffB); PG8_STAGE_A(PG8_SA(0, 0), cA, 0); PG8_STAGE_A(PG8_SA(0, 1), cA, 1);
        if (wr == 1) PG8_BAR;
        PG8_WAIT_V(2); PG8_BAR;
        PG8_STAGE(PG8_SB(1, 0), cB + kstep, voffB); PG8_STAGE_A(PG8_SA(1, 0), cA + kstep, 0); PG8_STAGE(PG8_SB(1, 1), cB + hstep + kstep, voffB);
        PG8_WAIT_V(6); PG8_BAR;
    } else {
        PG8_STAGE(PG8_SB(0, 0), cB, voffB); PG8_STAGE_A(PG8_SA(0, 0), cA, 0); PG8_STAGE(PG8_SB(0, 1), cB + hstep, voffB); PG8_STAGE_A(PG8_SA(0, 1), cA, 1);
        if (wr == 1) PG8_BAR;
        PG8_WAIT_V(4); PG8_BAR;
        PG8_STAGE(PG8_SB(1, 0), cB + kstep, voffB); PG8_STAGE_A(PG8_SA(1, 0), cA + kstep, 0); PG8_STAGE(PG8_SB(1, 1), cB + hstep + kstep, voffB);
        PG8_WAIT_V(6); PG8_BAR;
    }
    for (;;) {
        const bool has_next = S.next(ui + 1, nxt);
        const char* nA = (has_next && !GATHER) ? (const char*)g.A + (size_t)nxt.pm * tstep + (size_t)nxt.koff * ES : cA; const char* nB = has_next ? (const char*)g.Bt + (size_t)nxt.pb * tstep + (size_t)nxt.koff * ES : cB;
        if constexpr (GATHER) { if (has_next) { PG8_GOFF(voffN, nxt); } else { _Pragma("unroll") for (int _h = 0; _h < 2; ++_h) _Pragma("unroll") for (int _i = 0; _i < 2; ++_i) voffN[_h][_i] = voffA[_h][_i]; } }
        for (int t = 0; t < nt; t += 2) {
            const bool last = (t == nt - 2);
            const char* a1 = cA + (size_t)(t + 1) * kstep;
            const char* a2 = last ? nA : cA + (size_t)(t + 2) * kstep; const char* b2 = last ? nB : cB + (size_t)(t + 2) * kstep;
            const char* a3 = a2 + kstep; const char* b3 = b2 + kstep;
            if (last && has_next) S.a_ready(nxt);
            if constexpr (SP2) {
            PG8_LDB(B0, 0, 0); PG8_LDB(B1, 0, 1); PG8_SCHED; PG8_LDA(At, 0, 0); PG8_STAGE_A(PG8_SA(1, 1), a1, 1);
            if constexpr (GATHER) { if (last) { _Pragma("unroll") for (int _h = 0; _h < 2; ++_h) _Pragma("unroll") for (int _i = 0; _i < 2; ++_i) voffA[_h][_i] = voffN[_h][_i]; } }
            PG8_WAIT_V(8); PG8_WAIT_L(0); PG8_BAR; PG8_MMA(0, 0, At, B0); PG8_MMA(0, 1, At, B1); PG8_BAR; PG8_SCHED;
            PG8_LDA(At, 0, 1); PG8_STAGE(PG8_SB(0, 0), b2, voffB); PG8_STAGE(PG8_SB(0, 1), b2 + hstep, voffB); PG8_STAGE_A(PG8_SA(0, 0), a2, 0);
            PG8_WAIT_V(8); PG8_WAIT_L(0); PG8_BAR; PG8_MMA(1, 0, At, B0); PG8_MMA(1, 1, At, B1); PG8_BAR; PG8_SCHED;
            PG8_LDB(B0, 1, 0); PG8_LDB(B1, 1, 1); PG8_SCHED; PG8_LDA(At, 1, 0); PG8_STAGE_A(PG8_SA(0, 1), a2, 1);
            PG8_WAIT_V(8); PG8_WAIT_L(0); PG8_BAR; PG8_MMA(0, 0, At, B0); PG8_MMA(0, 1, At, B1); PG8_BAR; PG8_SCHED;
            PG8_LDA(At, 1, 1); PG8_STAGE(PG8_SB(1, 0), b3, voffB); PG8_STAGE(PG8_SB(1, 1), b3 + hstep, voffB); PG8_STAGE_A(PG8_SA(1, 0), a3, 0);
            PG8_WAIT_V(8); PG8_WAIT_L(0); PG8_BAR; PG8_MMA(1, 0, At, B0); PG8_MMA(1, 1, At, B1); PG8_BAR; PG8_SCHED;
            } else {
            PG8_LDB(B0, 0, 0); PG8_SCHED; PG8_LDA(At, 0, 0); PG8_STAGE_A(PG8_SA(1, 1), a1, 1);
            if constexpr (GATHER) { if (last) { _Pragma("unroll") for (int _h = 0; _h < 2; ++_h) _Pragma("unroll") for (int _i = 0; _i < 2; ++_i) voffA[_h][_i] = voffN[_h][_i]; } }
            PG8_WAIT_L(8); PG8_BAR; PG8_WAIT_L(0); PG8_MMA(0, 0, At, B0); PG8_BAR; PG8_SCHED;
            PG8_LDB(B1, 0, 1); PG8_STAGE(PG8_SB(0, 0), b2, voffB);
            PG8_BAR; PG8_WAIT_L(0); PG8_MMA(0, 1, At, B1); PG8_BAR;
            PG8_LDA(At, 0, 1); PG8_STAGE_A(PG8_SA(0, 0), a2, 0);
            PG8_BAR; PG8_WAIT_L(0); PG8_MMA(1, 0, At, B0); PG8_BAR; PG8_SCHED;
            PG8_STAGE(PG8_SB(0, 1), b2 + hstep, voffB);
            PG8_WAIT_V(6); PG8_BAR; PG8_MMA(1, 1, At, B1); PG8_BAR;
            PG8_LDB(B0, 1, 0); PG8_SCHED; PG8_LDA(At, 1, 0); PG8_STAGE_A(PG8_SA(0, 1), a2, 1);
            PG8_WAIT_L(8); PG8_BAR; PG8_WAIT_L(0); PG8_MMA(0, 0, At, B0); PG8_BAR; PG8_SCHED;
            PG8_LDB(B1, 1, 1); PG8_STAGE(PG8_SB(1, 0), b3, voffB);
            PG8_BAR; PG8_WAIT_L(0); PG8_MMA(0, 1, At, B1); PG8_BAR;
            PG8_LDA(At, 1, 1); PG8_STAGE_A(PG8_SA(1, 0), a3, 0);
            PG8_BAR; PG8_WAIT_L(0); PG8_MMA(1, 0, At, B0); PG8_BAR; PG8_SCHED;
            PG8_STAGE(PG8_SB(1, 1), b3 + hstep, voffB);
            PG8_WAIT_V(6); PG8_BAR; PG8_MMA(1, 1, At, B1); PG8_BAR;
            }
        }
        if constexpr (FP8) asm volatile("s_nop 15\n\ts_nop 15" ::: "memory");
        if constexpr (ALIGN_EPI) { if (wr == 0) PG8_BAR; }
        E(acc, cur, wr, wc, fr, fq, ui); S.done(cur);
        if (!has_next) break;
#pragma unroll
        for (int a = 0; a < 2; ++a)
#pragma unroll
            for (int b = 0; b < 2; ++b)
#pragma unroll
                for (int m = 0; m < 4; ++m)
#pragma unroll
                    for (int n = 0; n < 2; ++n) acc[a][b][m][n] = (f32x4){0.f, 0.f, 0.f, 0.f};
        cur = nxt; cA = nA; cB = nB; ++ui;
        if constexpr (ALIGN_EPI) { if (wr == 1) PG8_BAR; }
    }
    PG8_WAIT_V(0);
    if constexpr (!ALIGN_EPI) { if (wr == 0) PG8_BAR; }
    PG8_BAR;
#undef PG8_SA
#undef PG8_SB
#undef PG8_STAGE
#undef PG8_STAGE_A
#undef PG8_LDA
#undef PG8_LDB
#undef PG8_MMA
#undef PG8_CAT8
#undef PG8_WAIT_V
#undef PG8_WAIT_L
#undef PG8_BAR
#undef PG8_SCHED
#undef PG8_GOFF
}
}
constexpr int BATCH = 2, SEQ = 16384, T = BATCH * SEQ, DM = 1024, NPROJ = 2560, DFF = 2816, NEXP = 8, DFE = 3584, DEPTH = 2;
constexpr int C_QA = 0, C_KA = 256, C_VA = 512, C_QR = 768, C_KR = 1024, C_VR = 1280, C_GR = 1792, C_US = 2304;
constexpr int NCHUNK = SEQ / 128;
constexpr int NWAVES = 8;
constexpr size_t MiB = 1u << 20;
constexpr size_t WS_CTL = 0, CTL_ZERO_BYTES = 1 * MiB;
constexpr size_t WS_TABA = 1 * MiB;
constexpr size_t WS_TABR = 2 * MiB;
constexpr size_t WS_SSM = 6 * MiB;
constexpr size_t SSM_LAYER_BYTES = 512 * 1024, SSM_ABAR = 0, SSM_ABARL = 8192, SSM_BMT = 16384, SSM_CMT = 81920, SSM_GLWT = 147456;
constexpr size_t WS_MAPS = 8 * MiB;
constexpr size_t WS_TOKINFO = 12 * MiB;
constexpr size_t WS_WIN = 8 * MiB;
constexpr size_t WS_WOUT = 18 * MiB;
constexpr size_t WS_FGU = 22 * MiB;
constexpr size_t WS_FDN = 33 * MiB;
constexpr size_t WS_XN = 40 * MiB;
constexpr size_t WS_PROJ = 104 * MiB;
constexpr size_t WS_ATTP = 264 * MiB;
constexpr size_t WS_LSE = 312 * MiB;
constexpr size_t WS_KV = 314 * MiB;
constexpr size_t WS_SST = 346 * MiB;
constexpr size_t WS_XN2 = 280 * MiB;
constexpr size_t WS_SSQ = 348 * MiB;
constexpr size_t WS_ACT = 104 * MiB;
constexpr size_t WS_MGU = 104 * MiB;
constexpr size_t WS_MDN = 216 * MiB;
constexpr size_t WS_MACT = 272 * MiB;
constexpr size_t WS_MACT2 = 391 * MiB;
constexpr size_t WS_END = 512 * MiB;
static_assert(WS_MACT + (size_t)135 * 256 * DFE <= WS_MACT2 && WS_MACT2 + (size_t)135 * 256 * DFE <= WS_END, "ws map");
constexpr int CW_BAR = 4096;
constexpr int CW_MOECNT = 16384;
constexpr int CW_PAIRCNT = 16384 + 64;
constexpr int SCR_BYTES = 155648;
constexpr int MISC_OFF = SCR_BYTES;
constexpr int LDS_BYTES = 159744;

#define GAS __attribute__((address_space(1)))
#define LAS __attribute__((address_space(3)))
typedef unsigned short bf16;
typedef unsigned v4u __attribute__((ext_vector_type(4)));
typedef unsigned v2u __attribute__((ext_vector_type(2)));
typedef float f32x4 __attribute__((ext_vector_type(4)));
typedef GAS unsigned gu32;
#define RLX_AGENT __ATOMIC_RELAXED, __HIP_MEMORY_SCOPE_AGENT
#define LDS_WAIT() asm volatile("s_waitcnt lgkmcnt(0)" ::: "memory")
#define VM_WAIT() asm volatile("s_waitcnt vmcnt(0)" ::: "memory")
#define DI __device__ __forceinline__
DI unsigned f2bf(float f) { unsigned u = __builtin_bit_cast(unsigned, f); return (u + 0x7fffu + ((u >> 16) & 1u)) >> 16; }
DI unsigned pk2(float lo, float hi) { return f2bf(lo) | (f2bf(hi) << 16); }
DI float bflo(unsigned w) { return __uint_as_float(w << 16); }
DI float bfhi(unsigned w) { return __uint_as_float(w & 0xffff0000u); }
DI float bf2f(bf16 h) { return __uint_as_float((unsigned)h << 16); }
DI float wave_sum(float v) {
#pragma unroll
    for (int o = 1; o < 64; o <<= 1) v += __shfl_xor(v, o);
    return v;
}
DI float sigmoidf_(float x) { return 1.f / (1.f + __expf(-x)); }
template <int CTRL> DI float dpp_f(float v) { return __builtin_bit_cast(float, __builtin_amdgcn_mov_dpp(__builtin_bit_cast(int, v), CTRL, 0xf, 0xf, true)); }
DI float qx1(float v) { return dpp_f<0xB1>(v); }
DI float qx2(float v) { return dpp_f<0x4E>(v); }
template <int P> DI float qbc(float v) { return dpp_f<P * 85>(v); }

#define XB_TMO      128
#define XB_XCNT(j)  (256  + 64 * (j))
#define XB_XSUB(j)  (1280 + 64 * (j))
#define XB_XGEN(j)  (2304 + 64 * (j))
#define XB_TOP      3328
#define XB_TOPGEN   3392
#define XCD_BAR_WORDS 3456
#define XB_SPIN_CAP (1u << 18)
DI unsigned xb_ld(unsigned* p)              { return __hip_atomic_load(p, __ATOMIC_RELAXED, __HIP_MEMORY_SCOPE_AGENT); }
DI unsigned xb_add(unsigned* p, unsigned v) { return __hip_atomic_fetch_add(p, v, __ATOMIC_RELAXED, __HIP_MEMORY_SCOPE_AGENT); }
DI unsigned xb_xcc_id() { return (unsigned)__builtin_amdgcn_s_getreg((3 << 11) | 20) & 0xFu; }
#define XB_SPIN(cond, bar) do { unsigned _sp = 0; while (cond) { __builtin_amdgcn_s_sleep(1); \
    if ((++_sp & 255u) == 0u) { if (xb_ld(&(bar)[XB_TMO])) break; if (_sp > XB_SPIN_CAP) { atomicAdd(&(bar)[XB_TMO], 1u); break; } } } } while (0)
struct XcdBarrier { unsigned* bar; unsigned x; volatile LAS unsigned* st; };
DI XcdBarrier xcd_barrier_post(unsigned* bar, volatile LAS unsigned* st, bool t0) {
    XcdBarrier b; b.bar = bar; b.x = xb_xcc_id(); b.st = st;
    if (t0) (void)xb_add(&bar[XB_XCNT(b.x)], 1u);
    return b;
}
DI void xcd_barrier_complete(unsigned* bar, unsigned x, unsigned& nloc, unsigned& nx) {
    const unsigned G = gridDim.x * gridDim.y * gridDim.z;
    unsigned sum, cnt, mine, sp = 0u;
    for (;;) {
        sum = 0u; cnt = 0u; mine = 0u;
#pragma unroll
        for (unsigned j = 0; j < 16; ++j) { const unsigned c = xb_ld(&bar[XB_XCNT(j)]); sum += c; cnt += (c > 0u) ? 1u : 0u; mine = (j == x) ? c : mine; }
        if (sum == G) break;
        __builtin_amdgcn_s_sleep(1);
        if ((++sp & 255u) == 0u) { if (xb_ld(&bar[XB_TMO])) break; if (sp > XB_SPIN_CAP) { atomicAdd(&bar[XB_TMO], 1u); break; } }
    }
    nloc = mine > 0u ? mine : 1u; nx = cnt > 0u ? cnt : 1u;
}
DI void xcd_barrier(const XcdBarrier& b, bool t0) {
    asm volatile("s_waitcnt vmcnt(0)" ::: "memory");
    __syncthreads();
    if (t0) {
        unsigned* bar = b.bar;
        __builtin_amdgcn_s_waitcnt(0);
        unsigned nloc = b.st[0], nx = b.st[1];
        if (nloc == 0u) { xcd_barrier_complete(bar, b.x, nloc, nx); b.st[0] = nloc; b.st[1] = nx; }
        const unsigned old = xb_add(&bar[XB_XSUB(b.x)], 1u);
        const unsigned gen = old / nloc;
        if (old + 1u == (gen + 1u) * nloc) {
            __builtin_amdgcn_fence(__ATOMIC_RELEASE, "agent");
            asm volatile("s_waitcnt vmcnt(0)" ::: "memory");
            const unsigned og = xb_add(&bar[XB_TOP], 1u);
            const unsigned tg = og / nx;
            if (og + 1u == (tg + 1u) * nx) xb_add(&bar[XB_TOPGEN], 1u);
            else XB_SPIN(xb_ld(&bar[XB_TOPGEN]) == tg, bar);
            __builtin_amdgcn_fence(__ATOMIC_ACQUIRE, "agent");
            xb_add(&bar[XB_XGEN(b.x)], 1u);
            asm volatile("s_waitcnt vmcnt(0)" ::: "memory");
        } else {
            XB_SPIN(xb_ld(&bar[XB_XGEN(b.x)]) == gen, bar);
            __builtin_amdgcn_fence(__ATOMIC_ACQUIRE, "agent");
            asm volatile("s_waitcnt vmcnt(0)" ::: "memory");
        }
    }
    __syncthreads();
}

namespace pg8 {
struct EpiBf16 {
    static constexpr bool PERM = true;
    bf16_t* O; int ldc; const PG8_LAS float* rs;
    __device__ __forceinline__ void operator()(const f32x4 (&acc)[2][2][4][2], const Unit& u, int wr, int wc, int fr, int fq, int ui) const {
        const int row0 = u.pm * BM + wr * 64 + fr, col0 = u.pn * BM + wc * 32 + 8 * fq;
#pragma unroll
        for (int ai = 0; ai < 2; ++ai)
#pragma unroll
            for (int m = 0; m < 4; ++m) { bf16_t* rowp = O + (size_t)(row0 + ai * HALF + m * 16) * ldc + col0; const float sc = rs ? rs[ui * 256 + ai * HALF + wr * 64 + m * 16 + fr] : 1.0f;
#pragma unroll
                for (int bj = 0; bj < 2; ++bj) { const f32x4 v0 = acc[ai][bj][m][0] * sc, v1 = acc[ai][bj][m][1] * sc;
                    u32x4 w; w.x = cvt_pk_bf16(v0[0], v0[1]); w.y = cvt_pk_bf16(v0[2], v0[3]); w.z = cvt_pk_bf16(v1[0], v1[1]); w.w = cvt_pk_bf16(v1[2], v1[3]);
                    *(u32x4*)(rowp + bj * HALF) = w; } }
    }
};
__device__ __forceinline__ float silu_mul(float g, float u) { return g * __builtin_amdgcn_rcpf(1.f + __expf(-g)) * u; }
struct EpiSwiGLU {
    static constexpr bool PERM = true;
    bf16_t* O; int ldc; const PG8_LAS float* rs;
    __device__ __forceinline__ void operator()(const f32x4 (&acc)[2][2][4][2], const Unit& u, int wr, int wc, int fr, int fq, int ui) const {
        const int row0 = u.pm * BM + wr * 64 + fr, col0 = u.pn * HALF + wc * 32 + 8 * fq;
#pragma unroll
        for (int ai = 0; ai < 2; ++ai)
#pragma unroll
            for (int m = 0; m < 4; ++m) { bf16_t* rowp = O + (size_t)(row0 + ai * HALF + m * 16) * ldc + col0;
                const float sc = rs ? rs[ui * 256 + ai * HALF + wr * 64 + m * 16 + fr] : 1.0f;
                const f32x4 g0 = acc[ai][0][m][0] * sc, g1 = acc[ai][0][m][1] * sc, u0 = acc[ai][1][m][0] * sc, u1 = acc[ai][1][m][1] * sc;
                u32x4 w; w.x = cvt_pk_bf16(silu_mul(g0[0], u0[0]), silu_mul(g0[1], u0[1])); w.y = cvt_pk_bf16(silu_mul(g0[2], u0[2]), silu_mul(g0[3], u0[3]));
                w.z = cvt_pk_bf16(silu_mul(g1[0], u1[0]), silu_mul(g1[1], u1[1])); w.w = cvt_pk_bf16(silu_mul(g1[2], u1[2]), silu_mul(g1[3], u1[3]));
                *(u32x4*)rowp = w; }
    }
};
__device__ __forceinline__ float clamp_fp8(float x) { return __builtin_amdgcn_fmed3f(x, -448.0f, 448.0f); }
__device__ __forceinline__ unsigned pk4_fp8(float a, float b, float c, float d) { a = clamp_fp8(a); b = clamp_fp8(b); c = clamp_fp8(c); d = clamp_fp8(d); int w = 0; w = __builtin_amdgcn_cvt_pk_fp8_f32(a, b, w, false); w = __builtin_amdgcn_cvt_pk_fp8_f32(c, d, w, true); return (unsigned)w; }
struct EpiSwiGLU8 {
    static constexpr bool PERM = true;
    unsigned char* O; int ldc; float gs, os;
    __device__ __forceinline__ void operator()(const f32x4 (&acc)[2][2][4][2], const Unit& u, int wr, int wc, int fr, int fq, int ui) const {
        const int row0 = u.pm * BM + wr * 64 + fr, col0 = u.pn * HALF + wc * 32 + 8 * fq;
#pragma unroll
        for (int ai = 0; ai < 2; ++ai)
#pragma unroll
            for (int m = 0; m < 4; ++m) { unsigned char* rowp = O + (size_t)(row0 + ai * HALF + m * 16) * ldc + col0;
                const f32x4 g0 = acc[ai][0][m][0] * gs, g1 = acc[ai][0][m][1] * gs, u0 = acc[ai][1][m][0] * (gs * os), u1 = acc[ai][1][m][1] * (gs * os);
                typedef unsigned u32x2 __attribute__((ext_vector_type(2))); u32x2 w;
                w.x = pk4_fp8(silu_mul(g0[0], u0[0]), silu_mul(g0[1], u0[1]), silu_mul(g0[2], u0[2]), silu_mul(g0[3], u0[3]));
                w.y = pk4_fp8(silu_mul(g1[0], u1[0]), silu_mul(g1[1], u1[1]), silu_mul(g1[2], u1[2]), silu_mul(g1[3], u1[3]));
                *(u32x2*)rowp = w; }
    }
};
struct EpiResF32 {
    static constexpr bool PERM = false;
    const float* res; float* out; int ldc; float sc; bf16_t* xr; const float* gain; float* ssq;
    __device__ __forceinline__ void operator()(const f32x4 (&acc)[2][2][4][2], const Unit& u, int wr, int wc, int fr, int fq, int ui) const {
        const int row0 = u.pm * BM + wr * 64 + fr, col0 = u.pn * BM + wc * 32 + 4 * fq;
        f32x4 gv[2][2];
        if (xr) {
#pragma unroll
            for (int bj = 0; bj < 2; ++bj)
#pragma unroll
                for (int n = 0; n < 2; ++n) gv[bj][n] = *(const f32x4*)(gain + col0 + bj * HALF + n * 16); }
#pragma unroll
        for (int ai = 0; ai < 2; ++ai) {
            f32x4 r[4][2][2];
#pragma unroll
            for (int m = 0; m < 4; ++m) { const size_t off = (size_t)(row0 + ai * HALF + m * 16) * ldc + col0;
#pragma unroll
                for (int bj = 0; bj < 2; ++bj)
#pragma unroll
                    for (int n = 0; n < 2; ++n) r[m][bj][n] = *(const f32x4*)(res + off + bj * HALF + n * 16); }
#pragma unroll
            for (int m = 0; m < 4; ++m) { const int row = row0 + ai * HALF + m * 16; const size_t off = (size_t)row * ldc + col0; float s = 0.f;
#pragma unroll
                for (int bj = 0; bj < 2; ++bj)
#pragma unroll
                    for (int n = 0; n < 2; ++n) { const f32x4 o = r[m][bj][n] + acc[ai][bj][m][n] * sc; *(f32x4*)(out + off + bj * HALF + n * 16) = o;
                        if (xr) { s += (o[0] * o[0] + o[1] * o[1]) + (o[2] * o[2] + o[3] * o[3]); const f32x4 y = o * gv[bj][n];
                            unsigned w0 = cvt_pk_bf16(y[0], y[1]), w1 = cvt_pk_bf16(y[2], y[3]); typedef unsigned u32x2 __attribute__((ext_vector_type(2))); *(u32x2*)(xr + off + bj * HALF + n * 16) = (u32x2){w0, w1}; } }
                if (xr) { s += __shfl_xor(s, 16); s += __shfl_xor(s, 32); if (fq == 0) ssq[(size_t)row * 16 + u.pn * 4 + wc] = s; } }
        }
    }
};
#ifndef MDN_ROWS
#define MDN_ROWS 4
#endif
struct EpiMoeDown {
    static constexpr bool PERM = false;
    float* out; int ldc; const int* tok; const float* gate; float sc;
    __device__ __forceinline__ void operator()(const f32x4 (&acc)[2][2][4][2], const Unit& u, int wr, int wc, int fr, int fq, int ui) const {
        const int col0 = u.pn * BM + wc * 32 + 4 * fq;
        int tk[2][4]; float gt[2][4];
#pragma unroll
        for (int ai = 0; ai < 2; ++ai)
#pragma unroll
            for (int m = 0; m < 4; ++m) { const int slot = u.r0 + ai * HALF + wr * 64 + m * 16 + fr, sl = slot < 32767 ? slot : 32767;
                tk[ai][m] = tok[u.e * 32768 + sl]; gt[ai][m] = gate[u.e * 32768 + sl]; }
#pragma unroll
        for (int ai = 0; ai < 2; ++ai)
#pragma unroll
            for (int m = 0; m < 4; ++m) { const bool ok = (u.r0 + ai * HALF + wr * 64 + m * 16 + fr) < u.cn; tk[ai][m] = ok ? tk[ai][m] : -1; gt[ai][m] = ok ? gt[ai][m] * sc : 0.f; }
#pragma unroll
        for (int ai = 0; ai < 2; ++ai)
#pragma unroll
            for (int mh = 0; mh < 4 / MDN_ROWS; ++mh) {
                f32x4 r[MDN_ROWS][2][2];
#pragma unroll
                for (int mm = 0; mm < MDN_ROWS; ++mm) { const int m = MDN_ROWS * mh + mm; const float* rowp = out + (size_t)(tk[ai][m] < 0 ? 0 : tk[ai][m]) * ldc + col0;
#pragma unroll
                    for (int bj = 0; bj < 2; ++bj)
#pragma unroll
                        for (int n = 0; n < 2; ++n) r[mm][bj][n] = *(const f32x4*)(rowp + bj * HALF + n * 16); }
#pragma unroll
                for (int mm = 0; mm < MDN_ROWS; ++mm) { const int m = MDN_ROWS * mh + mm; if (tk[ai][m] >= 0) { float* rowp = out + (size_t)tk[ai][m] * ldc + col0;
#pragma unroll
                    for (int bj = 0; bj < 2; ++bj)
#pragma unroll
                        for (int n = 0; n < 2; ++n) *(f32x4*)(rowp + bj * HALF + n * 16) = r[mm][bj][n] + acc[ai][bj][m][n] * gt[ai][m]; } }
            }
    }
};
struct EpiMoeDownA {
    static constexpr bool PERM = false;
    float* out; int ldc; const int* tok; const float* gate; float sc;
    __device__ __forceinline__ void operator()(const f32x4 (&acc)[2][2][4][2], const Unit& u, int wr, int wc, int fr, int fq, int ui) const {
        const int col0 = u.pn * BM + wc * 32 + 4 * fq;
        int tk[2][4]; float gt[2][4];
#pragma unroll
        for (int ai = 0; ai < 2; ++ai)
#pragma unroll
            for (int m = 0; m < 4; ++m) { const int slot = u.r0 + ai * HALF + wr * 64 + m * 16 + fr, sl = slot < 32767 ? slot : 32767;
                tk[ai][m] = tok[u.e * 32768 + sl]; gt[ai][m] = gate[u.e * 32768 + sl]; }
#pragma unroll
        for (int ai = 0; ai < 2; ++ai)
#pragma unroll
            for (int m = 0; m < 4; ++m) { const bool ok = (u.r0 + ai * HALF + wr * 64 + m * 16 + fr) < u.cn;
                if (ok) { typedef __attribute__((address_space(1))) float gfloat; gfloat* rowp = (gfloat*)(out + (size_t)tk[ai][m] * ldc + col0); const float g_ = gt[ai][m] * sc;
#pragma unroll
                    for (int bj = 0; bj < 2; ++bj)
#pragma unroll
                        for (int n = 0; n < 2; ++n)
#pragma unroll
                            for (int j = 0; j < 4; ++j) __builtin_amdgcn_global_atomic_fadd_f32(rowp + bj * HALF + n * 16 + j, acc[ai][bj][m][n][j] * g_); } }
    }
};
#define MO_T(c) (((c) + 255) >> 8)
struct MoeOrder : StaticOrder {
    int c0, c1, c2, c3, c4, c5, c6, c7; const int* tok; int nNl; const PG8_LAS int* ltab;
    __device__ __forceinline__ void init_moe(const unsigned* cnt, const int* tok_, int N, int G_, int c_, int tile_cap = 1 << 20) {
        tok = tok_; ltab = nullptr;
#define MO_LD(e) (int)__hip_atomic_load(cnt + e, __ATOMIC_RELAXED, __HIP_MEMORY_SCOPE_AGENT)
        c0 = MO_LD(0); c1 = MO_LD(1); c2 = MO_LD(2); c3 = MO_LD(3); c4 = MO_LD(4); c5 = MO_LD(5); c6 = MO_LD(6); c7 = MO_LD(7);
#undef MO_LD
        nNl = N / BM; const int nt_ = tiles(); init((nt_ < tile_cap ? nt_ : tile_cap) * BM, N, G_, c_);
    }
    __device__ __forceinline__ void decode(Unit& u) const {
        int e = 0, tb = 0, c = c0, acc = MO_T(c0);
#define MO_STEP(k, ck) if (u.pm >= acc) { e = k; tb = acc; c = ck; } acc += MO_T(ck);
        MO_STEP(1, c1) MO_STEP(2, c2) MO_STEP(3, c3) MO_STEP(4, c4) MO_STEP(5, c5) MO_STEP(6, c6) MO_STEP(7, c7)
#undef MO_STEP
        u.e = e; u.r0 = (u.pm - tb) * BM; u.cn = c; u.pb = e * nNl + u.pn;
    }
    __device__ __forceinline__ int tiles() const { return MO_T(c0) + MO_T(c1) + MO_T(c2) + MO_T(c3) + MO_T(c4) + MO_T(c5) + MO_T(c6) + MO_T(c7); }
    __device__ __forceinline__ bool next(int i, Unit& u) const {
        if (!StaticOrder::next(i, u)) return false;
        decode(u); u.aux = i; return true;
    }
    __device__ __forceinline__ int arow(const Unit& u, int R) const { if (ltab) return ltab[u.aux * 256 + R]; const int slot = u.r0 + R; return slot < u.cn ? tok[u.e * 32768 + slot] : 0; }
    __device__ __forceinline__ void build_ltab(PG8_LAS int* tab, int tid) { Unit u; for (int i = 0; next(i, u); ++i) if (tid < 256) { const int slot = u.r0 + tid; tab[i * 256 + tid] = slot < u.cn ? tok[u.e * 32768 + slot] : 0; }
        __syncthreads(); ltab = tab; }
};
#undef MO_T
struct MoeTailOrder {
    const MoeOrder* mo; int G, c, ntail, KS, kslice;
    __device__ __forceinline__ void init(const MoeOrder* mo_, int G_, int c_, int KS_, int kslice_, int max_tail) { mo = mo_; G = G_; c = c_; KS = KS_; kslice = kslice_; const int t = (mo_->tiles() - 128) * mo_->nNl; ntail = t < 0 ? 0 : (t > max_tail ? max_tail : t); }
    __device__ __forceinline__ bool next(int i, Unit& u) const {
        const int s = i * G + c; if (s >= ntail * KS) return false;
        const int t = s / KS, ks = s - t * KS; u.pm = 128 + t / mo->nNl; u.pn = t % mo->nNl; mo->decode(u); u.koff = ks * kslice; u.aux = s; return true;
    }
    __device__ __forceinline__ void a_ready(const Unit&) const {}
    __device__ __forceinline__ void done(const Unit&) const {}
    __device__ __forceinline__ int arow(const Unit&, int) const { return 0; }
};
struct EpiPart {
    static constexpr bool PERM = false;
    float* part;
    __device__ __forceinline__ void operator()(const f32x4 (&acc)[2][2][4][2], const Unit& u, int wr, int wc, int fr, int fq, int ui) const {
        float* base = part + (size_t)u.aux * 65536 + (size_t)(wr * 64 + fr) * 256 + wc * 32 + 4 * fq;
#pragma unroll
        for (int ai = 0; ai < 2; ++ai)
#pragma unroll
            for (int m = 0; m < 4; ++m)
#pragma unroll
                for (int bj = 0; bj < 2; ++bj)
#pragma unroll
                    for (int n = 0; n < 2; ++n) *(f32x4*)(base + (size_t)(ai * HALF + m * 16) * 256 + bj * HALF + n * 16) = acc[ai][bj][m][n];
    }
};
}
#include <cmath>
struct Args { const float* in[25]; float* out; unsigned char* ws; int ph_lo, ph_hi; };
struct KArgs {
    typedef const __attribute__((address_space(4))) char* kptr;
    DI kptr base() const { kptr p = (kptr)__builtin_amdgcn_kernarg_segment_ptr(); asm volatile("" : "+s"(p)); return p; }
    DI const float* in(int i) const { return *(const float* const __attribute__((address_space(4)))*)(base() + 8 * i); }
    DI float* out() const { return *(float* const __attribute__((address_space(4)))*)(base() + 200); }
    DI unsigned char* ws() const { return *(unsigned char* const __attribute__((address_space(4)))*)(base() + 208); }
    DI int ph_lo() const { return *(const int __attribute__((address_space(4)))*)(base() + 216); }
    DI int ph_hi() const { return *(const int __attribute__((address_space(4)))*)(base() + 220); }
};
static_assert(sizeof(Args) == 224, "Args layout");
enum { I_X = 0, I_N1G, I_WIN, I_QNG, I_KNG, I_GNG, I_ARE, I_AIM, I_BRE, I_BIM, I_CRE, I_CIM, I_SD, I_LDT, I_GLW, I_GLB, I_WOUT, I_N2G, I_FG, I_FU, I_FD, I_RT, I_MG, I_MU, I_MD };

DI void transpose_item(const float* W, int ldw, bf16* WT, int ldo, int k0, int n0, int drow0, float* scr, int lane) {
    float v[32];
    const float* src = W + (size_t)(k0 + (lane >> 5)) * ldw + n0 + (lane & 31);
#pragma unroll
    for (int i = 0; i < 32; ++i) v[i] = src[(size_t)(2 * i) * ldw];
#pragma unroll
    for (int i = 0; i < 32; ++i) scr[(2 * i + (lane >> 5)) * 33 + (lane & 31)] = v[i];
    LDS_WAIT(); asm volatile("" ::: "memory");
    const int c = lane & 7;
#pragma unroll
    for (int j = 0; j < 4; ++j) { const int n = (lane >> 3) + 8 * j; const float* s = scr + (8 * c) * 33 + n;
        v4u o; o.x = pk2(s[0 * 33], s[1 * 33]); o.y = pk2(s[2 * 33], s[3 * 33]); o.z = pk2(s[4 * 33], s[5 * 33]); o.w = pk2(s[6 * 33], s[7 * 33]);
        *(v4u*)(WT + (size_t)(drow0 + n) * ldo + k0 + 8 * c) = o; }
    LDS_WAIT(); asm volatile("" ::: "memory");
}
DI void rms_row(const float* xrow, const float* g, bf16* orow, int lane, f32x4 (&v)[4]) {
    const f32x4* xr = (const f32x4*)xrow + lane; float s = 0.f;
#pragma unroll
    for (int j = 0; j < 4; ++j) { v[j] = xr[64 * j]; s += (v[j].x * v[j].x + v[j].y * v[j].y) + (v[j].z * v[j].z + v[j].w * v[j].w); }
    const float rs = rsqrtf(wave_sum(s) * (1.f / DM) + 1e-6f);
    v2u* o8 = (v2u*)orow + lane;
#pragma unroll
    for (int j = 0; j < 4; ++j) { const f32x4 gg = ((const f32x4*)g)[lane + 64 * j]; v[j] = v[j] * rs * gg; v2u w; w.x = pk2(v[j].x, v[j].y); w.y = pk2(v[j].z, v[j].w); o8[64 * j] = w; }
}
DI void transpose_item8(const float* W, int ldw, unsigned char* WT, int ldo, int k0, int n0, int drow0, float scale, float* scr, int lane) {
    float v[32];
    const float* src = W + (size_t)(k0 + (lane >> 5)) * ldw + n0 + (lane & 31);
#pragma unroll
    for (int i = 0; i < 32; ++i) v[i] = src[(size_t)(2 * i) * ldw];
#pragma unroll
    for (int i = 0; i < 32; ++i) scr[(2 * i + (lane >> 5)) * 33 + (lane & 31)] = v[i] * scale;
    LDS_WAIT(); asm volatile("" ::: "memory");
    const int n = lane >> 1, hf = lane & 1; const float* s = scr + (32 * hf) * 33 + n;
    v4u o0, o1;
    o0.x = pg8::pk4_fp8(s[0 * 33], s[1 * 33], s[2 * 33], s[3 * 33]); o0.y = pg8::pk4_fp8(s[4 * 33], s[5 * 33], s[6 * 33], s[7 * 33]); o0.z = pg8::pk4_fp8(s[8 * 33], s[9 * 33], s[10 * 33], s[11 * 33]); o0.w = pg8::pk4_fp8(s[12 * 33], s[13 * 33], s[14 * 33], s[15 * 33]);
    o1.x = pg8::pk4_fp8(s[16 * 33], s[17 * 33], s[18 * 33], s[19 * 33]); o1.y = pg8::pk4_fp8(s[20 * 33], s[21 * 33], s[22 * 33], s[23 * 33]); o1.z = pg8::pk4_fp8(s[24 * 33], s[25 * 33], s[26 * 33], s[27 * 33]); o1.w = pg8::pk4_fp8(s[28 * 33], s[29 * 33], s[30 * 33], s[31 * 33]);
    unsigned char* dp = WT + (size_t)(drow0 + n) * ldo + k0 + 32 * hf;
    *(v4u*)dp = o0; *(v4u*)(dp + 16) = o1;
    LDS_WAIT(); asm volatile("" ::: "memory");
}
struct T8Item { const float* W; unsigned char* WT; int ldw, ldo, k0, n0, drow0; float scale; };
DI void t8_load(float (&v)[32], const T8Item& d, int lane) {
    const float* src = d.W + (size_t)(d.k0 + (lane >> 5)) * d.ldw + d.n0 + (lane & 31);
#pragma unroll
    for (int i = 0; i < 32; ++i) v[i] = src[(size_t)(2 * i) * d.ldw];
}
DI void t8_store(const float (&v)[32], const T8Item& d, float* scr, int lane) {
#pragma unroll
    for (int i = 0; i < 32; ++i) scr[(2 * i + (lane >> 5)) * 33 + (lane & 31)] = v[i] * d.scale;
    LDS_WAIT(); asm volatile("" ::: "memory");
    const int n = lane >> 1, hf = lane & 1; const float* s = scr + (32 * hf) * 33 + n;
    v4u o0, o1;
    o0.x = pg8::pk4_fp8(s[0 * 33], s[1 * 33], s[2 * 33], s[3 * 33]); o0.y = pg8::pk4_fp8(s[4 * 33], s[5 * 33], s[6 * 33], s[7 * 33]); o0.z = pg8::pk4_fp8(s[8 * 33], s[9 * 33], s[10 * 33], s[11 * 33]); o0.w = pg8::pk4_fp8(s[12 * 33], s[13 * 33], s[14 * 33], s[15 * 33]);
    o1.x = pg8::pk4_fp8(s[16 * 33], s[17 * 33], s[18 * 33], s[19 * 33]); o1.y = pg8::pk4_fp8(s[20 * 33], s[21 * 33], s[22 * 33], s[23 * 33]); o1.z = pg8::pk4_fp8(s[24 * 33], s[25 * 33], s[26 * 33], s[27 * 33]); o1.w = pg8::pk4_fp8(s[28 * 33], s[29 * 33], s[30 * 33], s[31 * 33]);
    unsigned char* dp = d.WT + (size_t)(d.drow0 + n) * d.ldo + d.k0 + 32 * hf;
    *(v4u*)dp = o0; *(v4u*)(dp + 16) = o1;
    LDS_WAIT(); asm volatile("" ::: "memory");
}
DI void rms_rows_phase(const float* x, const float* g, bf16* out, int gw, int NGW, int lane) {
    f32x4 gg[4];
#pragma unroll
    for (int j = 0; j < 4; ++j) gg[j] = ((const f32x4*)g)[lane + 64 * j];
    for (int m0 = gw; m0 < T; m0 += 4 * NGW) {
        f32x4 v[4][4];
#pragma unroll
        for (int r = 0; r < 4; ++r) { const int m = m0 + r * NGW; if (m < T) {
#pragma unroll
            for (int j = 0; j < 4; ++j) v[r][j] = ((const f32x4*)(x + (size_t)m * DM))[lane + 64 * j]; } }
#pragma unroll
        for (int r = 0; r < 4; ++r) { const int m = m0 + r * NGW; if (m < T) { float s = 0.f;
#pragma unroll
            for (int j = 0; j < 4; ++j) s += (v[r][j].x * v[r][j].x + v[r][j].y * v[r][j].y) + (v[r][j].z * v[r][j].z + v[r][j].w * v[r][j].w);
            const float rs = rsqrtf(wave_sum(s) * (1.f / DM) + 1e-6f); v2u* o8 = (v2u*)(out + (size_t)m * DM) + lane;
#pragma unroll
            for (int j = 0; j < 4; ++j) { const f32x4 y = v[r][j] * rs * gg[j]; v2u w; w.x = pk2(y.x, y.y); w.y = pk2(y.z, y.w); o8[64 * j] = w; } } }
    }
}
DI void unpack8(const v4u w, float (&x)[8]) { x[0] = bflo(w.x); x[1] = bfhi(w.x); x[2] = bflo(w.y); x[3] = bfhi(w.y); x[4] = bflo(w.z); x[5] = bfhi(w.z); x[6] = bflo(w.w); x[7] = bfhi(w.w); }
DI v4u pack8(const float (&x)[8]) { v4u w; w.x = pk2(x[0], x[1]); w.y = pk2(x[2], x[3]); w.z = pk2(x[4], x[5]); w.w = pk2(x[6], x[7]); return w; }

template <class Sched> DI void build_rs(LAS float* RS, const Sched& S, const float* ssq, int tid) {
    pg8::Unit u;
    for (int i = 0; S.next(i, u); ++i) if (tid < 256) { const f32x4* p = (const f32x4*)(ssq + ((size_t)u.pm * 256 + tid) * 16); const f32x4 a0 = p[0], a1 = p[1], a2 = p[2], a3 = p[3];
        const float s = ((a0.x + a0.y) + (a0.z + a0.w)) + ((a1.x + a1.y) + (a1.z + a1.w)) + ((a2.x + a2.y) + (a2.z + a2.w)) + ((a3.x + a3.y) + (a3.z + a3.w));
        RS[i * 256 + tid] = rsqrtf(s * (1.f / DM) + 1e-6f); }
    __syncthreads();
}
DI void phase_prologue(const KArgs& a, char* lds, int gw, int NGW, int wave, int lane) {
    unsigned char* ws = a.ws();
    float* scr = (float*)(lds + wave * 16384);
    constexpr int I_IN = 16 * 80, I_OUT = 16 * 32, I_G = 16 * 88, I_D = 44 * 32;
    constexpr int NIT = 2 * I_IN + 2 * I_OUT + 2 * I_G + I_D;
    for (int it = gw; it < NIT; it += NGW) {
        int r = it;
        if (r < 2 * I_IN) { const int l = r / I_IN; r -= l * I_IN; const int kb = r / 80, nb = r % 80;
            transpose_item(a.in(I_WIN) + (size_t)l * DM * NPROJ, NPROJ, (bf16*)(ws + WS_WIN) + (size_t)l * NPROJ * DM, DM, 64 * kb, 32 * nb, 32 * nb, scr, lane); continue; }
        r -= 2 * I_IN;
        if (r < 2 * I_OUT) { const int l = r / I_OUT; r -= l * I_OUT; const int kb = r / 32, nb = r % 32;
            transpose_item(a.in(I_WOUT) + (size_t)l * DM * DM, DM, (bf16*)(ws + WS_WOUT) + (size_t)l * DM * DM, DM, 64 * kb, 32 * nb, 32 * nb, scr, lane); continue; }
        r -= 2 * I_OUT;
        if (r < 2 * I_G) { const int up = r / I_G; r -= up * I_G; const int kb = r / 88, nb = r % 88, n0 = 32 * nb;
            transpose_item(a.in(up ? I_FU : I_FG), DFF, (bf16*)(ws + WS_FGU), DM, 64 * kb, n0, (n0 >> 7) * 256 + (n0 & 127) + up * 128, scr, lane); continue; }
        r -= 2 * I_G;
        { const int kb = r / 32, nb = r % 32; transpose_item(a.in(I_FD), DM, (bf16*)(ws + WS_FDN), DFF, 64 * kb, 32 * nb, 32 * nb, scr, lane); }
    }
    const int gt = gw * 64 + lane, NGT = NGW * 64;
    float* tabA = (float*)(ws + WS_TABA); float* tabR = (float*)(ws + WS_TABR);
    for (int i = gt; i < SEQ * 8; i += NGT) { const int pos = i >> 3, k = i & 7; const float inv = powf(500000.0f, -(float)k * 2.0f / 16.0f); const double ang = (double)((float)pos * inv);
        tabA[2 * i] = (float)cos(ang); tabA[2 * i + 1] = (float)sin(ang); }
    for (int i = gt; i < SEQ * 32; i += NGT) { const int pos = i >> 5, k = i & 31; const float inv = powf(10000.0f, -(float)k * 2.0f / 64.0f); const double ang = (double)((float)pos * inv);
        tabR[2 * i] = (float)cos(ang); tabR[2 * i + 1] = (float)sin(ang); }
    for (int i = gt; i < DEPTH * 16 * 64; i += NGT) { const int l = i >> 10, gp = i & 1023, gI = gp >> 6;
        float* base = (float*)(ws + WS_SSM + (size_t)l * SSM_LAYER_BYTES);
        const float dt = expf(a.in(I_LDT)[l * 16 + gI]), lr = a.in(I_ARE)[i], li = a.in(I_AIM)[i];
        const float mag = expf(lr * dt), ang = li * dt; const float ar = mag * cosf(ang), ai = mag * sinf(ang);
        const float den = lr * lr + li * li, nr = ar - 1.0f, ni = ai; const float fre = (nr * lr + ni * li) / den, fim = (ni * lr - nr * li) / den;
        bf16* bmt = (bf16*)((char*)base + SSM_BMT) + ((size_t)gI * 128 + (gp & 63)) * 16;
        for (int c = 0; c < 16; ++c) { const float br = a.in(I_BRE)[(size_t)i * 16 + c], bi = a.in(I_BIM)[(size_t)i * 16 + c]; bmt[c] = (bf16)f2bf(fre * br - fim * bi); bmt[64 * 16 + c] = (bf16)f2bf(fre * bi + fim * br); }
        bf16* cmt = (bf16*)((char*)base + SSM_CMT) + (size_t)gI * 16 * 128 + 2 * (gp & 63);
        for (int c = 0; c < 16; ++c) { cmt[c * 128] = (bf16)f2bf(a.in(I_CRE)[((size_t)(l * 16 + gI) * 16 + c) * 64 + (gp & 63)]); cmt[c * 128 + 1] = (bf16)f2bf(-a.in(I_CIM)[((size_t)(l * 16 + gI) * 16 + c) * 64 + (gp & 63)]); }
        base[SSM_ABAR / 4 + 2 * gp] = ar; base[SSM_ABAR / 4 + 2 * gp + 1] = ai;
        float pr = ar, pi = ai;
        for (int k = 0; k < 7; ++k) { const float t0 = pr * pr - pi * pi, t1 = 2.0f * pr * pi; pr = t0; pi = t1; }
        base[SSM_ABARL / 4 + 2 * gp] = pr; base[SSM_ABARL / 4 + 2 * gp + 1] = pi; }
    for (int i = gt; i < DEPTH * 65536; i += NGT) { const int l = i >> 16, n = (i >> 8) & 255, k = i & 255;
        ((bf16*)(ws + WS_SSM + (size_t)l * SSM_LAYER_BYTES + SSM_GLWT))[n * 256 + k] = (bf16)f2bf(a.in(I_GLW)[(size_t)l * 65536 + k * 256 + n]); }
    rms_rows_phase(a.in(I_X), a.in(I_N1G), (bf16*)(ws + WS_XN), gw, NGW, lane);
}

DI void prep_phase(bf16* proj, const float* qg, const float* kg, const float* tabA, int gw, int NGW, int lane) {
    const int vec = lane >> 3, sub = lane & 7;
    const int coff = (vec < 4 ? C_QA + vec * 64 : C_KA + (vec - 4) * 64) + sub * 8;
    float g[8];
    { const f32x4* gp = (const f32x4*)((vec < 4 ? qg : kg) + sub * 8); const f32x4 g0 = gp[0], g1 = gp[1]; g[0] = g0.x; g[1] = g0.y; g[2] = g0.z; g[3] = g0.w; g[4] = g1.x; g[5] = g1.y; g[6] = g1.z; g[7] = g1.w; }
    const float qs = vec < 4 ? 0.125f * 1.4426950408889634f : 1.0f;
    for (int t0 = gw; t0 < T; t0 += 4 * NGW) {
        v4u raw[4]; f32x4 cs[4][4];
#pragma unroll
        for (int r = 0; r < 4; ++r) { const int t = t0 + r * NGW; if (t < T) { raw[r] = *(const v4u*)(proj + (size_t)t * NPROJ + coff); const f32x4* cp = (const f32x4*)(tabA + (size_t)(t & (SEQ - 1)) * 16);
#pragma unroll
            for (int c = 0; c < 4; ++c) cs[r][c] = cp[c]; } }
#pragma unroll
        for (int r = 0; r < 4; ++r) { const int t = t0 + r * NGW; if (t < T) {
            float x[8]; unpack8(raw[r], x);
            float ss = 0.f;
#pragma unroll
            for (int e = 0; e < 8; ++e) ss += x[e] * x[e];
            ss += __shfl_xor(ss, 1); ss += __shfl_xor(ss, 2); ss += __shfl_xor(ss, 4);
            const float rs = rsqrtf(ss * (1.f / 64.f) + 1e-6f);
#pragma unroll
            for (int e = 0; e < 8; ++e) x[e] = x[e] * rs * g[e];
            const float cc[8] = {cs[r][0].x, cs[r][0].z, cs[r][1].x, cs[r][1].z, cs[r][2].x, cs[r][2].z, cs[r][3].x, cs[r][3].z};
            const float sn[8] = {cs[r][0].y, cs[r][0].w, cs[r][1].y, cs[r][1].w, cs[r][2].y, cs[r][2].w, cs[r][3].y, cs[r][3].w};
#pragma unroll
            for (int e = 0; e < 8; ++e) { const float o = __shfl_xor(x[e], 1);
                if (sub == 0) x[e] = x[e] * cc[e] - o * sn[e]; else if (sub == 1) x[e] = x[e] * cc[e] + o * sn[e]; }
#pragma unroll
            for (int e = 0; e < 8; ++e) x[e] *= qs;
            *(v4u*)(proj + (size_t)t * NPROJ + coff) = pack8(x); } }
    }
}
DI void ret_load_rope(float* dst, int ld, const bf16* proj, size_t grow0, int pos0, int col0, float scale, bool zeta, float lg, const float* tabR, int tid) {
    const int row = tid >> 2, qd = tid & 3;
    const bf16* src = proj + (grow0 + row) * NPROJ + col0;
    float own[16], par[16];
    { float t8[8]; unpack8(*(const v4u*)(src + qd * 16), t8);
#pragma unroll
      for (int e = 0; e < 8; ++e) own[e] = t8[e];
      unpack8(*(const v4u*)(src + qd * 16 + 8), t8);
#pragma unroll
      for (int e = 0; e < 8; ++e) own[8 + e] = t8[e];
      unpack8(*(const v4u*)(src + (qd ^ 2) * 16), t8);
#pragma unroll
      for (int e = 0; e < 8; ++e) par[e] = t8[e];
      unpack8(*(const v4u*)(src + (qd ^ 2) * 16 + 8), t8);
#pragma unroll
      for (int e = 0; e < 8; ++e) par[8 + e] = t8[e]; }
    const float* cs = tabR + ((size_t)(pos0 + row) * 32 + (qd & 1) * 16) * 2;
    float sc = scale; if (zeta) sc *= __expf(lg * (float)(127 - row));
    float* d = dst + row * ld + qd * 16;
#pragma unroll
    for (int e = 0; e < 16; ++e) { const float c = cs[2 * e], s = cs[2 * e + 1]; const float r = (qd < 2) ? own[e] * c - par[e] * s : own[e] * c + par[e] * s; d[e] = r * sc; }
}
DI float ret_loggamma(int h) { return log1pf(-exp2f(-5.0f - (float)h)); }

DI void ret_kv_unit(const KArgs& a, char* lds, int unit, int tid) {
    asm volatile("" : "+v"(tid));
    const int n = unit & 127, h = (unit >> 7) & 3, b = unit >> 9;
    float* KS = (float*)lds; float* VS = (float*)(lds + 32768);
    const bf16* proj = (const bf16*)(a.ws() + WS_PROJ); const size_t grow0 = (size_t)b * SEQ + n * 128;
    const float lg = ret_loggamma(h);
    ret_load_rope(KS, 64, proj, grow0, n * 128, C_KR + h * 64, 0.125f, true, lg, (const float*)(a.ws() + WS_TABR), tid);
    { const int row = tid >> 2, q = tid & 3; const bf16* src = proj + (grow0 + row) * NPROJ + C_VR + h * 128 + q * 32; float* d = VS + row * 128 + q * 32;
#pragma unroll
      for (int c = 0; c < 4; ++c) { float t8[8]; unpack8(*(const v4u*)(src + 8 * c), t8);
#pragma unroll
          for (int e = 0; e < 8; ++e) d[8 * c + e] = t8[e]; } }
    __syncthreads();
    const int e = tid & 127, dq = tid >> 7;
    float acc[16];
#pragma unroll
    for (int c = 0; c < 16; ++c) acc[c] = 0.f;
    for (int j = 0; j < 128; ++j) { const float vv = VS[j * 128 + e]; const f32x4* kk = (const f32x4*)(KS + j * 64 + dq * 16);
#pragma unroll
        for (int c = 0; c < 4; ++c) { const f32x4 k4 = kk[c]; acc[4 * c] += vv * k4.x; acc[4 * c + 1] += vv * k4.y; acc[4 * c + 2] += vv * k4.z; acc[4 * c + 3] += vv * k4.w; } }
    float* kv = (float*)(a.ws() + WS_KV) + ((size_t)((b * 4 + h) * 128 + n)) * 8192;
#pragma unroll
    for (int c = 0; c < 16; ++c) kv[(dq * 16 + c) * 128 + e] = acc[c];
    __syncthreads();
}
typedef short bf16x8_t __attribute__((ext_vector_type(8)));
typedef float f32x4_t __attribute__((ext_vector_type(4)));
constexpr int SSM_XLD = 528;
template <bool EMIT> DI void ssm_wave_chunk(const KArgs& a, int layer, int b, int chunk, int g, LAS char* XS  , LAS char* UWb  , LAS char* ZS, int zld  , float& hr, float& hi, int lane) {
    const bf16* proj = (const bf16*)(a.ws() + WS_PROJ); const size_t grow0 = (size_t)b * SEQ + chunk * 128;
    const char* sp = (const char*)(a.ws() + WS_SSM + (size_t)layer * SSM_LAYER_BYTES);
    const int l15 = lane & 15, l4 = lane >> 4;
    const bf16x8_t zero8 = (bf16x8_t){0, 0, 0, 0, 0, 0, 0, 0};
    bf16x8_t bmf[8];
#pragma unroll
    for (int nt = 0; nt < 8; ++nt) bmf[nt] = *(const bf16x8_t*)(sp + SSM_BMT + (((size_t)g * 128 + 16 * nt + l15) * 16 + 8 * (l4 & 1)) * 2);
    bf16x8_t cmf[4]; float dsk = 0.f;
    if (EMIT) {
#pragma unroll
        for (int s = 0; s < 4; ++s) cmf[s] = *(const bf16x8_t*)(sp + SSM_CMT + (((size_t)g * 16 + l15) * 128 + 32 * s + 8 * l4) * 2);
        dsk = a.in(I_SD)[layer * 256 + g * 16 + l15];
    }
    const float ar = ((const float*)(sp + SSM_ABAR))[2 * (g * 64 + lane)], ai = ((const float*)(sp + SSM_ABAR))[2 * (g * 64 + lane) + 1];
    const bf16* usrc = proj + (grow0 + ((lane & 31) >> 1)) * NPROJ + C_US + g * 16 + (lane & 1) * 8;
    v4u unext = *(const v4u*)usrc;
    for (int blk = 0; blk < 8; ++blk) {
        if (lane < 32) *(LAS v4u*)(UWb + lane * 16) = unext;
        unext = *(const v4u*)(usrc + (size_t)(16 * (blk < 7 ? blk + 1 : 7)) * NPROJ);
        LDS_WAIT(); asm volatile("" ::: "memory");
        const bf16x8_t uf = *(const LAS bf16x8_t*)(UWb + l15 * 32 + (l4 & 1) * 16);
        f32x4_t dx[8];
#pragma unroll
        for (int nt = 0; nt < 8; ++nt) dx[nt] = __builtin_amdgcn_mfma_f32_16x16x32_bf16(uf, bmf[nt], (f32x4_t){0.f, 0.f, 0.f, 0.f}, 0, 0, 0);
        asm volatile("" : "+v"(dx[0]), "+v"(dx[1]), "+v"(dx[2]), "+v"(dx[3]), "+v"(dx[4]), "+v"(dx[5]), "+v"(dx[6]), "+v"(dx[7]) : "v"(uf));
#pragma unroll
        for (int nt = 0; nt < 8; ++nt)
#pragma unroll
            for (int r = 0; r < 4; ++r) *(LAS float*)(XS + (4 * l4 + r) * SSM_XLD + (16 * nt + l15) * 4) = 0.5f * dx[nt][r];
        asm volatile("" :: "v"(bmf[0]), "v"(bmf[1]), "v"(bmf[2]), "v"(bmf[3]), "v"(bmf[4]), "v"(bmf[5]), "v"(bmf[6]), "v"(bmf[7]));
        LDS_WAIT(); asm volatile("" ::: "memory");
        float xr_[16], xi_[16];
#pragma unroll
        for (int tt = 0; tt < 16; ++tt) { xr_[tt] = *(const LAS float*)(XS + tt * SSM_XLD + lane * 4); xi_[tt] = *(const LAS float*)(XS + tt * SSM_XLD + 256 + lane * 4); }
        asm volatile("" ::: "memory");
#pragma unroll
        for (int tt = 0; tt < 16; ++tt) { const float xr = xr_[tt], xi = xi_[tt];
            const float nhr = ar * hr - ai * hi + xr, nhi = ar * hi + ai * hr + xi; hr = nhr; hi = nhi;
            if (EMIT) *(LAS unsigned*)(XS + tt * SSM_XLD + lane * 4) = pg8::cvt_pk_bf16(hr, hi); }
        if (EMIT) {
            LDS_WAIT(); asm volatile("" ::: "memory");
            f32x4_t y = (f32x4_t){0.f, 0.f, 0.f, 0.f};
#pragma unroll
            for (int s = 0; s < 4; ++s) { const bf16x8_t hf = *(const LAS bf16x8_t*)(XS + l15 * SSM_XLD + (32 * s + 8 * l4) * 2); y = __builtin_amdgcn_mfma_f32_16x16x32_bf16(hf, cmf[s], y, 0, 0, 0); asm volatile("" : "+v"(y) : "v"(hf), "v"(cmf[s])); }

#pragma unroll
            for (int r = 0; r < 4; ++r) { const int t = 4 * l4 + r; const float uv = bf2f(*(const LAS bf16*)(UWb + t * 32 + l15 * 2)); const float yv = y[r] + dsk * uv;
                const float z = yv * sigmoidf_(1.5957691216057308f * (yv + 0.044715f * yv * yv * yv));
                *(LAS bf16*)(ZS + (16 * blk + t) * zld + (g * 16 + l15) * 2) = (bf16)f2bf(z); }
        }
        LDS_WAIT(); asm volatile("" ::: "memory");
    }
}
DI void attn_unit(const KArgs& a, char* lds, int unit, int tid) {
    asm volatile("" : "+v"(tid));
    const int pat = unit >> 10, rem = unit & 1023, b = rem >> 9, h = (rem >> 7) & 3, rn = rem & 127;
    const int dil = pat == 0 ? 1 : (pat == 1 ? 4 : 16), nbk = 128 / dil;
    const int n = rn % nbk, r = rn / nbk;
    constexpr int LDK = 68;
    float* KS = (float*)lds; float* VS = (float*)(lds + 256 * LDK * 4);
    const bf16* proj = (const bf16*)(a.ws() + WS_PROJ);
    { const int j = tid >> 1, half = tid & 1; const int l = 128 * (n - 1) + j; float* kd = KS + j * LDK + half * 32; float* vd = VS + j * LDK + half * 32;
      if (l >= 0) { const size_t grow = (size_t)b * SEQ + (size_t)l * dil + r; const bf16* ks = proj + grow * NPROJ + C_KA + h * 64 + half * 32; const bf16* vs = proj + grow * NPROJ + C_VA + h * 64 + half * 32;
#pragma unroll
          for (int c = 0; c < 4; ++c) { float t8[8]; unpack8(*(const v4u*)(ks + 8 * c), t8);
#pragma unroll
              for (int e = 0; e < 8; ++e) kd[8 * c + e] = t8[e];
              unpack8(*(const v4u*)(vs + 8 * c), t8);
#pragma unroll
              for (int e = 0; e < 8; ++e) vd[8 * c + e] = t8[e]; }
      } else {
#pragma unroll
          for (int e = 0; e < 32; ++e) { kd[e] = 0.f; vd[e] = 0.f; } } }
    __syncthreads();
    const int qi = tid >> 2, part = tid & 3;
    const size_t growq = (size_t)b * SEQ + (size_t)(128 * n + qi) * dil + r;
    float q[64];
    { const bf16* qs = proj + growq * NPROJ + C_QA + h * 64;
#pragma unroll
      for (int c = 0; c < 8; ++c) { float t8[8]; unpack8(*(const v4u*)(qs + 8 * c), t8);
#pragma unroll
          for (int e = 0; e < 8; ++e) q[8 * c + e] = t8[e]; } }
    float m = -INFINITY, l = 0.f, o[64];
#pragma unroll
    for (int e = 0; e < 64; ++e) o[e] = 0.f;
    for (int jj = 0; jj < 33; ++jj) {
        const int j = qi + 4 * jj + part;
        const bool valid = (j <= qi + 128) && (n > 0 || j >= 128);
        if (valid) {
            const f32x4* kr = (const f32x4*)(KS + j * LDK); float s = 0.f;
#pragma unroll
            for (int c = 0; c < 16; ++c) { const f32x4 k4 = kr[c]; s += q[4 * c] * k4.x + q[4 * c + 1] * k4.y + q[4 * c + 2] * k4.z + q[4 * c + 3] * k4.w; }
            const float mn = fmaxf(m, s), sc = __expf(m - mn), p = __expf(s - mn);
            l = l * sc + p; m = mn;
            const f32x4* vr = (const f32x4*)(VS + j * LDK);
#pragma unroll
            for (int c = 0; c < 16; ++c) { const f32x4 v4 = vr[c]; o[4 * c] = o[4 * c] * sc + p * v4.x; o[4 * c + 1] = o[4 * c + 1] * sc + p * v4.y; o[4 * c + 2] = o[4 * c + 2] * sc + p * v4.z; o[4 * c + 3] = o[4 * c + 3] * sc + p * v4.w; }
        }
    }
    float M = fmaxf(m, qx1(m)); M = fmaxf(M, qx2(M));
    const float f = (m == -INFINITY) ? 0.f : __expf(m - M);
    l *= f; l += qx1(l); l += qx2(l);
    const float il = 1.0f / l;
#pragma unroll
    for (int e = 0; e < 64; ++e) { float t = o[e] * f; t += qx1(t); t += qx2(t); o[e] = t * il; }
    float w[16];
#pragma unroll
    for (int e = 0; e < 16; ++e) w[e] = part == 0 ? o[e] : (part == 1 ? o[16 + e] : (part == 2 ? o[32 + e] : o[48 + e]));
    bf16* op = (bf16*)(a.ws() + WS_ATTP) + ((size_t)pat * T + growq) * 256 + h * 64 + part * 16;
    { v4u w0, w1; w0.x = pk2(w[0], w[1]); w0.y = pk2(w[2], w[3]); w0.z = pk2(w[4], w[5]); w0.w = pk2(w[6], w[7]); w1.x = pk2(w[8], w[9]); w1.y = pk2(w[10], w[11]); w1.z = pk2(w[12], w[13]); w1.w = pk2(w[14], w[15]);
      *(v4u*)op = w0; *(v4u*)(op + 8) = w1; }
    if (part == 0) ((float*)(a.ws() + WS_LSE))[((size_t)pat * T + growq) * 4 + h] = M + __logf(l);
    __syncthreads();
}
typedef short s16x4_t __attribute__((ext_vector_type(4)));
typedef float f32x16_t __attribute__((ext_vector_type(16)));
typedef float f32x2_t __attribute__((ext_vector_type(2)));
typedef __bf16 bf16x2_t __attribute__((ext_vector_type(2)));
DI unsigned cvtpk(float lo, float hi) { f32x2_t v = {lo, hi}; bf16x2_t b = __builtin_convertvector(v, bf16x2_t); return __builtin_bit_cast(unsigned, b); }
DI s16x4_t ldtr(const LAS char* p) { return __builtin_bit_cast(s16x4_t, __builtin_amdgcn_ds_read_tr16_b64_v4i16((LAS s16x4_t*)p)); }
DI int crow16(int r, int hh) { return (r & 3) + 8 * (r >> 2) + 4 * hh; }
struct AttnUnitId { int pat, b, h, dil, r, u; };
DI AttnUnitId attn_decode(int unit) { AttnUnitId d; d.pat = unit >> 9; const int rem = unit & 511; d.b = rem >> 8; d.h = (rem >> 6) & 3; const int cu = rem & 63;
    d.dil = d.pat == 0 ? 1 : (d.pat == 1 ? 4 : 16); const int upc = 64 / d.dil; d.r = cu / upc; d.u = cu % upc; return d; }
DI unsigned attn_issue_kv(const bf16* proj, const AttnUnitId& d, int tid, v4u (&kv)[6], v4u (&vv)[6]) {
    const int kc0 = 256 * d.u - 128 + (tid >> 3);
    const bf16* p0 = proj + ((size_t)d.b * SEQ + (size_t)d.r) * NPROJ + C_KA + d.h * 64 + (tid & 7) * 8;
    unsigned mask = 0u;
#pragma unroll
    for (int it = 0; it < 6; ++it) { const int kc = kc0 + 64 * it, kcc = kc < 0 ? 0 : kc; mask |= (kc >= 0 ? 1u : 0u) << it;
        const bf16* p = p0 + (size_t)(kcc * d.dil) * NPROJ; kv[it] = *(const v4u*)p; vv[it] = *(const v4u*)(p + (C_VA - C_KA)); }
    return mask;
}
template <class F> DI void attn_run(const KArgs& a, LAS char* lds, int nun, const F& unit_of, int tid) {
    asm volatile("" : "+v"(tid));
    if (nun <= 0) return;
    constexpr int RS = 144;
    LAS char* KL = lds; LAS char* VL = lds + 384 * RS;
    const bf16* proj = (const bf16*)(a.ws() + WS_PROJ);
    const int w = tid >> 6, lane = tid & 63, ql = lane & 31, hh = lane >> 5;
    const int q4 = (lane & 15) >> 2, p4 = lane & 3, blk = (lane >> 4) & 1;
    AttnUnitId d = attn_decode(unit_of(0));
    v4u kv[6], vv[6];
    unsigned kvmask = attn_issue_kv(proj, d, tid, kv, vv);
    bf16x8_t qn[4];
    { const size_t grow = (size_t)d.b * SEQ + (size_t)(256 * d.u + 32 * w + ql) * d.dil + d.r;
#pragma unroll
      for (int s = 0; s < 4; ++s) qn[s] = *(const bf16x8_t*)(proj + grow * NPROJ + C_QA + d.h * 64 + 16 * s + 8 * hh); }
    for (int k = 0; k < nun; ++k) {
#pragma unroll
        for (int it = 0; it < 6; ++it) { const int c = tid + 512 * it, row = c >> 3, ch = c & 7; const bool ok = (kvmask >> it) & 1u; const v4u z4 = (v4u){0u, 0u, 0u, 0u};
            *(LAS v4u*)(KL + row * RS + ch * 16) = ok ? kv[it] : z4; *(LAS v4u*)(VL + row * RS + ch * 16) = ok ? vv[it] : z4; }
        const AttnUnitId dc = d; const size_t growc = (size_t)d.b * SEQ + (size_t)(256 * d.u + 32 * w + ql) * d.dil + d.r;
        bf16x8_t qc[4];
#pragma unroll
        for (int s = 0; s < 4; ++s) qc[s] = qn[s];
        __syncthreads();
        d = attn_decode(unit_of(k + 1 < nun ? k + 1 : k)); kvmask = attn_issue_kv(proj, d, tid, kv, vv);
        { const size_t grow = (size_t)d.b * SEQ + (size_t)(256 * d.u + 32 * w + ql) * d.dil + d.r;
#pragma unroll
          for (int s = 0; s < 4; ++s) qn[s] = *(const bf16x8_t*)(proj + grow * NPROJ + C_QA + d.h * 64 + 16 * s + 8 * hh); }
        f32x16_t p[5];
#pragma unroll
        for (int kt = 0; kt < 5; ++kt) {
#pragma unroll
            for (int e = 0; e < 16; ++e) p[kt][e] = 0.f;
#pragma unroll
            for (int s = 0; s < 4; ++s) { const bf16x8_t kf = *(const LAS bf16x8_t*)(KL + (32 * w + 32 * kt + ql) * RS + 32 * s + 16 * hh); p[kt] = __builtin_amdgcn_mfma_f32_32x32x16_bf16(kf, qc[s], p[kt], 0, 0, 0); } }
        const int kc0 = 256 * dc.u + 32 * w - 128;
        float m = -INFINITY;
#pragma unroll
        for (int kt = 0; kt < 5; ++kt)
#pragma unroll
            for (int e = 0; e < 16; ++e) { const int c = crow16(e, hh);
                bool valid;
                if (kt == 0) valid = (c >= ql) && (kc0 >= 0); else if (kt == 4) valid = (c <= ql); else valid = (kc0 + 32 * kt >= 0);
                p[kt][e] = valid ? p[kt][e] : -INFINITY; m = fmaxf(m, p[kt][e]); }
        m = fmaxf(m, __shfl_xor(m, 32));
        float l = 0.f;
#pragma unroll
        for (int kt = 0; kt < 5; ++kt)
#pragma unroll
            for (int e = 0; e < 16; ++e) { const float pe = __builtin_amdgcn_exp2f(p[kt][e] - m); p[kt][e] = pe; l += pe; }
        l += __shfl_xor(l, 32);
        f32x16_t o[2];
#pragma unroll
        for (int e = 0; e < 16; ++e) { o[0][e] = 0.f; o[1][e] = 0.f; }
#pragma unroll
        for (int kt = 0; kt < 5; ++kt)
#pragma unroll
            for (int s = 0; s < 2; ++s) {
                v4u pw; pw.x = cvtpk(p[kt][8 * s], p[kt][8 * s + 1]); pw.y = cvtpk(p[kt][8 * s + 2], p[kt][8 * s + 3]); pw.z = cvtpk(p[kt][8 * s + 4], p[kt][8 * s + 5]); pw.w = cvtpk(p[kt][8 * s + 6], p[kt][8 * s + 7]);
                const bf16x8_t pb = __builtin_bit_cast(bf16x8_t, pw);
                const int row0 = 32 * w + 32 * kt + 16 * s + 4 * hh + q4;
#pragma unroll
                for (int db = 0; db < 2; ++db) { const LAS char* vp = VL + row0 * RS + (32 * db + 16 * blk + 4 * p4) * 2;
                    const s16x4_t lo = ldtr(vp), hi = ldtr(vp + 8 * RS);
                    const bf16x8_t af = __builtin_shufflevector(lo, hi, 0, 1, 2, 3, 4, 5, 6, 7);
                    o[db] = __builtin_amdgcn_mfma_f32_32x32x16_bf16(af, pb, o[db], 0, 0, 0); } }
        const float il = 1.0f / l;
        bf16* op = (bf16*)(a.ws() + WS_ATTP) + ((size_t)dc.pat * T + growc) * 256 + dc.h * 64;
#pragma unroll
        for (int db = 0; db < 2; ++db)
#pragma unroll
            for (int g = 0; g < 4; ++g) { v2u wv; wv.x = cvtpk(o[db][4 * g] * il, o[db][4 * g + 1] * il); wv.y = cvtpk(o[db][4 * g + 2] * il, o[db][4 * g + 3] * il);
                *(v2u*)(op + 32 * db + 8 * g + 4 * hh) = wv; }
        if (hh == 0) ((float*)(a.ws() + WS_LSE))[((size_t)dc.pat * T + growc) * 4 + dc.h] = (m + __log2f(l)) * 0.6931471805599453f;
        __syncthreads();
    }
}
DI void ret_load_rope_bf16(LAS char* dst, int rs, const bf16* proj, size_t grow0, int pos0, int col0, float scale, bool zeta, float lg, const float* tabR, int tid) {
    const int row = tid >> 2, qd = tid & 3;
    const bf16* src = proj + (grow0 + row) * NPROJ + col0;
    float own[16], par[16];
    { float t8[8]; unpack8(*(const v4u*)(src + qd * 16), t8);
#pragma unroll
      for (int e = 0; e < 8; ++e) own[e] = t8[e];
      unpack8(*(const v4u*)(src + qd * 16 + 8), t8);
#pragma unroll
      for (int e = 0; e < 8; ++e) own[8 + e] = t8[e];
      unpack8(*(const v4u*)(src + (qd ^ 2) * 16), t8);
#pragma unroll
      for (int e = 0; e < 8; ++e) par[e] = t8[e];
      unpack8(*(const v4u*)(src + (qd ^ 2) * 16 + 8), t8);
#pragma unroll
      for (int e = 0; e < 8; ++e) par[8 + e] = t8[e]; }
    const float* cs = tabR + ((size_t)(pos0 + row) * 32 + (qd & 1) * 16) * 2;
    float sc = scale; if (zeta) sc *= __expf(lg * (float)(127 - row));
    float o[16];
#pragma unroll
    for (int e = 0; e < 16; ++e) { const float c = cs[2 * e], s = cs[2 * e + 1]; o[e] = ((qd < 2) ? own[e] * c - par[e] * s : own[e] * c + par[e] * s) * sc; }
    v4u w0, w1; w0.x = pk2(o[0], o[1]); w0.y = pk2(o[2], o[3]); w0.z = pk2(o[4], o[5]); w0.w = pk2(o[6], o[7]); w1.x = pk2(o[8], o[9]); w1.y = pk2(o[10], o[11]); w1.z = pk2(o[12], o[13]); w1.w = pk2(o[14], o[15]);
    *(LAS v4u*)(dst + row * rs + qd * 32) = w0; *(LAS v4u*)(dst + row * rs + qd * 32 + 16) = w1;
}
constexpr int RKS = 144, RVS = 272;
DI void ret_kv_unit_mfma(const KArgs& a, LAS char* lds, int unit, int tid) {
    asm volatile("" : "+v"(tid));
    const int n = unit & 127, h = (unit >> 7) & 3, b = unit >> 9;
    LAS char* KL = lds; LAS char* VL = lds + 128 * RKS;
    const bf16* proj = (const bf16*)(a.ws() + WS_PROJ); const size_t grow0 = (size_t)b * SEQ + n * 128;
    const float lg = ret_loggamma(h);
    ret_load_rope_bf16(KL, RKS, proj, grow0, n * 128, C_KR + h * 64, 0.125f, true, lg, (const float*)(a.ws() + WS_TABR), tid);
    { const int row = tid >> 2, qq = tid & 3; const v4u* src = (const v4u*)(proj + (grow0 + row) * NPROJ + C_VR + h * 128 + qq * 32);
#pragma unroll
      for (int c = 0; c < 4; ++c) *(LAS v4u*)(VL + row * RVS + qq * 64 + c * 16) = src[c]; }
    __syncthreads();
    const int w = tid >> 6, lane = tid & 63, ql = lane & 31, hh = lane >> 5, q4 = (lane & 15) >> 2, p4 = lane & 3, blk = (lane >> 4) & 1;
    const int et = w >> 1, dt = w & 1;
    f32x16_t acc;
#pragma unroll
    for (int e = 0; e < 16; ++e) acc[e] = 0.f;
#pragma unroll
    for (int s = 0; s < 8; ++s) { const int row0 = 16 * s + 8 * hh + q4;
        const LAS char* vp = VL + row0 * RVS + (32 * et + 16 * blk + 4 * p4) * 2; const LAS char* kp = KL + row0 * RKS + (32 * dt + 16 * blk + 4 * p4) * 2;
        const s16x4_t alo = ldtr(vp), ahi = ldtr(vp + 4 * RVS), blo = ldtr(kp), bhi = ldtr(kp + 4 * RKS);
        const bf16x8_t af = __builtin_shufflevector(alo, ahi, 0, 1, 2, 3, 4, 5, 6, 7), bfr = __builtin_shufflevector(blo, bhi, 0, 1, 2, 3, 4, 5, 6, 7);
        acc = __builtin_amdgcn_mfma_f32_32x32x16_bf16(af, bfr, acc, 0, 0, 0); }
    float* kv = (float*)(a.ws() + WS_KV) + ((size_t)((b * 4 + h) * 128 + n)) * 8192;
#pragma unroll
    for (int e = 0; e < 16; ++e) kv[(32 * et + crow16(e, hh)) * 64 + 32 * dt + ql] = acc[e];
    __syncthreads();
}
struct RetRaw { v4u q[4], k[4], v[4], g[4]; f32x4 pv[4]; };
DI void ret_issue(const KArgs& a, int unit, int tid, RetRaw& r) {
    const int n = unit & 127, h = (unit >> 7) & 3, b = unit >> 9, row = tid >> 2, qd = tid & 3;
    const bf16* base = (const bf16*)(a.ws() + WS_PROJ) + ((size_t)b * SEQ + n * 128 + row) * NPROJ;
    const bf16* sq = base + C_QR + h * 64; const bf16* sk = base + C_KR + h * 64; const bf16* sv = base + C_VR + h * 128 + qd * 32;
    r.q[0] = *(const v4u*)(sq + qd * 16); r.q[1] = *(const v4u*)(sq + qd * 16 + 8); r.q[2] = *(const v4u*)(sq + (qd ^ 2) * 16); r.q[3] = *(const v4u*)(sq + (qd ^ 2) * 16 + 8);
    r.k[0] = *(const v4u*)(sk + qd * 16); r.k[1] = *(const v4u*)(sk + qd * 16 + 8); r.k[2] = *(const v4u*)(sk + (qd ^ 2) * 16); r.k[3] = *(const v4u*)(sk + (qd ^ 2) * 16 + 8);
#pragma unroll
    for (int c = 0; c < 4; ++c) { r.v[c] = *(const v4u*)(sv + 8 * c); r.g[c] = *(const v4u*)(base + C_GR + h * 128 + qd * 32 + 8 * c); }
    const f32x4* sp = (const f32x4*)((const float*)(a.ws() + WS_KV) + ((size_t)((b * 4 + h) * 128 + n)) * 8192 + row * 64 + qd * 16);
#pragma unroll
    for (int c = 0; c < 4; ++c) r.pv[c] = sp[c];
}
DI void ret_rope_store(LAS char* dst, const v4u (&raw)[4], const float* cs, int qd, float scale) {
    float own[16], par[16];
    { float t8[8]; unpack8(raw[0], t8);
#pragma unroll
      for (int e = 0; e < 8; ++e) own[e] = t8[e];
      unpack8(raw[1], t8);
#pragma unroll
      for (int e = 0; e < 8; ++e) own[8 + e] = t8[e];
      unpack8(raw[2], t8);
#pragma unroll
      for (int e = 0; e < 8; ++e) par[e] = t8[e];
      unpack8(raw[3], t8);
#pragma unroll
      for (int e = 0; e < 8; ++e) par[8 + e] = t8[e]; }
    float o[16];
#pragma unroll
    for (int e = 0; e < 16; ++e) { const float c = cs[2 * e], s = cs[2 * e + 1]; o[e] = ((qd < 2) ? own[e] * c - par[e] * s : own[e] * c + par[e] * s) * scale; }
    v4u w0, w1; w0.x = pk2(o[0], o[1]); w0.y = pk2(o[2], o[3]); w0.z = pk2(o[4], o[5]); w0.w = pk2(o[6], o[7]); w1.x = pk2(o[8], o[9]); w1.y = pk2(o[10], o[11]); w1.z = pk2(o[12], o[13]); w1.w = pk2(o[14], o[15]);
    *(LAS v4u*)dst = w0; *(LAS v4u*)(dst + 16) = w1;
}
template <class F> DI void ret_out_run(const KArgs& a, LAS char* lds, int layer, int nun, const F& unit_of, int tid) {
    asm volatile("" : "+v"(tid));
    if (nun <= 0) return;
    LAS char* QL = lds; LAS char* KL = lds + 128 * RKS; LAS char* VL = lds + 2 * 128 * RKS; LAS char* PL = VL + 128 * RVS; LAS float* ST = (LAS float*)(PL + 128 * RKS);
    const bf16* proj = (const bf16*)(a.ws() + WS_PROJ); const float* tabR = (const float*)(a.ws() + WS_TABR);
    const int w = tid >> 6, lane = tid & 63, ql = lane & 31, hh = lane >> 5, q4 = (lane & 15) >> 2, p4 = lane & 3, blk = (lane >> 4) & 1;
    const int ib = w >> 1, eh = w & 1, i = 32 * ib + ql, row = tid >> 2, qd = tid & 3;
    RetRaw raw; int unit = unit_of(0);
    ret_issue(a, unit, tid, raw);
    for (int kk = 0; kk < nun; ++kk) {
        const int n = unit & 127, h = (unit >> 7) & 3, b = unit >> 9; const size_t grow0 = (size_t)b * SEQ + n * 128; const float lg = ret_loggamma(h);
        { const float* cs = tabR + ((size_t)(n * 128 + row) * 32 + (qd & 1) * 16) * 2;
          ret_rope_store(QL + row * RKS + qd * 32, raw.q, cs, qd, 1.0f); ret_rope_store(KL + row * RKS + qd * 32, raw.k, cs, qd, 0.125f * __expf(-lg * (float)(row + 1)));
#pragma unroll
          for (int c = 0; c < 4; ++c) *(LAS v4u*)(VL + row * RVS + qd * 64 + c * 16) = raw.v[c];
          v4u w0, w1; w0.x = pk2(raw.pv[0].x, raw.pv[0].y); w0.y = pk2(raw.pv[0].z, raw.pv[0].w); w0.z = pk2(raw.pv[1].x, raw.pv[1].y); w0.w = pk2(raw.pv[1].z, raw.pv[1].w);
          w1.x = pk2(raw.pv[2].x, raw.pv[2].y); w1.y = pk2(raw.pv[2].z, raw.pv[2].w); w1.z = pk2(raw.pv[3].x, raw.pv[3].y); w1.w = pk2(raw.pv[3].z, raw.pv[3].w);
          *(LAS v4u*)(PL + row * RKS + qd * 32) = w0; *(LAS v4u*)(PL + row * RKS + qd * 32 + 16) = w1; }
        v4u gcur[4];
#pragma unroll
        for (int c = 0; c < 4; ++c) gcur[c] = raw.g[c];
        __syncthreads();
        unit = unit_of(kk + 1 < nun ? kk + 1 : kk); ret_issue(a, unit, tid, raw);
        bf16x8_t qf[4], qsf[4];
        { const float xi = __expf(lg * (float)(i + 1));
#pragma unroll
          for (int s = 0; s < 4; ++s) { qf[s] = *(const LAS bf16x8_t*)(QL + i * RKS + 32 * s + 16 * hh); float t8[8]; unpack8(__builtin_bit_cast(v4u, qf[s]), t8);
              v4u ww; ww.x = cvtpk(t8[0] * xi, t8[1] * xi); ww.y = cvtpk(t8[2] * xi, t8[3] * xi); ww.z = cvtpk(t8[4] * xi, t8[5] * xi); ww.w = cvtpk(t8[6] * xi, t8[7] * xi); qsf[s] = __builtin_bit_cast(bf16x8_t, ww); } }
        f32x16_t o[2];
#pragma unroll
        for (int e = 0; e < 16; ++e) { o[0][e] = 0.f; o[1][e] = 0.f; }
#pragma unroll
        for (int t = 0; t < 2; ++t)
#pragma unroll
            for (int s = 0; s < 4; ++s) { const bf16x8_t af = *(const LAS bf16x8_t*)(PL + (64 * eh + 32 * t + ql) * RKS + 32 * s + 16 * hh); o[t] = __builtin_amdgcn_mfma_f32_32x32x16_bf16(af, qsf[s], o[t], 0, 0, 0); }
        for (int jb = 0; jb <= ib; ++jb) {
            f32x16_t p;
#pragma unroll
            for (int e = 0; e < 16; ++e) p[e] = 0.f;
#pragma unroll
            for (int s = 0; s < 4; ++s) { const bf16x8_t kf = *(const LAS bf16x8_t*)(KL + (32 * jb + ql) * RKS + 32 * s + 16 * hh); p = __builtin_amdgcn_mfma_f32_32x32x16_bf16(kf, qsf[s], p, 0, 0, 0); }
            if (jb == ib) {
#pragma unroll
                for (int e = 0; e < 16; ++e) p[e] = (ql >= crow16(e, hh)) ? p[e] : 0.f; }
#pragma unroll
            for (int s2 = 0; s2 < 2; ++s2) {
                v4u pw; pw.x = cvtpk(p[8 * s2], p[8 * s2 + 1]); pw.y = cvtpk(p[8 * s2 + 2], p[8 * s2 + 3]); pw.z = cvtpk(p[8 * s2 + 4], p[8 * s2 + 5]); pw.w = cvtpk(p[8 * s2 + 6], p[8 * s2 + 7]);
                const bf16x8_t pb = __builtin_bit_cast(bf16x8_t, pw);
                const int row0 = 32 * jb + 16 * s2 + 4 * hh + q4;
#pragma unroll
                for (int t = 0; t < 2; ++t) { const LAS char* vp = VL + row0 * RVS + (64 * eh + 32 * t + 16 * blk + 4 * p4) * 2;
                    const s16x4_t lo = ldtr(vp), hi = ldtr(vp + 8 * RVS);
                    const bf16x8_t af = __builtin_shufflevector(lo, hi, 0, 1, 2, 3, 4, 5, 6, 7);
                    o[t] = __builtin_amdgcn_mfma_f32_32x32x16_bf16(af, pb, o[t], 0, 0, 0); } }
        }
        float s1 = 0.f, s2 = 0.f;
#pragma unroll
        for (int t = 0; t < 2; ++t)
#pragma unroll
            for (int e = 0; e < 16; ++e) { s1 += o[t][e]; s2 += o[t][e] * o[t][e]; }
        s1 += __shfl_xor(s1, 32); s2 += __shfl_xor(s2, 32);
        if (hh == 0) { ST[((ib * 2 + eh) * 32 + ql) * 2] = s1; ST[((ib * 2 + eh) * 32 + ql) * 2 + 1] = s2; }
        __syncthreads();
        const float t1 = ST[((ib * 2) * 32 + ql) * 2] + ST[((ib * 2 + 1) * 32 + ql) * 2], t2 = ST[((ib * 2) * 32 + ql) * 2 + 1] + ST[((ib * 2 + 1) * 32 + ql) * 2 + 1];
        const float mu = t1 * (1.f / 128.f), var = fmaxf(t2 * (1.f / 128.f) - mu * mu, 0.f), rstd = rsqrtf(var + 1e-5f);
#pragma unroll
        for (int t = 0; t < 2; ++t)
#pragma unroll
            for (int g4 = 0; g4 < 4; ++g4) { v2u yw; yw.x = cvtpk((o[t][4 * g4] - mu) * rstd, (o[t][4 * g4 + 1] - mu) * rstd); yw.y = cvtpk((o[t][4 * g4 + 2] - mu) * rstd, (o[t][4 * g4 + 3] - mu) * rstd);
                *(LAS v2u*)(VL + i * RVS + (64 * eh + 32 * t + 8 * g4 + 4 * hh) * 2) = yw; }
        __syncthreads();
        { const float* gn = a.in(I_GNG) + layer * 512 + h * 128 + qd * 32;
          bf16* op = (bf16*)(a.ws() + WS_XN) + (grow0 + row) * DM + 256 + h * 128 + qd * 32;
#pragma unroll
          for (int c = 0; c < 4; ++c) { float y8[8], g8[8], o8[8]; unpack8(*(const LAS v4u*)(VL + row * RVS + qd * 64 + c * 16), y8); unpack8(gcur[c], g8);
              const f32x4 n0 = *(const f32x4*)(gn + 8 * c), n1 = *(const f32x4*)(gn + 8 * c + 4); const float nn[8] = {n0.x, n0.y, n0.z, n0.w, n1.x, n1.y, n1.z, n1.w};
#pragma unroll
              for (int e = 0; e < 8; ++e) o8[e] = g8[e] * sigmoidf_(g8[e]) * y8[e] * nn[e];
              *(v4u*)(op + 8 * c) = pack8(o8); } }
        __syncthreads();
    }
}
template <int PARTS = 3> DI void ssm_out_unit(const KArgs& a, LAS char* lds, int layer, int unit, int tid) {
    asm volatile("" : "+v"(tid));
    const int chunk = unit & 127, b = unit >> 7, wave = __builtin_amdgcn_readfirstlane(tid >> 6), lane = tid & 63;
    constexpr int ZLD = 528;
    LAS char* ZS = lds; LAS char* XS = lds + 128 * ZLD + wave * (16 * SSM_XLD); LAS char* UWb = lds + 128 * ZLD + 8 * 16 * SSM_XLD + wave * 512;
    const float* sst = (const float*)(a.ws() + WS_SST);
    if (PARTS & 1) for (int gi = 0; gi < 2; ++gi) { const int g = wave + 8 * gi;
        const size_t so = (((size_t)(b * 128 + chunk)) * 1024 + g * 64 + lane) * 2; float hr = sst[so], hi = sst[so + 1];
        ssm_wave_chunk<true>(a, layer, b, chunk, g, XS, UWb, ZS, ZLD, hr, hi, lane); }
    __syncthreads();
    if (!(PARTS & 2)) return;
    const int ql = lane & 31, hh = lane >> 5, n = 32 * wave + ql;
    const bf16* glwt = (const bf16*)(a.ws() + WS_SSM + (size_t)layer * SSM_LAYER_BYTES + SSM_GLWT);
    bf16x8_t bfr[16];
#pragma unroll
    for (int s = 0; s < 16; ++s) bfr[s] = *(const bf16x8_t*)(glwt + (size_t)n * 256 + 16 * s + 8 * hh);
    const float bn = a.in(I_GLB)[layer * 256 + n];
    bf16* mixed = (bf16*)(a.ws() + WS_XN); const size_t grow0 = (size_t)b * SEQ + chunk * 128;
#pragma unroll 1
    for (int rt = 0; rt < 4; ++rt) { f32x16_t acc;
#pragma unroll
        for (int e = 0; e < 16; ++e) acc[e] = 0.f;
#pragma unroll
        for (int s = 0; s < 16; ++s) { const bf16x8_t af = *(const LAS bf16x8_t*)(ZS + (32 * rt + ql) * ZLD + (16 * s + 8 * hh) * 2); acc = __builtin_amdgcn_mfma_f32_32x32x16_bf16(af, bfr[s], acc, 0, 0, 0); }
#pragma unroll
        for (int e = 0; e < 16; ++e) { const int t = 32 * rt + crow16(e, hh); const float z = bf2f(*(const LAS bf16*)(ZS + t * ZLD + n * 2));
            mixed[(grow0 + t) * DM + 768 + n] = (bf16)f2bf(z * sigmoidf_(acc[e] + bn)); } }
    __syncthreads();
}
#ifndef MK_PER_PHASE
#define MK_PER_PHASE 0
#endif

#ifdef DIS_KV
#define TST_KV(x)
#else
#define TST_KV(x) x
#endif
#ifdef DIS_ATT
#define TST_ATT(x)
#else
#define TST_ATT(x) x
#endif
#ifdef DIS_RO
#define TST_RO(x)
#else
#define TST_RO(x) x
#endif
#ifdef DIS_SO
#define TST_SO(x)
#else
#define TST_SO(x) x
#endif
#ifdef DIS_PRO
#define EN_PRO 0
#else
#define EN_PRO 1
#endif
#ifdef DIS_INP
#define EN_INP 0
#else
#define EN_INP 1
#endif
#ifdef DIS_M1
#define EN_M1 0
#else
#define EN_M1 1
#endif
#ifdef DIS_M2
#define EN_M2 0
#else
#define EN_M2 1
#endif
#ifdef DIS_M3
#define EN_M3 0
#else
#define EN_M3 1
#endif
#ifdef DIS_WOUT
#define EN_WOUT 0
#else
#define EN_WOUT 1
#endif
#ifdef DIS_N2
#define EN_N2 0
#else
#define EN_N2 1
#endif
#ifdef DIS_FUP
#define EN_FUP 0
#else
#define EN_FUP 1
#endif
#ifdef DIS_FDN
#define EN_FDN 0
#else
#define EN_FDN 1
#endif
#ifdef DIS_N1
#define EN_N1 0
#else
#define EN_N1 1
#endif
#ifdef DIS_MUP
#define EN_MUP 0
#else
#define EN_MUP 1
#endif
#ifdef DIS_MDN
#define EN_MDN 0
#else
#define EN_MDN 1
#endif

#ifdef DUP_RO
#define PROBE_RO(x) x
#else
#define PROBE_RO(x)
#endif
#ifdef DUP_SO
#define PROBE_SO(x) x
#else
#define PROBE_SO(x)
#endif
#ifndef THIN_REPS
#define THIN_REPS 1
#endif
#ifndef EXTRA_BARS
#define EXTRA_BARS 0
#endif
#ifndef WOUT_REPS
#define WOUT_REPS 1
#endif
#ifndef FDN_REPS
#define FDN_REPS 1
#endif
#ifndef MDN_EPI
#define MDN_EPI pg8::EpiMoeDown
#endif
#ifndef MDN_REPS
#define MDN_REPS 1
#endif
#ifndef RO_REPS
#define RO_REPS 1
#endif
#ifndef INP_REPS
#define INP_REPS 1
#endif
#ifndef FUP_REPS
#define FUP_REPS 1
#endif
#ifndef MUP_REPS
#define MUP_REPS 1
#endif
#ifdef DUP_CONV
#define MOECONV_REPS 2
#else
#define MOECONV_REPS 1
#endif
#ifdef DUP_ATT
#define PROBE_ATT(x) x
#else
#define PROBE_ATT(x)
#endif
#ifdef DUP_KV
#define PROBE_KV(x) x
#else
#define PROBE_KV(x)
#endif
#ifndef ATT_REPS
#define ATT_REPS 1
#endif
#ifndef SO_PARTS
#define SO_PARTS 3
#endif
#ifndef ORDER_SPLIT
#define ORDER_SPLIT 1
#endif
#ifndef CONV_IN_WOUT
#define CONV_IN_WOUT 1
#endif
#define MOE_ITEM(d, it_) do { const int e = (it_) / 5376; int r = (it_) - e * 5376; \
                    if (r < 3584) { const int up = r / 1792; r -= up * 1792; const int kb = r / 112, nb = r % 112, n0 = 32 * nb; \
                        d.W = args.in(up ? I_MU : I_MG) + (size_t)e * DM * DFE; d.ldw = DFE; d.WT = (unsigned char*)(ws + WS_MGU) + (size_t)e * 2 * DFE * DM; d.ldo = DM; d.k0 = 64 * kb; d.n0 = n0; d.drow0 = (n0 >> 7) * 256 + (n0 & 127) + up * 128; d.scale = 32.0f; } \
                    else { r -= 3584; const int kb = r / 32, nb = r % 32; \
                        d.W = args.in(I_MD) + (size_t)e * DFE * DM; d.ldw = DM; d.WT = (unsigned char*)(ws + WS_MDN) + (size_t)e * DM * DFE; d.ldo = DFE; d.k0 = 64 * kb; d.n0 = 32 * nb; d.drow0 = 32 * nb; d.scale = 64.0f; } } while (0)
#define MOE_CONV() do { float* scr = (float*)(L + wave * 16384); constexpr int NIT_ = 8 * 5376; \
                for (int rep_ = 0; rep_ < MOECONV_REPS; ++rep_) \
                    for (int it = gw; it < NIT_; it += 2 * NGW) { const int it2 = (it + NGW < NIT_) ? it + NGW : it;     \
                        T8Item da, db; float va[32], vb[32]; MOE_ITEM(da, it); MOE_ITEM(db, it2); t8_load(va, da, lane); t8_load(vb, db, lane); \
                        t8_store(va, da, scr, lane); t8_store(vb, db, scr, lane); } } while (0)
constexpr int PH_PRO = 0, PH_L0 = 1, PH_PER_LAYER = 13, NPH = 1 + 2 * PH_PER_LAYER;
__global__ void __launch_bounds__(NWAVES * 64, 2) fwd_kernel(Args args_) {
    const KArgs args;
    extern __shared__ __attribute__((aligned(16))) unsigned char lds[];
    const int tid0 = threadIdx.x;
    const int wave0 = __builtin_amdgcn_readfirstlane(tid0 >> 6);
    const int G = gridDim.x, bx = blockIdx.x, NGW = G * NWAVES;
#define PHASE_IDS int wave = wave0; asm volatile("" : "+s"(wave)); unsigned z_ = 0u; asm volatile("" : "+v"(z_)); const int lane = (int)__builtin_amdgcn_mbcnt_hi(~0u, __builtin_amdgcn_mbcnt_lo(~0u, z_)); const int tid = wave * 64 + lane, gw = bx * NWAVES + wave; (void)tid; (void)gw
    unsigned char* ws = args.ws();
    unsigned* ctl = (unsigned*)(ws + WS_CTL);
    volatile LAS unsigned* MISC = (volatile LAS unsigned*)((LAS unsigned char*)lds + MISC_OFF);
    if (tid0 < 32) MISC[tid0] = 0u;
    __syncthreads();
    const int lo = args.ph_lo(), hi = args.ph_hi();
    XcdBarrier bar; bar.bar = ctl + CW_BAR; bar.x = 0; bar.st = nullptr;
    if (hi - lo > 1) bar = xcd_barrier_post(ctl + CW_BAR, MISC + 8, tid0 == 0);
#define IN(k) (lo <= (k) && (k) < hi)
#define SEAM(k) do { if ((k) + 1 < hi) { int w_ = wave0; asm volatile("" : "+s"(w_)); unsigned zz_ = 0u; asm volatile("" : "+v"(zz_)); const int l_ = (int)__builtin_amdgcn_mbcnt_hi(~0u, __builtin_amdgcn_mbcnt_lo(~0u, zz_)); xcd_barrier(bar, (w_ * 64 + l_) == 0); } } while (0)
    char* L = (char*)lds;
    LAS unsigned char* L3 = (LAS unsigned char*)lds;
    bf16* XN = (bf16*)(ws + WS_XN); bf16* PROJ = (bf16*)(ws + WS_PROJ);

    if (EN_PRO && IN(PH_PRO)) { PHASE_IDS; for (int rep_ = 0; rep_ < THIN_REPS; ++rep_) phase_prologue(args, L, gw, NGW, wave, lane); for (int xb_ = 0; xb_ < EXTRA_BARS; ++xb_) SEAM(PH_PRO); SEAM(PH_PRO); }

#define LAYER_BODY(layer) do { \
        const int base = PH_L0 + layer * PH_PER_LAYER; \
         \
        if (EN_INP && IN(base + 0)) { PHASE_IDS; \
            pg8::Gemm g{layer == 0 ? XN : (const bf16*)(ws + WS_XN2), (const bf16*)(ws + WS_WIN) + (size_t)layer * NPROJ * DM, T, NPROJ, DM, DM}; pg8::StaticOrder S; S.init(T, NPROJ, G, bx); \
            LAS float* RS = (LAS float*)((LAS char*)lds + 132096); if (layer == 1) build_rs(RS, S, (const float*)(ws + WS_SSQ), tid); \
            pg8::EpiBf16 E{PROJ, NPROJ, layer == 1 ? RS : (LAS float*)nullptr}; \
            for (int rep_ = 0; rep_ < INP_REPS; ++rep_) pg8::gemm_phase<pg8::EpiBf16, pg8::StaticOrder, true, true, false>(L3, g, S, E, tid); \
            SEAM(base + 0); \
        } \
         \
        if (EN_M1 && IN(base + 1)) { \
            \
          const int og_ = ORDER_SPLIT ? ((bx >> 3) & 1) : 0; \
          _Pragma("unroll 1") for (int s_ = 0; s_ < 3; ++s_) { const int part_ = og_ ? 2 - s_ : s_; \
           if (part_ == 0) { PHASE_IDS; \
            const float* tabA = (const float*)(ws + WS_TABA); \
            prep_phase(PROJ, args.in(I_QNG) + layer * 64, args.in(I_KNG) + layer * 64, tabA, gw, NGW, lane); \
           } else if (part_ == 1) { \
            { PHASE_IDS; TST_KV(for (int u = bx; u < 1024; u += G) ret_kv_unit_mfma(args, (LAS char*)lds, u, tid);) } \
            PROBE_KV({ PHASE_IDS; for (int u = bx; u < 1024; u += G) ret_kv_unit_mfma(args, (LAS char*)lds, u, tid); }) \
           } else { \
            for (int rep_ = 0; rep_ < THIN_REPS; ++rep_) { PHASE_IDS; for (int u = bx; u < 256; u += G) { const int chunk = u & 127, b = u >> 7; LAS char* XS = (LAS char*)lds + wave * (16 * SSM_XLD); LAS char* UWb = (LAS char*)lds + 8 * 16 * SSM_XLD + wave * 512; \
                for (int gi = 0; gi < 2; ++gi) { const int g = wave + 8 * gi; float hr = 0.f, hi_ = 0.f; \
                    ssm_wave_chunk<false>(args, layer, b, chunk, g, XS, UWb, XS, 0, hr, hi_, lane); \
                    float* sst = (float*)(ws + WS_SST) + (((size_t)(b * 128 + chunk)) * 1024 + g * 64 + lane) * 2; sst[0] = hr; sst[1] = hi_; } \
                __syncthreads(); } } \
           } \
           __syncthreads(); } \
            SEAM(base + 1); \
        } \
         \
        if (EN_M2 && IN(base + 2)) { PHASE_IDS; \
            for (int u = bx; u < 128; u += G) {                     \
                const int gid = u * 512 + tid, bh = gid >> 13, el = gid & 8191; const float cd = __expf(ret_loggamma(bh & 3) * 128.0f); \
                float* p = (float*)(ws + WS_KV) + (size_t)bh * 128 * 8192 + el; float st = 0.f; \
                for (int n0 = 0; n0 < 128; n0 += 32) { float x[32]; \
                    _Pragma("unroll") for (int k = 0; k < 32; ++k) x[k] = p[(size_t)(n0 + k) * 8192]; \
                    _Pragma("unroll") for (int k = 0; k < 32; ++k) { p[(size_t)(n0 + k) * 8192] = st; st = cd * st + x[k]; } } } \
            { const int idx = (G >= 128) ? (bx >= 128 ? bx - 128 : bx + G - 128) : bx; \
              for (int u = idx; u < 4; u += G) {                    \
                const int gid = u * 512 + tid, b = gid >> 10, gp = gid & 1023; \
                const float* sp = (const float*)(ws + WS_SSM + (size_t)layer * SSM_LAYER_BYTES); const float ar = sp[SSM_ABARL / 4 + 2 * gp], ai = sp[SSM_ABARL / 4 + 2 * gp + 1]; \
                float* p = (float*)(ws + WS_SST) + ((size_t)b * 128 * 1024 + gp) * 2; float cr = 0.f, ci = 0.f; \
                for (int c0 = 0; c0 < 128; c0 += 32) { f32x2_t xv[32]; \
                    _Pragma("unroll") for (int k = 0; k < 32; ++k) xv[k] = *(const f32x2_t*)(p + (size_t)(c0 + k) * 2048); \
                    _Pragma("unroll") for (int k = 0; k < 32; ++k) { f32x2_t o_; o_.x = cr; o_.y = ci; *(f32x2_t*)(p + (size_t)(c0 + k) * 2048) = o_; const float nr = ar * cr - ai * ci + xv[k].x, ni = ar * ci + ai * cr + xv[k].y; cr = nr; ci = ni; } } } } \
            { PHASE_IDS; \
              if (G == 256) { const int na = bx < 128 ? 5 : 7; const int bx_ = bx; \
                  attn_run(args, (LAS char*)lds, na, [bx_](int k) { return (k < 6) ? bx_ + 256 * k : (bx_ - 128) + 1280; }, tid); } \
              else { const int bx_ = bx, G_ = G; attn_run(args, (LAS char*)lds, (1536 - bx + G - 1) / G, [bx_, G_](int k) { return bx_ + G_ * k; }, tid); } } \
            SEAM(base + 2); \
        } \
         \
        if (EN_M3 && IN(base + 3)) { \
          const int og_ = ORDER_SPLIT ? ((bx >> 3) & 1) : 0; \
          _Pragma("unroll 1") for (int s_ = 0; s_ < 3; ++s_) { const int part_ = og_ ? 2 - s_ : s_; \
           if (part_ == 0) { PHASE_IDS; \
            { const bf16* attp = (const bf16*)(ws + WS_ATTP); const float* lse = (const float*)(ws + WS_LSE); const int h = lane >> 4, sub = lane & 15; \
              for (int rep_ = 0; rep_ < THIN_REPS; ++rep_) for (int t0 = gw; t0 < T; t0 += 4 * NGW) { \
                float ls[4][3]; v2u ow[4][3]; \
                _Pragma("unroll") for (int r = 0; r < 4; ++r) { const int t = t0 + r * NGW; if (t < T) { \
                    _Pragma("unroll") for (int p = 0; p < 3; ++p) { ls[r][p] = lse[((size_t)p * T + t) * 4 + h]; ow[r][p] = *(const v2u*)(attp + ((size_t)p * T + t) * 256 + h * 64 + sub * 4); } } } \
                _Pragma("unroll") for (int r = 0; r < 4; ++r) { const int t = t0 + r * NGW; if (t < T) { \
                    const float M = fmaxf(ls[r][0], fmaxf(ls[r][1], ls[r][2])); const float w0 = __expf(ls[r][0] - M), w1 = __expf(ls[r][1] - M), w2 = __expf(ls[r][2] - M); const float iw = 1.0f / (w0 + w1 + w2); \
                    const float r0 = (w0 * bflo(ow[r][0].x) + w1 * bflo(ow[r][1].x) + w2 * bflo(ow[r][2].x)) * iw, r1 = (w0 * bfhi(ow[r][0].x) + w1 * bfhi(ow[r][1].x) + w2 * bfhi(ow[r][2].x)) * iw; \
                    const float r2 = (w0 * bflo(ow[r][0].y) + w1 * bflo(ow[r][1].y) + w2 * bflo(ow[r][2].y)) * iw, r3 = (w0 * bfhi(ow[r][0].y) + w1 * bfhi(ow[r][1].y) + w2 * bfhi(ow[r][2].y)) * iw; \
                    v2u w; w.x = pk2(r0, r1); w.y = pk2(r2, r3); *(v2u*)(XN + (size_t)t * DM + h * 64 + sub * 4) = w; } } } } \
           } else if (part_ == 1) { \
            for (int rep_ = 0; rep_ < RO_REPS; ++rep_) { PHASE_IDS; const int bx_ = bx, G_ = G; ret_out_run(args, (LAS char*)lds, layer, (1024 - bx + G - 1) / G, [bx_, G_](int k) { return bx_ + G_ * k; }, tid); } \
           } else { \
            { PHASE_IDS; TST_SO(for (int u = bx; u < 256; u += G) ssm_out_unit(args, (LAS char*)lds, layer, u, tid);) } \
            PROBE_SO({ PHASE_IDS; for (int u = bx; u < 256; u += G) ssm_out_unit<SO_PARTS>(args, (LAS char*)lds, layer, u, tid); }) \
           } \
           __syncthreads(); } \
            SEAM(base + 3); \
        } \
         \
        if (EN_WOUT && IN(base + 4)) { \
              \
            const int cgrp = (bx >> 3) & 1; \
            if (CONV_IN_WOUT && layer == 1 && cgrp == 0) { PHASE_IDS; MOE_CONV(); __syncthreads(); } \
            { PHASE_IDS; \
            pg8::Gemm g{XN, (const bf16*)(ws + WS_WOUT) + (size_t)layer * DM * DM, T, DM, DM, DM}; pg8::StaticOrder S; S.init(T, DM, G, bx); \
            for (int rep_ = 0; rep_ < WOUT_REPS; ++rep_) { pg8::EpiResF32 E{(layer == 0 && rep_ == 0) ? args.in(I_X) : args.out(), args.out(), DM, rep_ == WOUT_REPS - 1 ? 1.0f : 0.0f, layer == 0 ? (bf16*)(ws + WS_XN2) : (bf16*)nullptr, args.in(I_N2G), (float*)(ws + WS_SSQ)}; \
            pg8::gemm_phase<pg8::EpiResF32, pg8::StaticOrder, true, true, false>(L3, g, S, E, tid); } } \
            if (CONV_IN_WOUT && layer == 1 && cgrp == 1) { PHASE_IDS; __syncthreads(); MOE_CONV(); } \
            SEAM(base + 4); \
        } \
         \
        if (EN_N2 && layer == 1 && IN(base + 5)) { PHASE_IDS; \
            const float* g2 = args.in(I_N2G) + layer * DM; \
            if (layer == 1) { \
                int* sel_e = (int*)(L + 140000); float* sel_g = (float*)(L + 141024); int* lpair = (int*)(L + 142176); int* lpbase = (int*)(L + 142432); \
                float rw[16][8]; \
        _Pragma("unroll") \
                for (int j = 0; j < 4; ++j) \
        _Pragma("unroll") \
                    for (int c = 0; c < 4; ++c) { const f32x4* rp = (const f32x4*)(args.in(I_RT) + (size_t)(4 * lane + c + 256 * j) * 8); const f32x4 r0 = rp[0], r1 = rp[1]; \
                        rw[j * 4 + c][0] = r0.x; rw[j * 4 + c][1] = r0.y; rw[j * 4 + c][2] = r0.z; rw[j * 4 + c][3] = r0.w; rw[j * 4 + c][4] = r1.x; rw[j * 4 + c][5] = r1.y; rw[j * 4 + c][6] = r1.z; rw[j * 4 + c][7] = r1.w; } \
                f32x4 gg2[4]; \
                _Pragma("unroll") for (int j = 0; j < 4; ++j) gg2[j] = ((const f32x4*)g2)[lane + 64 * j]; \
                for (int u = bx; u < T / 128; u += G) { \
                    if (tid < 64) lpair[tid] = 0; \
                    for (int rr = 0; rr < 16; rr += 4) { f32x4 v[4][4]; \
                        _Pragma("unroll") for (int q_ = 0; q_ < 4; ++q_) { const int m = u * 128 + wave * 16 + rr + q_; \
                            _Pragma("unroll") for (int j = 0; j < 4; ++j) v[q_][j] = ((const f32x4*)(args.out() + (size_t)m * DM))[lane + 64 * j]; } \
                        _Pragma("unroll") for (int q_ = 0; q_ < 4; ++q_) { const int rl = wave * 16 + rr + q_, m = u * 128 + rl; float ss = 0.f; \
                            _Pragma("unroll") for (int j = 0; j < 4; ++j) ss += (v[q_][j].x * v[q_][j].x + v[q_][j].y * v[q_][j].y) + (v[q_][j].z * v[q_][j].z + v[q_][j].w * v[q_][j].w); \
                            const float rs = rsqrtf(wave_sum(ss) * (1.f / DM) + 1e-6f); \
                            _Pragma("unroll") for (int j = 0; j < 4; ++j) { v[q_][j] = v[q_][j] * rs * gg2[j]; ((unsigned*)((unsigned char*)XN + (size_t)m * DM))[lane + 64 * j] = pg8::pk4_fp8(v[q_][j].x, v[q_][j].y, v[q_][j].z, v[q_][j].w); } \
                            float pl[8]; \
                            _Pragma("unroll") for (int e = 0; e < 8; ++e) { float s = 0.f; \
                                _Pragma("unroll") for (int j = 0; j < 4; ++j) s += v[q_][j].x * rw[j * 4 + 0][e] + v[q_][j].y * rw[j * 4 + 1][e] + v[q_][j].z * rw[j * 4 + 2][e] + v[q_][j].w * rw[j * 4 + 3][e]; \
                                pl[e] = s; } \
                            const bool b5 = (lane & 32) != 0, b4 = (lane & 16) != 0, b3 = (lane & 8) != 0; float w4[4], w2[2], w1; \
                            _Pragma("unroll") for (int k = 0; k < 4; ++k) { const float send = b5 ? pl[k] : pl[k + 4], keep = b5 ? pl[k + 4] : pl[k]; w4[k] = keep + __shfl_xor(send, 32); } \
                            _Pragma("unroll") for (int k = 0; k < 2; ++k) { const float send = b4 ? w4[k] : w4[k + 2], keep = b4 ? w4[k + 2] : w4[k]; w2[k] = keep + __shfl_xor(send, 16); } \
                            { const float send = b3 ? w2[0] : w2[1], keep = b3 ? w2[1] : w2[0]; w1 = keep + __shfl_xor(send, 8); } \
                            w1 += __shfl_xor(w1, 4); w1 += __shfl_xor(w1, 2); w1 += __shfl_xor(w1, 1); \
                            float lg[8]; \
                            _Pragma("unroll") for (int e = 0; e < 8; ++e) lg[e] = __builtin_bit_cast(float, __builtin_amdgcn_readlane(__builtin_bit_cast(int, w1), 8 * e)); \
                            int e0 = 0; float l0 = lg[0]; \
                            _Pragma("unroll") for (int e = 1; e < 8; ++e) if (lg[e] > l0) { l0 = lg[e]; e0 = e; } \
                            int e1 = -1; float l1 = -INFINITY; \
                            _Pragma("unroll") for (int e = 0; e < 8; ++e) if (e != e0 && lg[e] > l1) { l1 = lg[e]; e1 = e; } \
                            const float g0 = 1.0f / (1.0f + __expf(l1 - l0)); \
                            if (lane == 0) { sel_e[rl * 2] = e0; sel_e[rl * 2 + 1] = e1; sel_g[rl * 2] = g0; sel_g[rl * 2 + 1] = 1.0f - g0; } } } \
                    __syncthreads(); \
                    int pr = 0, ppos = 0; \
                    if (tid < 128) { pr = sel_e[tid * 2] * 8 + sel_e[tid * 2 + 1]; ppos = atomicAdd(&lpair[pr], 1); } \
                    __syncthreads(); \
                    if (tid < 64) lpbase[tid] = (int)__hip_atomic_fetch_add(ctl + CW_PAIRCNT + tid, (unsigned)lpair[tid], __ATOMIC_RELAXED, __HIP_MEMORY_SCOPE_AGENT); \
                    __syncthreads(); \
                    if (tid < 128) { v4u ti; ti.x = (unsigned)(sel_e[tid * 2] | (sel_e[tid * 2 + 1] << 8)); ti.y = (unsigned)(lpbase[pr] + ppos); ti.z = __float_as_uint(sel_g[tid * 2]); ti.w = __float_as_uint(sel_g[tid * 2 + 1]); \
                        ((v4u*)(ws + WS_TOKINFO))[u * 128 + tid] = ti; } \
                    __syncthreads(); \
                } \
                if (!CONV_IN_WOUT) { MOE_CONV(); } \
            } \
            SEAM(base + 5); \
        } \
        if (layer == 1 && IN(base + 6)) { PHASE_IDS; \
            int* sel_e = (int*)(L + 140000); float* sel_g = (float*)(L + 141024); int* lcnt = (int*)(L + 142048); int* lbase = (int*)(L + 142112); int* fl = (int*)(L + 142688); int* pc = (int*)(L + 142944); int* pa = (int*)(L + 143200); \
            int* tokmap = (int*)(ws + WS_MAPS); float* gatemap = (float*)(ws + WS_MAPS + 2 * MiB); \
            if (tid < 64) { pc[tid] = (int)__hip_atomic_load(ctl + CW_PAIRCNT + tid, __ATOMIC_RELAXED, __HIP_MEMORY_SCOPE_AGENT); fl[tid] = 0; } \
            __syncthreads(); \
            if (tid == 0) { int rsum = 0; \
                for (int i = 0; i < 8; ++i) { int a_ = 0; for (int j = 0; j < 8; ++j) a_ += pc[i * 8 + j]; pa[i] = a_; pa[8 + i] = a_ & 255; pa[16 + i] = -(a_ & 255); rsum += a_ & 255; } \
                for (int m_ = rsum >> 8; m_ > 0; --m_) { int best = -1, bv = -1; for (int i = 0; i < 8; ++i) if (pa[16 + i] <= 0 && pa[8 + i] > bv) { bv = pa[8 + i]; best = i; } if (best >= 0) pa[16 + best] = 256 - pa[8 + best]; } \
                for (int i = 0; i < 8; ++i) if (pa[16 + i] < 0) { int s_ = -pa[16 + i]; \
                    for (int j = 0; j < 8 && s_ > 0; ++j) if (j != i && pa[16 + j] > 0) { int x_ = s_ < pa[16 + j] ? s_ : pa[16 + j]; if (x_ > pc[i * 8 + j]) x_ = pc[i * 8 + j]; fl[i * 8 + j] = x_; s_ -= x_; pa[16 + j] -= x_; } } } \
            __syncthreads(); \
            for (int u = bx; u < T / 128; u += G) { \
                if (tid < 16) lcnt[tid] = 0; \
                if (tid < 128) { const v4u ti = ((const v4u*)(ws + WS_TOKINFO))[u * 128 + tid]; const int e0 = (int)(ti.x & 255u), e1 = (int)((ti.x >> 8) & 255u); const bool flip = (int)ti.y < fl[e0 * 8 + e1]; \
                    sel_e[tid * 2] = flip ? e1 : e0; sel_e[tid * 2 + 1] = flip ? e0 : e1; sel_g[tid * 2] = __uint_as_float(flip ? ti.w : ti.z); sel_g[tid * 2 + 1] = __uint_as_float(flip ? ti.z : ti.w); } \
                __syncthreads(); \
                int e = 0, posv = 0; const int rl = tid >> 1, r = tid & 1; \
                if (tid < 256) { e = sel_e[rl * 2 + r]; posv = atomicAdd(&lcnt[r * 8 + e], 1); } \
                __syncthreads(); \
                if (tid < 16) lbase[tid] = (int)__hip_atomic_fetch_add(ctl + CW_MOECNT + tid, (unsigned)lcnt[tid], __ATOMIC_RELAXED, __HIP_MEMORY_SCOPE_AGENT); \
                __syncthreads(); \
                if (tid < 256) { const int slot = lbase[r * 8 + e] + posv; tokmap[(size_t)(r * 8 + e) * 32768 + slot] = u * 128 + rl; gatemap[(size_t)(r * 8 + e) * 32768 + slot] = sel_g[rl * 2 + r]; } \
                __syncthreads(); \
            } \
            SEAM(base + 6); \
        } \
        if (layer == 0) { \
             \
            if (EN_FUP && IN(base + 6)) { PHASE_IDS; \
                pg8::Gemm g{(const bf16*)(ws + WS_XN2), (const bf16*)(ws + WS_FGU), T, 2 * DFF, DM, DM}; pg8::StaticOrder S; S.init(T, 2 * DFF, G, bx); \
                LAS float* RS = (LAS float*)((LAS char*)lds + 132096); build_rs(RS, S, (const float*)(ws + WS_SSQ), tid); \
                pg8::EpiSwiGLU E{(bf16*)(ws + WS_ACT), DFF, RS}; \
                for (int rep_ = 0; rep_ < FUP_REPS; ++rep_) pg8::gemm_phase<pg8::EpiSwiGLU, pg8::StaticOrder, true, true, false>(L3, g, S, E, tid); \
                SEAM(base + 6); \
            } \
            if (EN_FDN && IN(base + 7)) { PHASE_IDS; \
                pg8::Gemm g{(const bf16*)(ws + WS_ACT), (const bf16*)(ws + WS_FDN), T, DM, DFF, DFF}; pg8::StaticOrder S; S.init(T, DM, G, bx); \
                for (int rep_ = 0; rep_ < FDN_REPS; ++rep_) { pg8::EpiResF32 E{args.out(), args.out(), DM, rep_ == FDN_REPS - 1 ? 1.0f : 0.0f, (bf16*)(ws + WS_XN2), args.in(I_N1G) + DM, (float*)(ws + WS_SSQ)}; \
                pg8::gemm_phase<pg8::EpiResF32, pg8::StaticOrder, true, true, false>(L3, g, S, E, tid); } \
                SEAM(base + 7); \
            } \
        } else { \
             \
          \
        const int mgrp = (bx >> 3) & 1; \
        _Pragma("unroll 1") \
            for (int st = 0; st < 4; ++st) { \
                const bool is_up = (st == 0) || (st == 1 && mgrp == 0) || (st == 2 && mgrp == 1); const int r = (st == 0) ? 0 : (st == 3) ? 1 : (is_up ? 1 : 0); \
                const int* tokmap = (const int*)(ws + WS_MAPS) + (size_t)r * 8 * 32768; const float* gatemap = (const float*)(ws + WS_MAPS + 2 * MiB) + (size_t)r * 8 * 32768; \
                unsigned char* mact = ws + (r == 0 ? WS_MACT : WS_MACT2); \
                if (is_up) { if (EN_MUP && IN(base + 7)) { PHASE_IDS; \
                    pg8::Gemm g{XN, (const bf16*)(ws + WS_MGU), 0, 2 * DFE, DM, DM}; pg8::MoeOrder S; S.init_moe(ctl + CW_MOECNT + r * 8, tokmap, 2 * DFE, G, bx); S.build_ltab((LAS int*)((LAS char*)lds + 132096), tid); \
                    pg8::EpiSwiGLU8 E{mact, DFE, 1.0f / 32.0f, 4.0f}; \
                    for (int rep_ = 0; rep_ < MUP_REPS; ++rep_) pg8::gemm_phase<pg8::EpiSwiGLU8, pg8::MoeOrder, true, true, true, true>(L3, g, S, E, tid); \
                } } else { if (EN_MDN && IN(base + 7)) { PHASE_IDS; \
                    pg8::Gemm g{(const bf16*)mact, (const bf16*)(ws + WS_MDN), 0, DM, DFE, DFE}; pg8::MoeOrder S; S.init_moe(ctl + CW_MOECNT + r * 8, tokmap, DM, G, bx, r == 1 ? 128 : (1 << 20)); \
                    for (int rep_ = 0; rep_ < MDN_REPS; ++rep_) { MDN_EPI E{args.out(), DM, tokmap, gatemap, rep_ == MDN_REPS - 1 ? (1.0f / 256.0f) : 0.0f}; \
                    pg8::gemm_phase<MDN_EPI, pg8::MoeOrder, true, true, false, true>(L3, g, S, E, tid); } \
                    if (r == 1) { pg8::MoeOrder SA; SA.init_moe(ctl + CW_MOECNT + r * 8, tokmap, DM, G, bx); const int ntl = (SA.tiles() - 128) * 4; const int KS = ntl <= 18 ? 14 : 7;     \
                      pg8::MoeTailOrder ST; ST.init(&SA, G, bx, KS, DFE / KS, 32); \
                      pg8::Gemm gt{(const bf16*)mact, (const bf16*)(ws + WS_MDN), 0, DM, DFE / KS, DFE}; pg8::EpiPart EP{(float*)(ws + WS_XN)}; \
                      pg8::gemm_phase<pg8::EpiPart, pg8::MoeTailOrder, true, true, false, true>(L3, gt, ST, EP, tid); } \
                } } \
                __syncthreads(); \
                if (st != 1) SEAM(base + 7 + st); \
            } \
            { const int r = 1; const int* tokmap = (const int*)(ws + WS_MAPS) + (size_t)r * 8 * 32768; const float* gatemap = (const float*)(ws + WS_MAPS + 2 * MiB) + (size_t)r * 8 * 32768; \
                if (EN_MDN && IN(base + 12)) { PHASE_IDS; \
                    pg8::MoeOrder SA; SA.init_moe(ctl + CW_MOECNT + r * 8, tokmap, DM, G, bx); int ntl = (SA.tiles() - 128) * 4; ntl = ntl < 0 ? 0 : (ntl > 32 ? 32 : ntl); const int KS = ntl <= 18 ? 14 : 7; \
                    const float* part = (const float*)(ws + WS_XN); float* outp = args.out(); \
                    for (int gi = bx * 512 + tid; gi < ntl * 16384; gi += G * 512) { const int t = gi >> 14, row = (gi >> 6) & 255, c4 = gi & 63; \
                        pg8::Unit u; u.pm = 128 + (t >> 2); u.pn = t & 3; SA.decode(u); const int slot = u.r0 + row; \
                        if (slot < u.cn) { const int tk = tokmap[u.e * 32768 + slot]; const float gt_ = gatemap[u.e * 32768 + slot]; \
                            f32x4 s = (f32x4){0.f, 0.f, 0.f, 0.f}; \
                            for (int ks = 0; ks < KS; ++ks) s = s + *(const f32x4*)(part + (size_t)(t * KS + ks) * 65536 + row * 256 + c4 * 4); \
                            float* op = outp + (size_t)tk * DM + u.pn * 256 + c4 * 4; *(f32x4*)op = *(const f32x4*)op + s * (gt_ * (1.0f / 256.0f)); } } \
                    SEAM(base + 12); \
                } \
            } \
        } \
    } while (0)
    LAYER_BODY(0);
    LAYER_BODY(1);
#undef LAYER_BODY
#undef IN
#undef SEAM
}

extern "C" void kernel_launch(void* const* d_in, const int* in_sizes, int n_in, void* d_out, int out_size, void* d_ws, size_t ws_size, hipStream_t stream) {
    static int grid = 0;
    if (grid == 0) {
        if (n_in != 25 || in_sizes[0] != T * DM || out_size != T * DM || ws_size < WS_END) { fprintf(stderr, "kernel_launch: unexpected shapes (n_in %d, in0 %d, out %d, ws %zu); nothing launched\n", n_in, n_in > 0 ? in_sizes[0] : -1, out_size, ws_size); grid = -1; return; }
        int dev = 0, cus = 0, per_cu = 0;
        if (hipGetDevice(&dev) != hipSuccess || hipDeviceGetAttribute(&cus, hipDeviceAttributeMultiprocessorCount, dev) != hipSuccess) { grid = -1; return; }
        if (hipFuncSetAttribute((const void*)fwd_kernel, hipFuncAttributeMaxDynamicSharedMemorySize, LDS_BYTES) != hipSuccess) { fprintf(stderr, "kernel_launch: hipFuncSetAttribute failed\n"); grid = -1; return; }
        if (hipOccupancyMaxActiveBlocksPerMultiprocessor(&per_cu, (const void*)fwd_kernel, NWAVES * 64, LDS_BYTES) != hipSuccess || per_cu < 1) { fprintf(stderr, "kernel_launch: occupancy query reports %d blocks per CU\n", per_cu); }
        (void)hipGetLastError();
        grid = cus;
    }
    if (grid < 0) return;
    (void)hipMemsetAsync((char*)d_ws + WS_CTL, 0, CTL_ZERO_BYTES, stream);
    Args a{};
    for (int i = 0; i < 25; ++i) a.in[i] = (const float*)d_in[i];
    a.out = (float*)d_out; a.ws = (unsigned char*)d_ws;
#if MK_PER_PHASE
    for (int p = 0; p < NPH; ++p) { if (p == PH_L0 + 6 + 3 || p == PH_L0 + 6 + 4) continue; a.ph_lo = p; a.ph_hi = p + 1; hipLaunchKernelGGL(fwd_kernel, dim3(grid), dim3(NWAVES * 64), LDS_BYTES, stream, a); }
#else
    a.ph_lo = 0; a.ph_hi = NPH; hipLaunchKernelGGL(fwd_kernel, dim3(grid), dim3(NWAVES * 64), LDS_BYTES, stream, a);
#endif
}
```

```cpp
#include <hip/hip_runtime.h>
#include <cstdio>
#include <cstdint>
namespace pg8 {
#define PG8_LAS __attribute__((address_space(3)))
typedef unsigned short bf16_t;
typedef short bf16x8 __attribute__((ext_vector_type(8)));
typedef float f32x4 __attribute__((ext_vector_type(4)));
typedef unsigned u32x4 __attribute__((ext_vector_type(4)));
typedef int i32x4 __attribute__((ext_vector_type(4)));
constexpr int BM = 256, BK = 64, HALF = 128, HTB = HALF * BK * 2  , STAGE_BYTES = 8 * HTB, NXCD = 8, WGM = 8;

__host__ __device__ __forceinline__ int lds_byte(int r, int c) { const int st = (r >> 4) * 2 + (c >> 5), rr = r & 15, cc = c & 31, ob = rr * 64 + cc * 2; return st * 1024 + (ob ^ (((ob >> 9) & 1) << 5)); }
__host__ __device__ __forceinline__ void stage_rc(int b, int& R, int& C) { const int st = b / 1024, sb = b % 1024, swz = sb ^ (((sb >> 9) & 1) << 5); R = (st >> 1) * 16 + swz / 64; C = (st & 1) * 32 + (swz % 64) / 2; }
__host__ __device__ __forceinline__ int perm32(int rho) { const int n = rho >> 4, i = rho & 15; return 8 * (i >> 2) + 4 * n + (i & 3); }

struct Unit { int pm, pn, pb, e, r0, cn, koff, aux; };
struct Gemm { const bf16_t* A; const bf16_t* Bt; int M, N, K, ld; };

struct StaticOrder {
    int nM, nN, nwg, G, c;
    __host__ __device__ void init(int M, int N, int G_, int c_) { nM = M / BM; nN = N / BM; nwg = nM * nN; G = G_; c = c_; }
    __host__ __device__ bool next(int i, Unit& u) const {
        const long L = (long)i * G + c; if (L >= nwg) return false;
        int wgid = (int)L; { const int q = nwg / NXCD, r = nwg % NXCD, xcd = wgid % NXCD, off = wgid / NXCD; wgid = (xcd < r ? xcd * (q + 1) : r * (q + 1) + (xcd - r) * q) + off; }
        const int nig = WGM * nN, gid = wgid / nig, fm = gid * WGM, gsz = (nM - fm) < WGM ? (nM - fm) : WGM;
        u.pm = fm + ((wgid % nig) % gsz); u.pn = (wgid % nig) / gsz; u.pb = u.pn; u.e = 0; u.r0 = 0; u.cn = 0; u.koff = 0; u.aux = 0; return true;
    }
    __device__ __forceinline__ void a_ready(const Unit&) const {}
    __device__ __forceinline__ void done(const Unit&) const {}
    __device__ __forceinline__ int arow(const Unit&, int) const { return 0; }
};

__device__ __forceinline__ unsigned cvt_pk_bf16(float lo, float hi) { unsigned r; asm volatile("v_cvt_pk_bf16_f32 %0, %1, %2" : "=v"(r) : "v"(lo), "v"(hi)); return r; }

template <class Epi, class Sched, bool ALIGN_EPI = false, bool SP2 = false, bool GATHER = false, bool FP8 = false>
__device__ __forceinline__ void gemm_phase(PG8_LAS unsigned char* lds, const Gemm g, const Sched& S, const Epi& E, int tid) {
    asm volatile("" : "+v"(tid));
    const int wid = __builtin_amdgcn_readfirstlane(tid >> 6), lane = tid & 63, wr = wid >> 2, wc = wid & 3, fr = lane & 15, fq = lane >> 4;
    constexpr int ES = FP8 ? 1 : 2;
    const int K = g.ld, nt = (g.K * ES) / (BK * 2);
    unsigned voffA[2][2], voffN[2][2], voffB[2];
    const size_t kstep = (size_t)(BK * 2);
    const size_t hstep = (size_t)HALF * K * ES;
    const size_t tstep = 2 * hstep;
#pragma unroll
    for (int i = 0; i < 2; ++i) { int R, C; stage_rc(tid * 16 + i * 8192, R, C); const int Rb = Epi::PERM ? ((R & ~31) + perm32(R & 31)) : R;
        voffA[0][i] = (unsigned)(R * K * ES + C * 2); voffA[1][i] = voffA[0][i]; voffN[0][i] = voffA[0][i]; voffN[1][i] = voffA[0][i]; voffB[i] = (unsigned)(Rb * K * ES + C * 2); }
    const unsigned ldsw = (unsigned)wid * 1024u;
    const int aoff = lds_byte(wr * 64 + fr, fq * 8), boff = lds_byte(wc * 32 + fr, fq * 8);
#define PG8_SA(b, h) (((b) * 2 + (h)) * HTB)
#define PG8_SB(b, h) ((4 + (b) * 2 + (h)) * HTB)
#define PG8_STAGE(bufoff, gbase, voff) do { _Pragma("unroll") for (int _i = 0; _i < 2; ++_i) \
        __builtin_amdgcn_global_load_lds((const unsigned*)((const char*)(gbase) + (voff)[_i]), (PG8_LAS unsigned*)(lds + (bufoff) + ldsw + _i * 8192), 16, 0, 0); } while (0)
#define PG8_CAT8(x0, x1) __builtin_shufflevector(__builtin_bit_cast(i32x4, (x0)), __builtin_bit_cast(i32x4, (x1)), 0, 1, 2, 3, 4, 5, 6, 7)
#define PG8_STAGE_A(bufoff, gbase, h) do { if constexpr (GATHER) { PG8_STAGE(bufoff, gbase, voffA[h]); } else { PG8_STAGE(bufoff, (gbase) + (h) * hstep, voffA[0]); } } while (0)
#define PG8_LDA(dst, b, h) do { _Pragma("unroll") for (int m = 0; m < 4; ++m) { \
        if constexpr (FP8) { dst##8[m] = PG8_CAT8(*(const PG8_LAS bf16x8*)(lds + PG8_SA(b, h) + aoff + m * 2048), *(const PG8_LAS bf16x8*)(lds + PG8_SA(b, h) + aoff + m * 2048 + 1024)); } \
        else { _Pragma("unroll") for (int k = 0; k < 2; ++k) dst[m][k] = *(const PG8_LAS bf16x8*)(lds + PG8_SA(b, h) + aoff + m * 2048 + k * 1024); } } } while (0)
#define PG8_LDB(dst, b, h) do { _Pragma("unroll") for (int n = 0; n < 2; ++n) { \
        if constexpr (FP8) { dst##8[n] = PG8_CAT8(*(const PG8_LAS bf16x8*)(lds + PG8_SB(b, h) + boff + n * 2048), *(const PG8_LAS bf16x8*)(lds + PG8_SB(b, h) + boff + n * 2048 + 1024)); } \
        else { _Pragma("unroll") for (int k = 0; k < 2; ++k) dst[n][k] = *(const PG8_LAS bf16x8*)(lds + PG8_SB(b, h) + boff + n * 2048 + k * 1024); } } } while (0)
#define PG8_MMA(ai, bj, At, Bt) do { __builtin_amdgcn_s_setprio(1); \
        if constexpr (FP8) { _Pragma("unroll") for (int m = 0; m < 4; ++m) _Pragma("unroll") for (int n = 0; n < 2; ++n) \
            asm volatile("v_mfma_scale_f32_16x16x128_f8f6f4 %0, %1, %2, %0, %3, %3 op_sel_hi:[0,0,0]" : "+v"(acc[ai][bj][m][n]) : "v"(Bt##8[n]), "v"(At##8[m]), "v"(sc127)); } \
        else { _Pragma("unroll") for (int m = 0; m < 4; ++m) _Pragma("unroll") for (int n = 0; n < 2; ++n) _Pragma("unroll") for (int k = 0; k < 2; ++k) \
            acc[ai][bj][m][n] = __builtin_amdgcn_mfma_f32_16x16x32_bf16(Bt[n][k], At[m][k], acc[ai][bj][m][n], 0, 0, 0); } \
        __builtin_amdgcn_s_setprio(0); } while (0)
#define PG8_WAIT_V(n) asm volatile("s_waitcnt vmcnt(" #n ")" ::: "memory")
#define PG8_WAIT_L(n) asm volatile("s_waitcnt lgkmcnt(" #n ")" ::: "memory")
#define PG8_BAR __builtin_amdgcn_s_barrier()
#define PG8_SCHED __builtin_amdgcn_sched_barrier(0)
#define PG8_GOFF(vo, u) do { if constexpr (GATHER) { _Pragma("unroll") for (int _h = 0; _h < 2; ++_h) _Pragma("unroll") for (int _i = 0; _i < 2; ++_i) \
        { int _R, _C; stage_rc(tid * 16 + _i * 8192, _R, _C); vo[_h][_i] = (unsigned)S.arow((u), _h * HALF + _R) * (unsigned)(K * ES) + (unsigned)_C * 2u; } } } while (0)
    Unit cur, nxt; int ui = 0;
    if (!S.next(0, cur)) return;
    f32x4 acc[2][2][4][2];
#pragma unroll
    for (int a = 0; a < 2; ++a)
#pragma unroll
        for (int b = 0; b < 2; ++b)
#pragma unroll
            for (int m = 0; m < 4; ++m)
#pragma unroll
                for (int n = 0; n < 2; ++n) acc[a][b][m][n] = (f32x4){0.f, 0.f, 0.f, 0.f};
    bf16x8 At[4][2], B0[2][2], B1[2][2];
    typedef int i32x8 __attribute__((ext_vector_type(8))); i32x8 At8[4], B08[2], B18[2]; int sc127 = 127; asm volatile("" : "+v"(sc127));
    const char* cA = (const char*)g.A + (GATHER ? (size_t)0 : (size_t)cur.pm * tstep) + (size_t)cur.koff * ES; const char* cB = (const char*)g.Bt + (size_t)cur.pb * tstep + (size_t)cur.koff * ES;
    S.a_ready(cur);
    PG8_GOFF(voffA, cur);
    if constexpr (SP2) {
        PG8_STAGE(PG8_SB(0, 0), cB, voffB); PG8_STAGE(PG8_SB(0, 1), cB + hstep, voffB); PG8_STAGE_A(PG8_SA(0, 0), cA, 0); PG8_STAGE_A(PG8_SA(0, 1), cA, 1);
        if (wr == 1) PG8_BAR;
        PG8_WAIT_V(2); PG8_BAR;
        PG8_STAGE(PG8_SB(1, 0), cB + kstep, voffB); PG8_STAGE_A(PG8_SA(1, 0), cA + kstep, 0); PG8_STAGE(PG8_SB(1, 1), cB + hstep + kstep, voffB);
        PG8_WAIT_V(6); PG8_BAR;
    } else {
        PG8_STAGE(PG8_SB(0, 0), cB, voffB); PG8_STAGE_A(PG8_SA(0, 0), cA, 0); PG8_STAGE(PG8_SB(0, 1), cB + hstep, voffB); PG8_STAGE_A(PG8_SA(0, 1), cA, 1);
        if (wr == 1) PG8_BAR;
        PG8_WAIT_V(4); PG8_BAR;
        PG8_STAGE(PG8_SB(1, 0), cB + kstep, voffB); PG8_STAGE_A(PG8_SA(1, 0), cA + kstep, 0); PG8_STAGE(PG8_SB(1, 1), cB + hstep + kstep, voffB);
        PG8_WAIT_V(6); PG8_BAR;
    }
    for (;;) {
        const bool has_next = S.next(ui + 1, nxt);
        const char* nA = (has_next && !GATHER) ? (const char*)g.A + (size_t)nxt.pm * tstep + (size_t)nxt.koff * ES : cA; const char* nB = has_next ? (const char*)g.Bt + (size_t)nxt.pb * tstep + (size_t)nxt.koff * ES : cB;
        if constexpr (GATHER) { if (has_next) { PG8_GOFF(voffN, nxt); } else { _Pragma("unroll") for (int _h = 0; _h < 2; ++_h) _Pragma("unroll") for (int _i = 0; _i < 2; ++_i) voffN[_h][_i] = voffA[_h][_i]; } }
        for (int t = 0; t < nt; t += 2) {
            const bool last = (t == nt - 2);
            const char* a1 = cA + (size_t)(t + 1) * kstep;
            const char* a2 = last ? nA : cA + (size_t)(t + 2) * kstep; const char* b2 = last ? nB : cB + (size_t)(t + 2) * kstep;
            const char* a3 = a2 + kstep; const char* b3 = b2 + kstep;
            if (last && has_next) S.a_ready(nxt);
            if constexpr (SP2) {
            PG8_LDB(B0, 0, 0); PG8_LDB(B1, 0, 1); PG8_SCHED; PG8_LDA(At, 0, 0); PG8_STAGE_A(PG8_SA(1, 1), a1, 1);
            if constexpr (GATHER) { if (last) { _Pragma("unroll") for (int _h = 0; _h < 2; ++_h) _Pragma("unroll") for (int _i = 0; _i < 2; ++_i) voffA[_h][_i] = voffN[_h][_i]; } }
            PG8_WAIT_V(8); PG8_WAIT_L(0); PG8_BAR; PG8_MMA(0, 0, At, B0); PG8_MMA(0, 1, At, B1); PG8_BAR; PG8_SCHED;
            PG8_LDA(At, 0, 1); PG8_STAGE(PG8_SB(0, 0), b2, voffB); PG8_STAGE(PG8_SB(0, 1), b2 + hstep, voffB); PG8_STAGE_A(PG8_SA(0, 0), a2, 0);
            PG8_WAIT_V(8); PG8_WAIT_L(0); PG8_BAR; PG8_MMA(1, 0, At, B0); PG8_MMA(1, 1, At, B1); PG8_BAR; PG8_SCHED;
            PG8_LDB(B0, 1, 0); PG8_LDB(B1, 1, 1); PG8_SCHED; PG8_LDA(At, 1, 0); PG8_STAGE_A(PG8_SA(0, 1), a2, 1);
            PG8_WAIT_V(8); PG8_WAIT_L(0); PG8_BAR; PG8_MMA(0, 0, At, B0); PG8_MMA(0, 1, At, B1); PG8_BAR; PG8_SCHED;
            PG8_LDA(At, 1, 1); PG8_STAGE(PG8_SB(1, 0), b3, voffB); PG8_STAGE(PG8_SB(1, 1), b3 + hstep, voffB); PG8_STAGE_A(PG8_SA(1, 0), a3, 0);
            PG8_WAIT_V(8); PG8_WAIT_L(0); PG8_BAR; PG8_MMA(1, 0, At, B0); PG8_MMA(1, 1, At, B1); PG8_BAR; PG8_SCHED;
            } else {
            PG8_LDB(B0, 0, 0); PG8_SCHED; PG8_LDA(At, 0, 0); PG8_STAGE_A(PG8_SA(1, 1), a1, 1);
            if constexpr (GATHER) { if (last) { _Pragma("unroll") for (int _h = 0; _h < 2; ++_h) _Pragma("unroll") for (int _i = 0; _i < 2; ++_i) voffA[_h][_i] = voffN[_h][_i]; } }
            PG8_WAIT_L(8); PG8_BAR; PG8_WAIT_L(0); PG8_MMA(0, 0, At, B0); PG8_BAR; PG8_SCHED;
            PG8_LDB(B1, 0, 1); PG8_STAGE(PG8_SB(0, 0), b2, voffB);
            PG8_BAR; PG8_WAIT_L(0); PG8_MMA(0, 1, At, B1); PG8_BAR;
            PG8_LDA(At, 0, 1); PG8_STAGE_A(PG8_SA(0, 0), a2, 0);
            PG8_BAR; PG8_WAIT_L(0); PG8_MMA(1, 0, At, B0); PG8_BAR; PG8_SCHED;
            PG8_STAGE(PG8_SB(0, 1), b2 + hstep, voffB);
            PG8_WAIT_V(6); PG8_BAR; PG8_MMA(1, 1, At, B1); PG8_BAR;
            PG8_LDB(B0, 1, 0); PG8_SCHED; PG8_LDA(At, 1, 0); PG8_STAGE_A(PG8_SA(0, 1), a2, 1);
            PG8_WAIT_L(8); PG8_BAR; PG8_WAIT_L(0); PG8_MMA(0, 0, At, B0); PG8_BAR; PG8_SCHED;
            PG8_LDB(B1, 1, 1); PG8_STAGE(PG8_SB(1, 0), b3, voffB);
            PG8_BAR; PG8_WAIT_L(0); PG8_MMA(0, 1, At, B1); PG8_BAR;
            PG8_LDA(At, 1, 1); PG8_STAGE_A(PG8_SA(1, 0), a3, 0);
            PG8_BAR; PG8_WAIT_L(0); PG8_MMA(1, 0, At, B0); PG8_BAR; PG8_SCHED;
            PG8_STAGE(PG8_SB(1, 1), b3 + hstep, voffB);
            PG8_WAIT_V(6); PG8_BAR; PG8_MMA(1, 1, At, B1); PG8_BAR;
            }
        }
        if constexpr (FP8) asm volatile("s_nop 15\n\ts_nop 15" ::: "memory");
        if constexpr (ALIGN_EPI) { if (wr == 0) PG8_BAR; }
        E(acc, cur, wr, wc, fr, fq, ui); S.done(cur);
        if (!has_next) break;
#pragma unroll
        for (int a = 0; a < 2; ++a)
#pragma unroll
            for (int b = 0; b < 2; ++b)
#pragma unroll
                for (int m = 0; m < 4; ++m)
#pragma unroll
                    for (int n = 0; n < 2; ++n) acc[a][b][m][n] = (f32x4){0.f, 0.f, 0.f, 0.f};
        cur = nxt; cA = nA; cB = nB; ++ui;
        if constexpr (ALIGN_EPI) { if (wr == 1) PG8_BAR; }
    }
    PG8_WAIT_V(0);
    if constexpr (!ALIGN_EPI) { if (wr == 0) PG8_BAR; }
    PG8_BAR;
#undef PG8_SA
#undef PG8_SB
#undef PG8_STAGE
#undef PG8_STAGE_A
#undef PG8_LDA
#undef PG8_LDB
#undef PG8_MMA
#undef PG8_CAT8
#undef PG8_WAIT_V
#undef PG8_WAIT_L
#undef PG8_BAR
#undef PG8_SCHED
#undef PG8_GOFF
}
}
constexpr int BATCH = 2, SEQ = 16384, T = BATCH * SEQ, DM = 1024, NPROJ = 2560, DFF = 2816, NEXP = 8, DFE = 3584, DEPTH = 2;
constexpr int C_QA = 0, C_KA = 256, C_VA = 512, C_QR = 768, C_KR = 1024, C_VR = 1280, C_GR = 1792, C_US = 2304;
constexpr int NCHUNK = SEQ / 128;
constexpr int NWAVES = 8;
constexpr size_t MiB = 1u << 20;
constexpr size_t WS_CTL = 511 * MiB, CTL_ZERO_BYTES = 1 * MiB;
constexpr size_t WS_TABA = 510 * MiB;
constexpr size_t WS_TABR = 506 * MiB;
constexpr size_t WS_SSM = 504 * MiB;
constexpr size_t SSM_LAYER_BYTES = 512 * 1024, SSM_ABAR = 0, SSM_ABARL = 8192, SSM_BMT = 16384, SSM_CMT = 81920, SSM_GLWT = 147456;
constexpr size_t WS_MAPS = 500 * MiB;
constexpr size_t WS_TOKINFO = 499 * MiB;
constexpr size_t WS_WIN = 494 * MiB;
constexpr size_t WS_WOUT = 490 * MiB;
constexpr size_t WS_FGU = 479 * MiB;
constexpr size_t WS_FDN = 473 * MiB;
constexpr size_t WS_XN = 408 * MiB;
constexpr size_t WS_PROJ = 248 * MiB;
constexpr size_t WS_ATTP = 200 * MiB;
constexpr size_t WS_LSE = 198 * MiB;
constexpr size_t WS_KV = 166 * MiB;
constexpr size_t WS_SST = 164 * MiB;
constexpr size_t WS_XN2 = 168 * MiB;
constexpr size_t WS_SSQ = 162 * MiB;
constexpr size_t WS_ACT = 232 * MiB;
constexpr size_t WS_MGU = 352 * MiB;
constexpr size_t WS_MDN = 268 * MiB;
constexpr size_t WS_MACT = 121 * MiB;
constexpr size_t WS_MACT2 = 2 * MiB;
constexpr size_t WS_END = 512 * MiB;
static_assert(WS_MACT2 + (size_t)135 * 256 * DFE <= WS_MACT && WS_MACT + (size_t)135 * 256 * DFE <= 240 * MiB, "ws map");
constexpr int CW_BAR = 4096;
constexpr int CW_MOECNT = 16384;
constexpr int CW_PAIRCNT = 16384 + 64;
constexpr int SCR_BYTES = 155648;
constexpr int MISC_OFF = SCR_BYTES;
constexpr int LDS_BYTES = 159744;

#define GAS __attribute__((address_space(1)))
#define LAS __attribute__((address_space(3)))
typedef unsigned short bf16;
typedef unsigned v4u __attribute__((ext_vector_type(4)));
typedef unsigned v2u __attribute__((ext_vector_type(2)));
typedef float f32x4 __attribute__((ext_vector_type(4)));
typedef GAS unsigned gu32;
#define RLX_AGENT __ATOMIC_RELAXED, __HIP_MEMORY_SCOPE_AGENT
#define LDS_WAIT() asm volatile("s_waitcnt lgkmcnt(0)" ::: "memory")
#define VM_WAIT() asm volatile("s_waitcnt vmcnt(0)" ::: "memory")
#define DI __device__ __forceinline__
DI unsigned f2bf(float f) { unsigned u = __builtin_bit_cast(unsigned, f); return (u + 0x7fffu + ((u >> 16) & 1u)) >> 16; }
DI unsigned pk2(float lo, float hi) { return f2bf(lo) | (f2bf(hi) << 16); }
DI float bflo(unsigned w) { return __uint_as_float(w << 16); }
DI float bfhi(unsigned w) { return __uint_as_float(w & 0xffff0000u); }
DI float bf2f(bf16 h) { return __uint_as_float((unsigned)h << 16); }
DI float wave_sum(float v) {
#pragma unroll
    for (int o = 1; o < 64; o <<= 1) v += __shfl_xor(v, o);
    return v;
}
DI float sigmoidf_(float x) { return 1.f / (1.f + __expf(-x)); }
template <int CTRL> DI float dpp_f(float v) { return __builtin_bit_cast(float, __builtin_amdgcn_mov_dpp(__builtin_bit_cast(int, v), CTRL, 0xf, 0xf, true)); }
DI float qx1(float v) { return dpp_f<0xB1>(v); }
DI float qx2(float v) { return dpp_f<0x4E>(v); }
template <int P> DI float qbc(float v) { return dpp_f<P * 85>(v); }

#define XB_TMO      128
#define XB_XCNT(j)  (256  + 64 * (j))
#define XB_XSUB(j)  (1280 + 64 * (j))
#define XB_XGEN(j)  (2304 + 64 * (j))
#define XB_TOP      3328
#define XB_TOPGEN   3392
#define XCD_BAR_WORDS 3456
#define XB_SPIN_CAP (1u << 18)
DI unsigned xb_ld(unsigned* p)              { return __hip_atomic_load(p, __ATOMIC_RELAXED, __HIP_MEMORY_SCOPE_AGENT); }
DI unsigned xb_add(unsigned* p, unsigned v) { return __hip_atomic_fetch_add(p, v, __ATOMIC_RELAXED, __HIP_MEMORY_SCOPE_AGENT); }
DI unsigned xb_xcc_id() { return (unsigned)__builtin_amdgcn_s_getreg((3 << 11) | 20) & 0xFu; }
#define XB_SPIN(cond, bar) do { unsigned _sp = 0; while (cond) { __builtin_amdgcn_s_sleep(1); \
    if ((++_sp & 255u) == 0u) { if (xb_ld(&(bar)[XB_TMO])) break; if (_sp > XB_SPIN_CAP) { atomicAdd(&(bar)[XB_TMO], 1u); break; } } } } while (0)
struct XcdBarrier { unsigned* bar; unsigned x; volatile LAS unsigned* st; };
DI XcdBarrier xcd_barrier_post(unsigned* bar, volatile LAS unsigned* st, bool t0) {
    XcdBarrier b; b.bar = bar; b.x = xb_xcc_id(); b.st = st;
    if (t0) (void)xb_add(&bar[XB_XCNT(b.x)], 1u);
    return b;
}
DI void xcd_barrier_complete(unsigned* bar, unsigned x, unsigned& nloc, unsigned& nx) {
    const unsigned G = gridDim.x * gridDim.y * gridDim.z;
    unsigned sum, cnt, mine, sp = 0u;
    for (;;) {
        sum = 0u; cnt = 0u; mine = 0u;
#pragma unroll
        for (unsigned j = 0; j < 16; ++j) { const unsigned c = xb_ld(&bar[XB_XCNT(j)]); sum += c; cnt += (c > 0u) ? 1u : 0u; mine = (j == x) ? c : mine; }
        if (sum == G) break;
        __builtin_amdgcn_s_sleep(1);
        if ((++sp & 255u) == 0u) { if (xb_ld(&bar[XB_TMO])) break; if (sp > XB_SPIN_CAP) { atomicAdd(&bar[XB_TMO], 1u); break; } }
    }
    nloc = mine > 0u ? mine : 1u; nx = cnt > 0u ? cnt : 1u;
}
DI void xcd_barrier(const XcdBarrier& b, bool t0) {
    asm volatile("s_waitcnt vmcnt(0)" ::: "memory");
    __syncthreads();
    if (t0) {
        unsigned* bar = b.bar;
        __builtin_amdgcn_s_waitcnt(0);
        unsigned nloc = b.st[0], nx = b.st[1];
        if (nloc == 0u) { xcd_barrier_complete(bar, b.x, nloc, nx); b.st[0] = nloc; b.st[1] = nx; }
        const unsigned old = xb_add(&bar[XB_XSUB(b.x)], 1u);
        const unsigned gen = old / nloc;
        if (old + 1u == (gen + 1u) * nloc) {
            __builtin_amdgcn_fence(__ATOMIC_RELEASE, "agent");
            asm volatile("s_waitcnt vmcnt(0)" ::: "memory");
            const unsigned og = xb_add(&bar[XB_TOP], 1u);
            const unsigned tg = og / nx;
            if (og + 1u == (tg + 1u) * nx) xb_add(&bar[XB_TOPGEN], 1u);
            else XB_SPIN(xb_ld(&bar[XB_TOPGEN]) == tg, bar);
            __builtin_amdgcn_fence(__ATOMIC_ACQUIRE, "agent");
            xb_add(&bar[XB_XGEN(b.x)], 1u);
            asm volatile("s_waitcnt vmcnt(0)" ::: "memory");
        } else {
            XB_SPIN(xb_ld(&bar[XB_XGEN(b.x)]) == gen, bar);
            __builtin_amdgcn_fence(__ATOMIC_ACQUIRE, "agent");
            asm volatile("s_waitcnt vmcnt(0)" ::: "memory");
        }
    }
    __syncthreads();
}

namespace pg8 {
struct EpiBf16 {
    static constexpr bool PERM = true;
    bf16_t* O; int ldc; const PG8_LAS float* rs;
    __device__ __forceinline__ void operator()(const f32x4 (&acc)[2][2][4][2], const Unit& u, int wr, int wc, int fr, int fq, int ui) const {
        const int row0 = u.pm * BM + wr * 64 + fr, col0 = u.pn * BM + wc * 32 + 8 * fq;
#pragma unroll
        for (int ai = 0; ai < 2; ++ai)
#pragma unroll
            for (int m = 0; m < 4; ++m) { bf16_t* rowp = O + (size_t)(row0 + ai * HALF + m * 16) * ldc + col0; const float sc = rs ? rs[ui * 256 + ai * HALF + wr * 64 + m * 16 + fr] : 1.0f;
#pragma unroll
                for (int bj = 0; bj < 2; ++bj) { const f32x4 v0 = acc[ai][bj][m][0] * sc, v1 = acc[ai][bj][m][1] * sc;
                    u32x4 w; w.x = cvt_pk_bf16(v0[0], v0[1]); w.y = cvt_pk_bf16(v0[2], v0[3]); w.z = cvt_pk_bf16(v1[0], v1[1]); w.w = cvt_pk_bf16(v1[2], v1[3]);
                    *(u32x4*)(rowp + bj * HALF) = w; } }
    }
};
__device__ __forceinline__ float silu_mul(float g, float u) { return g * __builtin_amdgcn_rcpf(1.f + __expf(-g)) * u; }
struct EpiSwiGLU {
    static constexpr bool PERM = true;
    bf16_t* O; int ldc; const PG8_LAS float* rs;
    __device__ __forceinline__ void operator()(const f32x4 (&acc)[2][2][4][2], const Unit& u, int wr, int wc, int fr, int fq, int ui) const {
        const int row0 = u.pm * BM + wr * 64 + fr, col0 = u.pn * HALF + wc * 32 + 8 * fq;
#pragma unroll
        for (int ai = 0; ai < 2; ++ai)
#pragma unroll
            for (int m = 0; m < 4; ++m) { bf16_t* rowp = O + (size_t)(row0 + ai * HALF + m * 16) * ldc + col0;
                const float sc = rs ? rs[ui * 256 + ai * HALF + wr * 64 + m * 16 + fr] : 1.0f;
                const f32x4 g0 = acc[ai][0][m][0] * sc, g1 = acc[ai][0][m][1] * sc, u0 = acc[ai][1][m][0] * sc, u1 = acc[ai][1][m][1] * sc;
                u32x4 w; w.x = cvt_pk_bf16(silu_mul(g0[0], u0[0]), silu_mul(g0[1], u0[1])); w.y = cvt_pk_bf16(silu_mul(g0[2], u0[2]), silu_mul(g0[3], u0[3]));
                w.z = cvt_pk_bf16(silu_mul(g1[0], u1[0]), silu_mul(g1[1], u1[1])); w.w = cvt_pk_bf16(silu_mul(g1[2], u1[2]), silu_mul(g1[3], u1[3]));
                *(u32x4*)rowp = w; }
    }
};
__device__ __forceinline__ float clamp_fp8(float x) { return __builtin_amdgcn_fmed3f(x, -448.0f, 448.0f); }
__device__ __forceinline__ unsigned pk4_fp8(float a, float b, float c, float d) { a = clamp_fp8(a); b = clamp_fp8(b); c = clamp_fp8(c); d = clamp_fp8(d); int w = 0; w = __builtin_amdgcn_cvt_pk_fp8_f32(a, b, w, false); w = __builtin_amdgcn_cvt_pk_fp8_f32(c, d, w, true); return (unsigned)w; }
struct EpiSwiGLU8 {
    static constexpr bool PERM = true;
    unsigned char* O; int ldc; float gs, os;
    __device__ __forceinline__ void operator()(const f32x4 (&acc)[2][2][4][2], const Unit& u, int wr, int wc, int fr, int fq, int ui) const {
        const int row0 = u.pm * BM + wr * 64 + fr, col0 = u.pn * HALF + wc * 32 + 8 * fq;
#pragma unroll
        for (int ai = 0; ai < 2; ++ai)
#pragma unroll
            for (int m = 0; m < 4; ++m) { unsigned char* rowp = O + (size_t)(row0 + ai * HALF + m * 16) * ldc + col0;
                const f32x4 g0 = acc[ai][0][m][0] * gs, g1 = acc[ai][0][m][1] * gs, u0 = acc[ai][1][m][0] * (gs * os), u1 = acc[ai][1][m][1] * (gs * os);
                typedef unsigned u32x2 __attribute__((ext_vector_type(2))); u32x2 w;
                w.x = pk4_fp8(silu_mul(g0[0], u0[0]), silu_mul(g0[1], u0[1]), silu_mul(g0[2], u0[2]), silu_mul(g0[3], u0[3]));
                w.y = pk4_fp8(silu_mul(g1[0], u1[0]), silu_mul(g1[1], u1[1]), silu_mul(g1[2], u1[2]), silu_mul(g1[3], u1[3]));
                *(u32x2*)rowp = w; }
    }
};
struct EpiResF32 {
    static constexpr bool PERM = false;
    const float* res; float* out; int ldc; float sc; bf16_t* xr; const float* gain; float* ssq; bool ntres;
    __device__ __forceinline__ void operator()(const f32x4 (&acc)[2][2][4][2], const Unit& u, int wr, int wc, int fr, int fq, int ui) const {
        const int row0 = u.pm * BM + wr * 64 + fr, col0 = u.pn * BM + wc * 32 + 4 * fq;
        f32x4 gv[2][2];
        if (xr) {
#pragma unroll
            for (int bj = 0; bj < 2; ++bj)
#pragma unroll
                for (int n = 0; n < 2; ++n) gv[bj][n] = *(const f32x4*)(gain + col0 + bj * HALF + n * 16); }
#pragma unroll
        for (int ai = 0; ai < 2; ++ai) {
            f32x4 r[4][2][2];
#pragma unroll
            for (int m = 0; m < 4; ++m) { const size_t off = (size_t)(row0 + ai * HALF + m * 16) * ldc + col0;
#pragma unroll
                for (int bj = 0; bj < 2; ++bj)
#pragma unroll
                    for (int n = 0; n < 2; ++n) r[m][bj][n] = ntres ? __builtin_nontemporal_load((const f32x4*)(res + off + bj * HALF + n * 16)) : *(const f32x4*)(res + off + bj * HALF + n * 16); }
#pragma unroll
            for (int m = 0; m < 4; ++m) { const int row = row0 + ai * HALF + m * 16; const size_t off = (size_t)row * ldc + col0; float s = 0.f;
#pragma unroll
                for (int bj = 0; bj < 2; ++bj)
#pragma unroll
                    for (int n = 0; n < 2; ++n) { const f32x4 o = r[m][bj][n] + acc[ai][bj][m][n] * sc; *(f32x4*)(out + off + bj * HALF + n * 16) = o;
                        if (xr) { s += (o[0] * o[0] + o[1] * o[1]) + (o[2] * o[2] + o[3] * o[3]); const f32x4 y = o * gv[bj][n];
                            unsigned w0 = cvt_pk_bf16(y[0], y[1]), w1 = cvt_pk_bf16(y[2], y[3]); typedef unsigned u32x2 __attribute__((ext_vector_type(2))); *(u32x2*)(xr + off + bj * HALF + n * 16) = (u32x2){w0, w1}; } }
                if (xr) { s += __shfl_xor(s, 16); s += __shfl_xor(s, 32); if (fq == 0) ssq[(size_t)row * 16 + u.pn * 4 + wc] = s; } }
        }
    }
};
#ifndef MDN_ROWS
#define MDN_ROWS 4
#endif
struct EpiMoeDown {
    static constexpr bool PERM = false;
    float* out; int ldc; const int* tok; const float* gate; float sc;
    __device__ __forceinline__ void operator()(const f32x4 (&acc)[2][2][4][2], const Unit& u, int wr, int wc, int fr, int fq, int ui) const {
        const int col0 = u.pn * BM + wc * 32 + 4 * fq;
        int tk[2][4]; float gt[2][4];
#pragma unroll
        for (int ai = 0; ai < 2; ++ai)
#pragma unroll
            for (int m = 0; m < 4; ++m) { const int slot = u.r0 + ai * HALF + wr * 64 + m * 16 + fr, sl = slot < 32767 ? slot : 32767;
                tk[ai][m] = tok[u.e * 32768 + sl]; gt[ai][m] = gate[u.e * 32768 + sl]; }
#pragma unroll
        for (int ai = 0; ai < 2; ++ai)
#pragma unroll
            for (int m = 0; m < 4; ++m) { const bool ok = (u.r0 + ai * HALF + wr * 64 + m * 16 + fr) < u.cn; tk[ai][m] = ok ? tk[ai][m] : -1; gt[ai][m] = ok ? gt[ai][m] * sc : 0.f; }
#pragma unroll
        for (int ai = 0; ai < 2; ++ai)
#pragma unroll
            for (int mh = 0; mh < 4 / MDN_ROWS; ++mh) {
                f32x4 r[MDN_ROWS][2][2];
#pragma unroll
                for (int mm = 0; mm < MDN_ROWS; ++mm) { const int m = MDN_ROWS * mh + mm; const float* rowp = out + (size_t)(tk[ai][m] < 0 ? 0 : tk[ai][m]) * ldc + col0;
#pragma unroll
                    for (int bj = 0; bj < 2; ++bj)
#pragma unroll
                        for (int n = 0; n < 2; ++n) r[mm][bj][n] = *(const f32x4*)(rowp + bj * HALF + n * 16); }
#pragma unroll
                for (int mm = 0; mm < MDN_ROWS; ++mm) { const int m = MDN_ROWS * mh + mm; if (tk[ai][m] >= 0) { float* rowp = out + (size_t)tk[ai][m] * ldc + col0;
#pragma unroll
                    for (int bj = 0; bj < 2; ++bj)
#pragma unroll
                        for (int n = 0; n < 2; ++n) *(f32x4*)(rowp + bj * HALF + n * 16) = r[mm][bj][n] + acc[ai][bj][m][n] * gt[ai][m]; } }
            }
    }
};
struct EpiMoeDownA {
    static constexpr bool PERM = false;
    float* out; int ldc; const int* tok; const float* gate; float sc;
    __device__ __forceinline__ void operator()(const f32x4 (&acc)[2][2][4][2], const Unit& u, int wr, int wc, int fr, int fq, int ui) const {
        const int col0 = u.pn * BM + wc * 32 + 4 * fq;
        int tk[2][4]; float gt[2][4];
#pragma unroll
        for (int ai = 0; ai < 2; ++ai)
#pragma unroll
            for (int m = 0; m < 4; ++m) { const int slot = u.r0 + ai * HALF + wr * 64 + m * 16 + fr, sl = slot < 32767 ? slot : 32767;
                tk[ai][m] = tok[u.e * 32768 + sl]; gt[ai][m] = gate[u.e * 32768 + sl]; }
#pragma unroll
        for (int ai = 0; ai < 2; ++ai)
#pragma unroll
            for (int m = 0; m < 4; ++m) { const bool ok = (u.r0 + ai * HALF + wr * 64 + m * 16 + fr) < u.cn;
                if (ok) { typedef __attribute__((address_space(1))) float gfloat; gfloat* rowp = (gfloat*)(out + (size_t)tk[ai][m] * ldc + col0); const float g_ = gt[ai][m] * sc;
#pragma unroll
                    for (int bj = 0; bj < 2; ++bj)
#pragma unroll
                        for (int n = 0; n < 2; ++n)
#pragma unroll
                            for (int j = 0; j < 4; ++j) __builtin_amdgcn_global_atomic_fadd_f32(rowp + bj * HALF + n * 16 + j, acc[ai][bj][m][n][j] * g_); } }
    }
};
#define MO_T(c) (((c) + 255) >> 8)
struct MoeOrder : StaticOrder {
    int c0, c1, c2, c3, c4, c5, c6, c7; const int* tok; int nNl; const PG8_LAS int* ltab;
    __device__ __forceinline__ void init_moe(const unsigned* cnt, const int* tok_, int N, int G_, int c_, int tile_cap = 1 << 20) {
        tok = tok_; ltab = nullptr;
#define MO_LD(e) (int)__hip_atomic_load(cnt + e, __ATOMIC_RELAXED, __HIP_MEMORY_SCOPE_AGENT)
        c0 = MO_LD(0); c1 = MO_LD(1); c2 = MO_LD(2); c3 = MO_LD(3); c4 = MO_LD(4); c5 = MO_LD(5); c6 = MO_LD(6); c7 = MO_LD(7);
#undef MO_LD
        nNl = N / BM; const int nt_ = tiles(); init((nt_ < tile_cap ? nt_ : tile_cap) * BM, N, G_, c_);
    }
    __device__ __forceinline__ void decode(Unit& u) const {
        int e = 0, tb = 0, c = c0, acc = MO_T(c0);
#define MO_STEP(k, ck) if (u.pm >= acc) { e = k; tb = acc; c = ck; } acc += MO_T(ck);
        MO_STEP(1, c1) MO_STEP(2, c2) MO_STEP(3, c3) MO_STEP(4, c4) MO_STEP(5, c5) MO_STEP(6, c6) MO_STEP(7, c7)
#undef MO_STEP
        u.e = e; u.r0 = (u.pm - tb) * BM; u.cn = c; u.pb = e * nNl + u.pn;
    }
    __device__ __forceinline__ int tiles() const { return MO_T(c0) + MO_T(c1) + MO_T(c2) + MO_T(c3) + MO_T(c4) + MO_T(c5) + MO_T(c6) + MO_T(c7); }
    __device__ __forceinline__ bool next(int i, Unit& u) const {
        if (!StaticOrder::next(i, u)) return false;
        decode(u); u.aux = i; return true;
    }
    __device__ __forceinline__ int arow(const Unit& u, int R) const { if (ltab) return ltab[u.aux * 256 + R]; const int slot = u.r0 + R; return slot < u.cn ? tok[u.e * 32768 + slot] : 0; }
    __device__ __forceinline__ void build_ltab(PG8_LAS int* tab, int tid) { Unit u; for (int i = 0; next(i, u); ++i) if (tid < 256) { const int slot = u.r0 + tid; tab[i * 256 + tid] = slot < u.cn ? tok[u.e * 32768 + slot] : 0; }
        __syncthreads(); ltab = tab; }
};
#undef MO_T
struct MoeTailOrder {
    const MoeOrder* mo; int G, c, ntail, KS, kslice;
    __device__ __forceinline__ void init(const MoeOrder* mo_, int G_, int c_, int KS_, int kslice_, int max_tail) { mo = mo_; G = G_; c = c_; KS = KS_; kslice = kslice_; const int t = (mo_->tiles() - 128) * mo_->nNl; ntail = t < 0 ? 0 : (t > max_tail ? max_tail : t); }
    __device__ __forceinline__ bool next(int i, Unit& u) const {
        const int s = i * G + c; if (s >= ntail * KS) return false;
        const int t = s / KS, ks = s - t * KS; u.pm = 128 + t / mo->nNl; u.pn = t % mo->nNl; mo->decode(u); u.koff = ks * kslice; u.aux = s; return true;
    }
    __device__ __forceinline__ void a_ready(const Unit&) const {}
    __device__ __forceinline__ void done(const Unit&) const {}
    __device__ __forceinline__ int arow(const Unit&, int) const { return 0; }
};
struct EpiPart {
    static constexpr bool PERM = false;
    float* part;
    __device__ __forceinline__ void operator()(const f32x4 (&acc)[2][2][4][2], const Unit& u, int wr, int wc, int fr, int fq, int ui) const {
        float* base = part + (size_t)u.aux * 65536 + (size_t)(wr * 64 + fr) * 256 + wc * 32 + 4 * fq;
#pragma unroll
        for (int ai = 0; ai < 2; ++ai)
#pragma unroll
            for (int m = 0; m < 4; ++m)
#pragma unroll
                for (int bj = 0; bj < 2; ++bj)
#pragma unroll
                    for (int n = 0; n < 2; ++n) *(f32x4*)(base + (size_t)(ai * HALF + m * 16) * 256 + bj * HALF + n * 16) = acc[ai][bj][m][n];
    }
};
}
#include <cmath>
struct Args { const float* in[25]; float* out; unsigned char* ws; int ph_lo, ph_hi; };
struct KArgs {
    typedef const __attribute__((address_space(4))) char* kptr;
    DI kptr base() const { kptr p = (kptr)__builtin_amdgcn_kernarg_segment_ptr(); asm volatile("" : "+s"(p)); return p; }
    DI const float* in(int i) const { return *(const float* const __attribute__((address_space(4)))*)(base() + 8 * i); }
    DI float* out() const { return *(float* const __attribute__((address_space(4)))*)(base() + 200); }
    DI unsigned char* ws() const { return *(unsigned char* const __attribute__((address_space(4)))*)(base() + 208) + ((size_t)(*(const unsigned __attribute__((address_space(4)))*)(base() + 216) >> 8) << 20); }
    DI int ph_lo() const { return (*(const int __attribute__((address_space(4)))*)(base() + 216)) & 255; }
    DI int ph_hi() const { return *(const int __attribute__((address_space(4)))*)(base() + 220); }
};
static_assert(sizeof(Args) == 224, "Args layout");
enum { I_X = 0, I_N1G, I_WIN, I_QNG, I_KNG, I_GNG, I_ARE, I_AIM, I_BRE, I_BIM, I_CRE, I_CIM, I_SD, I_LDT, I_GLW, I_GLB, I_WOUT, I_N2G, I_FG, I_FU, I_FD, I_RT, I_MG, I_MU, I_MD };

DI void transpose_item(const float* W, int ldw, bf16* WT, int ldo, int k0, int n0, int drow0, float* scr, int lane) {
    float v[32];
    const float* src = W + (size_t)(k0 + (lane >> 5)) * ldw + n0 + (lane & 31);
#pragma unroll
    for (int i = 0; i < 32; ++i) v[i] = __builtin_nontemporal_load(src + (size_t)(2 * i) * ldw);
#pragma unroll
    for (int i = 0; i < 32; ++i) scr[(2 * i + (lane >> 5)) * 33 + (lane & 31)] = v[i];
    LDS_WAIT(); asm volatile("" ::: "memory");
    const int c = lane & 7;
#pragma unroll
    for (int j = 0; j < 4; ++j) { const int n = (lane >> 3) + 8 * j; const float* s = scr + (8 * c) * 33 + n;
        v4u o; o.x = pk2(s[0 * 33], s[1 * 33]); o.y = pk2(s[2 * 33], s[3 * 33]); o.z = pk2(s[4 * 33], s[5 * 33]); o.w = pk2(s[6 * 33], s[7 * 33]);
        *(v4u*)(WT + (size_t)(drow0 + n) * ldo + k0 + 8 * c) = o; }
    LDS_WAIT(); asm volatile("" ::: "memory");
}
DI void rms_row(const float* xrow, const float* g, bf16* orow, int lane, f32x4 (&v)[4]) {
    const f32x4* xr = (const f32x4*)xrow + lane; float s = 0.f;
#pragma unroll
    for (int j = 0; j < 4; ++j) { v[j] = xr[64 * j]; s += (v[j].x * v[j].x + v[j].y * v[j].y) + (v[j].z * v[j].z + v[j].w * v[j].w); }
    const float rs = rsqrtf(wave_sum(s) * (1.f / DM) + 1e-6f);
    v2u* o8 = (v2u*)orow + lane;
#pragma unroll
    for (int j = 0; j < 4; ++j) { const f32x4 gg = ((const f32x4*)g)[lane + 64 * j]; v[j] = v[j] * rs * gg; v2u w; w.x = pk2(v[j].x, v[j].y); w.y = pk2(v[j].z, v[j].w); o8[64 * j] = w; }
}
DI void transpose_item8(const float* W, int ldw, unsigned char* WT, int ldo, int k0, int n0, int drow0, float scale, float* scr, int lane) {
    float v[32];
    const float* src = W + (size_t)(k0 + (lane >> 5)) * ldw + n0 + (lane & 31);
#pragma unroll
    for (int i = 0; i < 32; ++i) v[i] = __builtin_nontemporal_load(src + (size_t)(2 * i) * ldw);
#pragma unroll
    for (int i = 0; i < 32; ++i) scr[(2 * i + (lane >> 5)) * 33 + (lane & 31)] = v[i] * scale;
    LDS_WAIT(); asm volatile("" ::: "memory");
    const int n = lane >> 1, hf = lane & 1; const float* s = scr + (32 * hf) * 33 + n;
    v4u o0, o1;
    o0.x = pg8::pk4_fp8(s[0 * 33], s[1 * 33], s[2 * 33], s[3 * 33]); o0.y = pg8::pk4_fp8(s[4 * 33], s[5 * 33], s[6 * 33], s[7 * 33]); o0.z = pg8::pk4_fp8(s[8 * 33], s[9 * 33], s[10 * 33], s[11 * 33]); o0.w = pg8::pk4_fp8(s[12 * 33], s[13 * 33], s[14 * 33], s[15 * 33]);
    o1.x = pg8::pk4_fp8(s[16 * 33], s[17 * 33], s[18 * 33], s[19 * 33]); o1.y = pg8::pk4_fp8(s[20 * 33], s[21 * 33], s[22 * 33], s[23 * 33]); o1.z = pg8::pk4_fp8(s[24 * 33], s[25 * 33], s[26 * 33], s[27 * 33]); o1.w = pg8::pk4_fp8(s[28 * 33], s[29 * 33], s[30 * 33], s[31 * 33]);
    unsigned char* dp = WT + (size_t)(drow0 + n) * ldo + k0 + 32 * hf;
    *(v4u*)dp = o0; *(v4u*)(dp + 16) = o1;
    LDS_WAIT(); asm volatile("" ::: "memory");
}
struct T8Item { const float* W; unsigned char* WT; int ldw, ldo, k0, n0, drow0; float scale; };
DI void t8_load(float (&v)[32], const T8Item& d, int lane) {
    const float* src = d.W + (size_t)(d.k0 + (lane >> 5)) * d.ldw + d.n0 + (lane & 31);
#pragma unroll
    for (int i = 0; i < 32; ++i) v[i] = __builtin_nontemporal_load(src + (size_t)(2 * i) * d.ldw);
}
DI void t8_store(const float (&v)[32], const T8Item& d, float* scr, int lane) {
#pragma unroll
    for (int i = 0; i < 32; ++i) scr[(2 * i + (lane >> 5)) * 33 + (lane & 31)] = v[i] * d.scale;
    LDS_WAIT(); asm volatile("" ::: "memory");
    const int n = lane >> 1, hf = lane & 1; const float* s = scr + (32 * hf) * 33 + n;
    v4u o0, o1;
    o0.x = pg8::pk4_fp8(s[0 * 33], s[1 * 33], s[2 * 33], s[3 * 33]); o0.y = pg8::pk4_fp8(s[4 * 33], s[5 * 33], s[6 * 33], s[7 * 33]); o0.z = pg8::pk4_fp8(s[8 * 33], s[9 * 33], s[10 * 33], s[11 * 33]); o0.w = pg8::pk4_fp8(s[12 * 33], s[13 * 33], s[14 * 33], s[15 * 33]);
    o1.x = pg8::pk4_fp8(s[16 * 33], s[17 * 33], s[18 * 33], s[19 * 33]); o1.y = pg8::pk4_fp8(s[20 * 33], s[21 * 33], s[22 * 33], s[23 * 33]); o1.z = pg8::pk4_fp8(s[24 * 33], s[25 * 33], s[26 * 33], s[27 * 33]); o1.w = pg8::pk4_fp8(s[28 * 33], s[29 * 33], s[30 * 33], s[31 * 33]);
    unsigned char* dp = d.WT + (size_t)(d.drow0 + n) * d.ldo + d.k0 + 32 * hf;
    *(v4u*)dp = o0; *(v4u*)(dp + 16) = o1;
    LDS_WAIT(); asm volatile("" ::: "memory");
}
DI void rms_rows_phase(const float* x, const float* g, bf16* out, int gw, int NGW, int lane) {
    f32x4 gg[4];
#pragma unroll
    for (int j = 0; j < 4; ++j) gg[j] = ((const f32x4*)g)[lane + 64 * j];
    for (int m0 = gw; m0 < T; m0 += 4 * NGW) {
        f32x4 v[4][4];
#pragma unroll
        for (int r = 0; r < 4; ++r) { const int m = m0 + r * NGW; if (m < T) {
#pragma unroll
            for (int j = 0; j < 4; ++j) v[r][j] = __builtin_nontemporal_load((const f32x4*)(x + (size_t)m * DM) + lane + 64 * j); } }
#pragma unroll
        for (int r = 0; r < 4; ++r) { const int m = m0 + r * NGW; if (m < T) { float s = 0.f;
#pragma unroll
            for (int j = 0; j < 4; ++j) s += (v[r][j].x * v[r][j].x + v[r][j].y * v[r][j].y) + (v[r][j].z * v[r][j].z + v[r][j].w * v[r][j].w);
            const float rs = rsqrtf(wave_sum(s) * (1.f / DM) + 1e-6f); v2u* o8 = (v2u*)(out + (size_t)m * DM) + lane;
#pragma unroll
            for (int j = 0; j < 4; ++j) { const f32x4 y = v[r][j] * rs * gg[j]; v2u w; w.x = pk2(y.x, y.y); w.y = pk2(y.z, y.w); o8[64 * j] = w; } } }
    }
}
DI void unpack8(const v4u w, float (&x)[8]) { x[0] = bflo(w.x); x[1] = bfhi(w.x); x[2] = bflo(w.y); x[3] = bfhi(w.y); x[4] = bflo(w.z); x[5] = bfhi(w.z); x[6] = bflo(w.w); x[7] = bfhi(w.w); }
DI v4u pack8(const float (&x)[8]) { v4u w; w.x = pk2(x[0], x[1]); w.y = pk2(x[2], x[3]); w.z = pk2(x[4], x[5]); w.w = pk2(x[6], x[7]); return w; }

template <class Sched> DI void build_rs(LAS float* RS, const Sched& S, const float* ssq, int tid) {
    pg8::Unit u;
    for (int i = 0; S.next(i, u); ++i) if (tid < 256) { const f32x4* p = (const f32x4*)(ssq + ((size_t)u.pm * 256 + tid) * 16); const f32x4 a0 = p[0], a1 = p[1], a2 = p[2], a3 = p[3];
        const float s = ((a0.x + a0.y) + (a0.z + a0.w)) + ((a1.x + a1.y) + (a1.z + a1.w)) + ((a2.x + a2.y) + (a2.z + a2.w)) + ((a3.x + a3.y) + (a3.z + a3.w));
        RS[i * 256 + tid] = rsqrtf(s * (1.f / DM) + 1e-6f); }
    __syncthreads();
}
#ifndef LATE_CONV
#define LATE_CONV 1
#endif
template <bool LATE> DI void conv_weights(const KArgs& a, char* lds, int gw, int NGW, int wave, int lane) {
    unsigned char* ws = a.ws();
    float* scr = (float*)(lds + wave * 16384);
    constexpr int I_IN = 16 * 80, I_OUT = 16 * 32, I_G = 16 * 88, I_D = 44 * 32;
    constexpr int NIT = LATE ? (I_IN + I_OUT + 2 * I_G + I_D) : (I_IN + I_OUT);
    for (int it = gw; it < NIT; it += NGW) {
        int r = it; const int l = LATE ? 1 : 0;
        if (r < I_IN) { const int kb = r / 80, nb = r % 80;
            transpose_item(a.in(I_WIN) + (size_t)l * DM * NPROJ, NPROJ, (bf16*)(ws + WS_WIN) + (size_t)l * NPROJ * DM, DM, 64 * kb, 32 * nb, 32 * nb, scr, lane); continue; }
        r -= I_IN;
        if (r < I_OUT) { const int kb = r / 32, nb = r % 32;
            transpose_item(a.in(I_WOUT) + (size_t)l * DM * DM, DM, (bf16*)(ws + WS_WOUT) + (size_t)l * DM * DM, DM, 64 * kb, 32 * nb, 32 * nb, scr, lane); continue; }
        r -= I_OUT;
        if (r < 2 * I_G) { const int up = r / I_G; r -= up * I_G; const int kb = r / 88, nb = r % 88, n0 = 32 * nb;
            transpose_item(a.in(up ? I_FU : I_FG), DFF, (bf16*)(ws + WS_FGU), DM, 64 * kb, n0, (n0 >> 7) * 256 + (n0 & 127) + up * 128, scr, lane); continue; }
        r -= 2 * I_G;
        { const int kb = r / 32, nb = r % 32; transpose_item(a.in(I_FD), DM, (bf16*)(ws + WS_FDN), DFF, 64 * kb, 32 * nb, 32 * nb, scr, lane); }
    }
}
DI void phase_prologue(const KArgs& a, char* lds, int gw, int NGW, int wave, int lane) {
    unsigned char* ws = a.ws();
    conv_weights<false>(a, lds, gw, NGW, wave, lane);
    if (!LATE_CONV) conv_weights<true>(a, lds, gw, NGW, wave, lane);
    const int pgrp_ = ((gw / NWAVES) >> 3) & 1;
#pragma unroll 1
    for (int ps_ = 0; ps_ < 2; ++ps_) { if ((ps_ == 0) == (pgrp_ == 0)) {
    const int gt = gw * 64 + lane, NGT = NGW * 64;
    float* tabA = (float*)(ws + WS_TABA); float* tabR = (float*)(ws + WS_TABR);
    for (int i = gt; i < SEQ * 8; i += NGT) { const int pos = i >> 3, k = i & 7; const float inv = powf(500000.0f, -(float)k * 2.0f / 16.0f); const double ang = (double)((float)pos * inv);
        tabA[2 * i] = (float)cos(ang); tabA[2 * i + 1] = (float)sin(ang); }
    for (int i = gt; i < SEQ * 32; i += NGT) { const int pos = i >> 5, k = i & 31; const float inv = powf(10000.0f, -(float)k * 2.0f / 64.0f); const double ang = (double)((float)pos * inv);
        tabR[2 * i] = (float)cos(ang); tabR[2 * i + 1] = (float)sin(ang); }
    for (int i = gt; i < DEPTH * 16 * 64; i += NGT) { const int l = i >> 10, gp = i & 1023, gI = gp >> 6;
        float* base = (float*)(ws + WS_SSM + (size_t)l * SSM_LAYER_BYTES);
        const float dt = expf(a.in(I_LDT)[l * 16 + gI]), lr = a.in(I_ARE)[i], li = a.in(I_AIM)[i];
        const float mag = expf(lr * dt), ang = li * dt; const float ar = mag * cosf(ang), ai = mag * sinf(ang);
        const float den = lr * lr + li * li, nr = ar - 1.0f, ni = ai; const float fre = (nr * lr + ni * li) / den, fim = (ni * lr - nr * li) / den;
        bf16* bmt = (bf16*)((char*)base + SSM_BMT) + ((size_t)gI * 128 + (gp & 63)) * 16;
        for (int c = 0; c < 16; ++c) { const float br = a.in(I_BRE)[(size_t)i * 16 + c], bi = a.in(I_BIM)[(size_t)i * 16 + c]; bmt[c] = (bf16)f2bf(fre * br - fim * bi); bmt[64 * 16 + c] = (bf16)f2bf(fre * bi + fim * br); }
        bf16* cmt = (bf16*)((char*)base + SSM_CMT) + (size_t)gI * 16 * 128 + 2 * (gp & 63);
        for (int c = 0; c < 16; ++c) { cmt[c * 128] = (bf16)f2bf(a.in(I_CRE)[((size_t)(l * 16 + gI) * 16 + c) * 64 + (gp & 63)]); cmt[c * 128 + 1] = (bf16)f2bf(-a.in(I_CIM)[((size_t)(l * 16 + gI) * 16 + c) * 64 + (gp & 63)]); }
        base[SSM_ABAR / 4 + 2 * gp] = ar; base[SSM_ABAR / 4 + 2 * gp + 1] = ai;
        float pr = ar, pi = ai;
        for (int k = 0; k < 7; ++k) { const float t0 = pr * pr - pi * pi, t1 = 2.0f * pr * pi; pr = t0; pi = t1; }
        base[SSM_ABARL / 4 + 2 * gp] = pr; base[SSM_ABARL / 4 + 2 * gp + 1] = pi; }
    for (int i = gt; i < DEPTH * 65536; i += NGT) { const int l = i >> 16, n = (i >> 8) & 255, k = i & 255;
        ((bf16*)(ws + WS_SSM + (size_t)l * SSM_LAYER_BYTES + SSM_GLWT))[n * 256 + k] = (bf16)f2bf(a.in(I_GLW)[(size_t)l * 65536 + k * 256 + n]); }
    } else {
    rms_rows_phase(a.in(I_X), a.in(I_N1G), (bf16*)(ws + WS_XN), gw, NGW, lane);
    } }
}

DI void prep_phase(bf16* proj, const float* qg, const float* kg, const float* tabA, int gw, int NGW, int lane) {
    const int vec = lane >> 3, sub = lane & 7;
    const int coff = (vec < 4 ? C_QA + vec * 64 : C_KA + (vec - 4) * 64) + sub * 8;
    float g[8];
    { const f32x4* gp = (const f32x4*)((vec < 4 ? qg : kg) + sub * 8); const f32x4 g0 = gp[0], g1 = gp[1]; g[0] = g0.x; g[1] = g0.y; g[2] = g0.z; g[3] = g0.w; g[4] = g1.x; g[5] = g1.y; g[6] = g1.z; g[7] = g1.w; }
    const float qs = vec < 4 ? 0.125f * 1.4426950408889634f : 1.0f;
    for (int t0 = gw; t0 < T; t0 += 4 * NGW) {
        v4u raw[4]; f32x4 cs[4][4];
#pragma unroll
        for (int r = 0; r < 4; ++r) { const int t = t0 + r * NGW; if (t < T) { raw[r] = *(const v4u*)(proj + (size_t)t * NPROJ + coff); const f32x4* cp = (const f32x4*)(tabA + (size_t)(t & (SEQ - 1)) * 16);
#pragma unroll
            for (int c = 0; c < 4; ++c) cs[r][c] = cp[c]; } }
#pragma unroll
        for (int r = 0; r < 4; ++r) { const int t = t0 + r * NGW; if (t < T) {
            float x[8]; unpack8(raw[r], x);
            float ss = 0.f;
#pragma unroll
            for (int e = 0; e < 8; ++e) ss += x[e] * x[e];
            ss += __shfl_xor(ss, 1); ss += __shfl_xor(ss, 2); ss += __shfl_xor(ss, 4);
            const float rs = rsqrtf(ss * (1.f / 64.f) + 1e-6f);
#pragma unroll
            for (int e = 0; e < 8; ++e) x[e] = x[e] * rs * g[e];
            const float cc[8] = {cs[r][0].x, cs[r][0].z, cs[r][1].x, cs[r][1].z, cs[r][2].x, cs[r][2].z, cs[r][3].x, cs[r][3].z};
            const float sn[8] = {cs[r][0].y, cs[r][0].w, cs[r][1].y, cs[r][1].w, cs[r][2].y, cs[r][2].w, cs[r][3].y, cs[r][3].w};
#pragma unroll
            for (int e = 0; e < 8; ++e) { const float o = __shfl_xor(x[e], 1);
                if (sub == 0) x[e] = x[e] * cc[e] - o * sn[e]; else if (sub == 1) x[e] = x[e] * cc[e] + o * sn[e]; }
#pragma unroll
            for (int e = 0; e < 8; ++e) x[e] *= qs;
            *(v4u*)(proj + (size_t)t * NPROJ + coff) = pack8(x); } }
    }
}
DI void ret_load_rope(float* dst, int ld, const bf16* proj, size_t grow0, int pos0, int col0, float scale, bool zeta, float lg, const float* tabR, int tid) {
    const int row = tid >> 2, qd = tid & 3;
    const bf16* src = proj + (grow0 + row) * NPROJ + col0;
    float own[16], par[16];
    { float t8[8]; unpack8(*(const v4u*)(src + qd * 16), t8);
#pragma unroll
      for (int e = 0; e < 8; ++e) own[e] = t8[e];
      unpack8(*(const v4u*)(src + qd * 16 + 8), t8);
#pragma unroll
      for (int e = 0; e < 8; ++e) own[8 + e] = t8[e];
      unpack8(*(const v4u*)(src + (qd ^ 2) * 16), t8);
#pragma unroll
      for (int e = 0; e < 8; ++e) par[e] = t8[e];
      unpack8(*(const v4u*)(src + (qd ^ 2) * 16 + 8), t8);
#pragma unroll
      for (int e = 0; e < 8; ++e) par[8 + e] = t8[e]; }
    const float* cs = tabR + ((size_t)(pos0 + row) * 32 + (qd & 1) * 16) * 2;
    float sc = scale; if (zeta) sc *= __expf(lg * (float)(127 - row));
    float* d = dst + row * ld + qd * 16;
#pragma unroll
    for (int e = 0; e < 16; ++e) { const float c = cs[2 * e], s = cs[2 * e + 1]; const float r = (qd < 2) ? own[e] * c - par[e] * s : own[e] * c + par[e] * s; d[e] = r * sc; }
}
DI float ret_loggamma(int h) { return log1pf(-exp2f(-5.0f - (float)h)); }

DI void ret_kv_unit(const KArgs& a, char* lds, int unit, int tid) {
    asm volatile("" : "+v"(tid));
    const int n = unit & 127, h = (unit >> 7) & 3, b = unit >> 9;
    float* KS = (float*)lds; float* VS = (float*)(lds + 32768);
    const bf16* proj = (const bf16*)(a.ws() + WS_PROJ); const size_t grow0 = (size_t)b * SEQ + n * 128;
    const float lg = ret_loggamma(h);
    ret_load_rope(KS, 64, proj, grow0, n * 128, C_KR + h * 64, 0.125f, true, lg, (const float*)(a.ws() + WS_TABR), tid);
    { const int row = tid >> 2, q = tid & 3; const bf16* src = proj + (grow0 + row) * NPROJ + C_VR + h * 128 + q * 32; float* d = VS + row * 128 + q * 32;
#pragma unroll
      for (int c = 0; c < 4; ++c) { float t8[8]; unpack8(*(const v4u*)(src + 8 * c), t8);
#pragma unroll
          for (int e = 0; e < 8; ++e) d[8 * c + e] = t8[e]; } }
    __syncthreads();
    const int e = tid & 127, dq = tid >> 7;
    float acc[16];
#pragma unroll
    for (int c = 0; c < 16; ++c) acc[c] = 0.f;
    for (int j = 0; j < 128; ++j) { const float vv = VS[j * 128 + e]; const f32x4* kk = (const f32x4*)(KS + j * 64 + dq * 16);
#pragma unroll
        for (int c = 0; c < 4; ++c) { const f32x4 k4 = kk[c]; acc[4 * c] += vv * k4.x; acc[4 * c + 1] += vv * k4.y; acc[4 * c + 2] += vv * k4.z; acc[4 * c + 3] += vv * k4.w; } }
    float* kv = (float*)(a.ws() + WS_KV) + ((size_t)((b * 4 + h) * 128 + n)) * 8192;
#pragma unroll
    for (int c = 0; c < 16; ++c) kv[(dq * 16 + c) * 128 + e] = acc[c];
    __syncthreads();
}
typedef short bf16x8_t __attribute__((ext_vector_type(8)));
typedef float f32x4_t __attribute__((ext_vector_type(4)));
constexpr int SSM_XLD = 528;
template <bool EMIT> DI void ssm_wave_chunk(const KArgs& a, int layer, int b, int chunk, int g, LAS char* XS  , LAS char* UWb  , LAS char* ZS, int zld  , float& hr, float& hi, int lane) {
    const bf16* proj = (const bf16*)(a.ws() + WS_PROJ); const size_t grow0 = (size_t)b * SEQ + chunk * 128;
    const char* sp = (const char*)(a.ws() + WS_SSM + (size_t)layer * SSM_LAYER_BYTES);
    const int l15 = lane & 15, l4 = lane >> 4;
    const bf16x8_t zero8 = (bf16x8_t){0, 0, 0, 0, 0, 0, 0, 0};
    bf16x8_t bmf[8];
#pragma unroll
    for (int nt = 0; nt < 8; ++nt) bmf[nt] = *(const bf16x8_t*)(sp + SSM_BMT + (((size_t)g * 128 + 16 * nt + l15) * 16 + 8 * (l4 & 1)) * 2);
    bf16x8_t cmf[4]; float dsk = 0.f;
    if (EMIT) {
#pragma unroll
        for (int s = 0; s < 4; ++s) cmf[s] = *(const bf16x8_t*)(sp + SSM_CMT + (((size_t)g * 16 + l15) * 128 + 32 * s + 8 * l4) * 2);
        dsk = a.in(I_SD)[layer * 256 + g * 16 + l15];
    }
    const float ar = ((const float*)(sp + SSM_ABAR))[2 * (g * 64 + lane)], ai = ((const float*)(sp + SSM_ABAR))[2 * (g * 64 + lane) + 1];
    const bf16* usrc = proj + (grow0 + ((lane & 31) >> 1)) * NPROJ + C_US + g * 16 + (lane & 1) * 8;
    v4u unext = *(const v4u*)usrc;
    for (int blk = 0; blk < 8; ++blk) {
        if (lane < 32) *(LAS v4u*)(UWb + lane * 16) = unext;
        unext = *(const v4u*)(usrc + (size_t)(16 * (blk < 7 ? blk + 1 : 7)) * NPROJ);
        LDS_WAIT(); asm volatile("" ::: "memory");
        const bf16x8_t uf = *(const LAS bf16x8_t*)(UWb + l15 * 32 + (l4 & 1) * 16);
        f32x4_t dx[8];
#pragma unroll
        for (int nt = 0; nt < 8; ++nt) dx[nt] = __builtin_amdgcn_mfma_f32_16x16x32_bf16(uf, bmf[nt], (f32x4_t){0.f, 0.f, 0.f, 0.f}, 0, 0, 0);
        asm volatile("" : "+v"(dx[0]), "+v"(dx[1]), "+v"(dx[2]), "+v"(dx[3]), "+v"(dx[4]), "+v"(dx[5]), "+v"(dx[6]), "+v"(dx[7]) : "v"(uf));
#pragma unroll
        for (int nt = 0; nt < 8; ++nt)
#pragma unroll
            for (int r = 0; r < 4; ++r) *(LAS float*)(XS + (4 * l4 + r) * SSM_XLD + (16 * nt + l15) * 4) = 0.5f * dx[nt][r];
        asm volatile("" :: "v"(bmf[0]), "v"(bmf[1]), "v"(bmf[2]), "v"(bmf[3]), "v"(bmf[4]), "v"(bmf[5]), "v"(bmf[6]), "v"(bmf[7]));
        LDS_WAIT(); asm volatile("" ::: "memory");
        float xr_[16], xi_[16];
#pragma unroll
        for (int tt = 0; tt < 16; ++tt) { xr_[tt] = *(const LAS float*)(XS + tt * SSM_XLD + lane * 4); xi_[tt] = *(const LAS float*)(XS + tt * SSM_XLD + 256 + lane * 4); }
        asm volatile("" ::: "memory");
#pragma unroll
        for (int tt = 0; tt < 16; ++tt) { const float xr = xr_[tt], xi = xi_[tt];
            const float nhr = ar * hr - ai * hi + xr, nhi = ar * hi + ai * hr + xi; hr = nhr; hi = nhi;
            if (EMIT) *(LAS unsigned*)(XS + tt * SSM_XLD + lane * 4) = pg8::cvt_pk_bf16(hr, hi); }
        if (EMIT) {
            LDS_WAIT(); asm volatile("" ::: "memory");
            f32x4_t y = (f32x4_t){0.f, 0.f, 0.f, 0.f};
#pragma unroll
            for (int s = 0; s < 4; ++s) { const bf16x8_t hf = *(const LAS bf16x8_t*)(XS + l15 * SSM_XLD + (32 * s + 8 * l4) * 2); y = __builtin_amdgcn_mfma_f32_16x16x32_bf16(hf, cmf[s], y, 0, 0, 0); asm volatile("" : "+v"(y) : "v"(hf), "v"(cmf[s])); }

#pragma unroll
            for (int r = 0; r < 4; ++r) { const int t = 4 * l4 + r; const float uv = bf2f(*(const LAS bf16*)(UWb + t * 32 + l15 * 2)); const float yv = y[r] + dsk * uv;
                const float z = yv * sigmoidf_(1.5957691216057308f * (yv + 0.044715f * yv * yv * yv));
                *(LAS bf16*)(ZS + (16 * blk + t) * zld + (g * 16 + l15) * 2) = (bf16)f2bf(z); }
        }
        LDS_WAIT(); asm volatile("" ::: "memory");
    }
}
DI void attn_unit(const KArgs& a, char* lds, int unit, int tid) {
    asm volatile("" : "+v"(tid));
    const int pat = unit >> 10, rem = unit & 1023, b = rem >> 9, h = (rem >> 7) & 3, rn = rem & 127;
    const int dil = pat == 0 ? 1 : (pat == 1 ? 4 : 16), nbk = 128 / dil;
    const int n = rn % nbk, r = rn / nbk;
    constexpr int LDK = 68;
    float* KS = (float*)lds; float* VS = (float*)(lds + 256 * LDK * 4);
    const bf16* proj = (const bf16*)(a.ws() + WS_PROJ);
    { const int j = tid >> 1, half = tid & 1; const int l = 128 * (n - 1) + j; float* kd = KS + j * LDK + half * 32; float* vd = VS + j * LDK + half * 32;
      if (l >= 0) { const size_t grow = (size_t)b * SEQ + (size_t)l * dil + r; const bf16* ks = proj + grow * NPROJ + C_KA + h * 64 + half * 32; const bf16* vs = proj + grow * NPROJ + C_VA + h * 64 + half * 32;
#pragma unroll
          for (int c = 0; c < 4; ++c) { float t8[8]; unpack8(*(const v4u*)(ks + 8 * c), t8);
#pragma unroll
              for (int e = 0; e < 8; ++e) kd[8 * c + e] = t8[e];
              unpack8(*(const v4u*)(vs + 8 * c), t8);
#pragma unroll
              for (int e = 0; e < 8; ++e) vd[8 * c + e] = t8[e]; }
      } else {
#pragma unroll
          for (int e = 0; e < 32; ++e) { kd[e] = 0.f; vd[e] = 0.f; } } }
    __syncthreads();
    const int qi = tid >> 2, part = tid & 3;
    const size_t growq = (size_t)b * SEQ + (size_t)(128 * n + qi) * dil + r;
    float q[64];
    { const bf16* qs = proj + growq * NPROJ + C_QA + h * 64;
#pragma unroll
      for (int c = 0; c < 8; ++c) { float t8[8]; unpack8(*(const v4u*)(qs + 8 * c), t8);
#pragma unroll
          for (int e = 0; e < 8; ++e) q[8 * c + e] = t8[e]; } }
    float m = -INFINITY, l = 0.f, o[64];
#pragma unroll
    for (int e = 0; e < 64; ++e) o[e] = 0.f;
    for (int jj = 0; jj < 33; ++jj) {
        const int j = qi + 4 * jj + part;
        const bool valid = (j <= qi + 128) && (n > 0 || j >= 128);
        if (valid) {
            const f32x4* kr = (const f32x4*)(KS + j * LDK); float s = 0.f;
#pragma unroll
            for (int c = 0; c < 16; ++c) { const f32x4 k4 = kr[c]; s += q[4 * c] * k4.x + q[4 * c + 1] * k4.y + q[4 * c + 2] * k4.z + q[4 * c + 3] * k4.w; }
            const float mn = fmaxf(m, s), sc = __expf(m - mn), p = __expf(s - mn);
            l = l * sc + p; m = mn;
            const f32x4* vr = (const f32x4*)(VS + j * LDK);
#pragma unroll
            for (int c = 0; c < 16; ++c) { const f32x4 v4 = vr[c]; o[4 * c] = o[4 * c] * sc + p * v4.x; o[4 * c + 1] = o[4 * c + 1] * sc + p * v4.y; o[4 * c + 2] = o[4 * c + 2] * sc + p * v4.z; o[4 * c + 3] = o[4 * c + 3] * sc + p * v4.w; }
        }
    }
    float M = fmaxf(m, qx1(m)); M = fmaxf(M, qx2(M));
    const float f = (m == -INFINITY) ? 0.f : __expf(m - M);
    l *= f; l += qx1(l); l += qx2(l);
    const float il = 1.0f / l;
#pragma unroll
    for (int e = 0; e < 64; ++e) { float t = o[e] * f; t += qx1(t); t += qx2(t); o[e] = t * il; }
    float w[16];
#pragma unroll
    for (int e = 0; e < 16; ++e) w[e] = part == 0 ? o[e] : (part == 1 ? o[16 + e] : (part == 2 ? o[32 + e] : o[48 + e]));
    bf16* op = (bf16*)(a.ws() + WS_ATTP) + ((size_t)pat * T + growq) * 256 + h * 64 + part * 16;
    { v4u w0, w1; w0.x = pk2(w[0], w[1]); w0.y = pk2(w[2], w[3]); w0.z = pk2(w[4], w[5]); w0.w = pk2(w[6], w[7]); w1.x = pk2(w[8], w[9]); w1.y = pk2(w[10], w[11]); w1.z = pk2(w[12], w[13]); w1.w = pk2(w[14], w[15]);
      *(v4u*)op = w0; *(v4u*)(op + 8) = w1; }
    if (part == 0) ((float*)(a.ws() + WS_LSE))[((size_t)pat * T + growq) * 4 + h] = M + __logf(l);
    __syncthreads();
}
typedef short s16x4_t __attribute__((ext_vector_type(4)));
typedef float f32x16_t __attribute__((ext_vector_type(16)));
typedef float f32x2_t __attribute__((ext_vector_type(2)));
typedef __bf16 bf16x2_t __attribute__((ext_vector_type(2)));
DI unsigned cvtpk(float lo, float hi) { f32x2_t v = {lo, hi}; bf16x2_t b = __builtin_convertvector(v, bf16x2_t); return __builtin_bit_cast(unsigned, b); }
DI s16x4_t ldtr(const LAS char* p) { return __builtin_bit_cast(s16x4_t, __builtin_amdgcn_ds_read_tr16_b64_v4i16((LAS s16x4_t*)p)); }
DI int crow16(int r, int hh) { return (r & 3) + 8 * (r >> 2) + 4 * hh; }
struct AttnUnitId { int pat, b, h, dil, r, u; };
DI AttnUnitId attn_decode(int unit) { AttnUnitId d; d.pat = unit >> 9; const int rem = unit & 511; d.b = rem >> 8; d.h = (rem >> 6) & 3; const int cu = rem & 63;
    d.dil = d.pat == 0 ? 1 : (d.pat == 1 ? 4 : 16); const int upc = 64 / d.dil; d.r = cu / upc; d.u = cu % upc; return d; }
DI unsigned attn_issue_kv(const bf16* proj, const AttnUnitId& d, int tid, v4u (&kv)[6], v4u (&vv)[6]) {
    const int kc0 = 256 * d.u - 128 + (tid >> 3);
    const bf16* p0 = proj + ((size_t)d.b * SEQ + (size_t)d.r) * NPROJ + C_KA + d.h * 64 + (tid & 7) * 8;
    unsigned mask = 0u;
#pragma unroll
    for (int it = 0; it < 6; ++it) { const int kc = kc0 + 64 * it, kcc = kc < 0 ? 0 : kc; mask |= (kc >= 0 ? 1u : 0u) << it;
        const bf16* p = p0 + (size_t)(kcc * d.dil) * NPROJ; kv[it] = *(const v4u*)p; vv[it] = *(const v4u*)(p + (C_VA - C_KA)); }
    return mask;
}
template <class F> DI void attn_run(const KArgs& a, LAS char* lds, int nun, const F& unit_of, int tid) {
    asm volatile("" : "+v"(tid));
    if (nun <= 0) return;
    constexpr int RS = 144;
    LAS char* KL = lds; LAS char* VL = lds + 384 * RS;
    const bf16* proj = (const bf16*)(a.ws() + WS_PROJ);
    const int w = tid >> 6, lane = tid & 63, ql = lane & 31, hh = lane >> 5;
    const int q4 = (lane & 15) >> 2, p4 = lane & 3, blk = (lane >> 4) & 1;
    AttnUnitId d = attn_decode(unit_of(0));
    v4u kv[6], vv[6];
    unsigned kvmask = attn_issue_kv(proj, d, tid, kv, vv);
    bf16x8_t qn[4];
    { const size_t grow = (size_t)d.b * SEQ + (size_t)(256 * d.u + 32 * w + ql) * d.dil + d.r;
#pragma unroll
      for (int s = 0; s < 4; ++s) qn[s] = *(const bf16x8_t*)(proj + grow * NPROJ + C_QA + d.h * 64 + 16 * s + 8 * hh); }
    for (int k = 0; k < nun; ++k) {
#pragma unroll
        for (int it = 0; it < 6; ++it) { const int c = tid + 512 * it, row = c >> 3, ch = c & 7; const bool ok = (kvmask >> it) & 1u; const v4u z4 = (v4u){0u, 0u, 0u, 0u};
            *(LAS v4u*)(KL + row * RS + ch * 16) = ok ? kv[it] : z4; *(LAS v4u*)(VL + row * RS + ch * 16) = ok ? vv[it] : z4; }
        const AttnUnitId dc = d; const size_t growc = (size_t)d.b * SEQ + (size_t)(256 * d.u + 32 * w + ql) * d.dil + d.r;
        bf16x8_t qc[4];
#pragma unroll
        for (int s = 0; s < 4; ++s) qc[s] = qn[s];
        __syncthreads();
        d = attn_decode(unit_of(k + 1 < nun ? k + 1 : k)); kvmask = attn_issue_kv(proj, d, tid, kv, vv);
        { const size_t grow = (size_t)d.b * SEQ + (size_t)(256 * d.u + 32 * w + ql) * d.dil + d.r;
#pragma unroll
          for (int s = 0; s < 4; ++s) qn[s] = *(const bf16x8_t*)(proj + grow * NPROJ + C_QA + d.h * 64 + 16 * s + 8 * hh); }
        f32x16_t p[5];
#pragma unroll
        for (int kt = 0; kt < 5; ++kt) {
#pragma unroll
            for (int e = 0; e < 16; ++e) p[kt][e] = 0.f;
#pragma unroll
            for (int s = 0; s < 4; ++s) { const bf16x8_t kf = *(const LAS bf16x8_t*)(KL + (32 * w + 32 * kt + ql) * RS + 32 * s + 16 * hh); p[kt] = __builtin_amdgcn_mfma_f32_32x32x16_bf16(kf, qc[s], p[kt], 0, 0, 0); } }
        const int kc0 = 256 * dc.u + 32 * w - 128;
        float m = -INFINITY;
#pragma unroll
        for (int kt = 0; kt < 5; ++kt)
#pragma unroll
            for (int e = 0; e < 16; ++e) { const int c = crow16(e, hh);
                bool valid;
                if (kt == 0) valid = (c >= ql) && (kc0 >= 0); else if (kt == 4) valid = (c <= ql); else valid = (kc0 + 32 * kt >= 0);
                p[kt][e] = valid ? p[kt][e] : -INFINITY; m = fmaxf(m, p[kt][e]); }
        m = fmaxf(m, __shfl_xor(m, 32));
        float l = 0.f;
#pragma unroll
        for (int kt = 0; kt < 5; ++kt)
#pragma unroll
            for (int e = 0; e < 16; ++e) { const float pe = __builtin_amdgcn_exp2f(p[kt][e] - m); p[kt][e] = pe; l += pe; }
        l += __shfl_xor(l, 32);
        f32x16_t o[2];
#pragma unroll
        for (int e = 0; e < 16; ++e) { o[0][e] = 0.f; o[1][e] = 0.f; }
#pragma unroll
        for (int kt = 0; kt < 5; ++kt)
#pragma unroll
            for (int s = 0; s < 2; ++s) {
                v4u pw; pw.x = cvtpk(p[kt][8 * s], p[kt][8 * s + 1]); pw.y = cvtpk(p[kt][8 * s + 2], p[kt][8 * s + 3]); pw.z = cvtpk(p[kt][8 * s + 4], p[kt][8 * s + 5]); pw.w = cvtpk(p[kt][8 * s + 6], p[kt][8 * s + 7]);
                const bf16x8_t pb = __builtin_bit_cast(bf16x8_t, pw);
                const int row0 = 32 * w + 32 * kt + 16 * s + 4 * hh + q4;
#pragma unroll
                for (int db = 0; db < 2; ++db) { const LAS char* vp = VL + row0 * RS + (32 * db + 16 * blk + 4 * p4) * 2;
                    const s16x4_t lo = ldtr(vp), hi = ldtr(vp + 8 * RS);
                    const bf16x8_t af = __builtin_shufflevector(lo, hi, 0, 1, 2, 3, 4, 5, 6, 7);
                    o[db] = __builtin_amdgcn_mfma_f32_32x32x16_bf16(af, pb, o[db], 0, 0, 0); } }
        const float il = 1.0f / l;
        bf16* op = (bf16*)(a.ws() + WS_ATTP) + ((size_t)dc.pat * T + growc) * 256 + dc.h * 64;
#pragma unroll
        for (int db = 0; db < 2; ++db)
#pragma unroll
            for (int g = 0; g < 4; ++g) { v2u wv; wv.x = cvtpk(o[db][4 * g] * il, o[db][4 * g + 1] * il); wv.y = cvtpk(o[db][4 * g + 2] * il, o[db][4 * g + 3] * il);
                *(v2u*)(op + 32 * db + 8 * g + 4 * hh) = wv; }
        if (hh == 0) ((float*)(a.ws() + WS_LSE))[((size_t)dc.pat * T + growc) * 4 + dc.h] = (m + __log2f(l)) * 0.6931471805599453f;
        __syncthreads();
    }
}
DI void ret_load_rope_bf16(LAS char* dst, int rs, const bf16* proj, size_t grow0, int pos0, int col0, float scale, bool zeta, float lg, const float* tabR, int tid) {
    const int row = tid >> 2, qd = tid & 3;
    const bf16* src = proj + (grow0 + row) * NPROJ + col0;
    float own[16], par[16];
    { float t8[8]; unpack8(*(const v4u*)(src + qd * 16), t8);
#pragma unroll
      for (int e = 0; e < 8; ++e) own[e] = t8[e];
      unpack8(*(const v4u*)(src + qd * 16 + 8), t8);
#pragma unroll
      for (int e = 0; e < 8; ++e) own[8 + e] = t8[e];
      unpack8(*(const v4u*)(src + (qd ^ 2) * 16), t8);
#pragma unroll
      for (int e = 0; e < 8; ++e) par[e] = t8[e];
      unpack8(*(const v4u*)(src + (qd ^ 2) * 16 + 8), t8);
#pragma unroll
      for (int e = 0; e < 8; ++e) par[8 + e] = t8[e]; }
    const float* cs = tabR + ((size_t)(pos0 + row) * 32 + (qd & 1) * 16) * 2;
    float sc = scale; if (zeta) sc *= __expf(lg * (float)(127 - row));
    float o[16];
#pragma unroll
    for (int e = 0; e < 16; ++e) { const float c = cs[2 * e], s = cs[2 * e + 1]; o[e] = ((qd < 2) ? own[e] * c - par[e] * s : own[e] * c + par[e] * s) * sc; }
    v4u w0, w1; w0.x = pk2(o[0], o[1]); w0.y = pk2(o[2], o[3]); w0.z = pk2(o[4], o[5]); w0.w = pk2(o[6], o[7]); w1.x = pk2(o[8], o[9]); w1.y = pk2(o[10], o[11]); w1.z = pk2(o[12], o[13]); w1.w = pk2(o[14], o[15]);
    *(LAS v4u*)(dst + row * rs + qd * 32) = w0; *(LAS v4u*)(dst + row * rs + qd * 32 + 16) = w1;
}
constexpr int RKS = 144, RVS = 272;
DI void ret_kv_unit_mfma(const KArgs& a, LAS char* lds, int unit, int tid) {
    asm volatile("" : "+v"(tid));
    const int n = unit & 127, h = (unit >> 7) & 3, b = unit >> 9;
    LAS char* KL = lds; LAS char* VL = lds + 128 * RKS;
    const bf16* proj = (const bf16*)(a.ws() + WS_PROJ); const size_t grow0 = (size_t)b * SEQ + n * 128;
    const float lg = ret_loggamma(h);
    ret_load_rope_bf16(KL, RKS, proj, grow0, n * 128, C_KR + h * 64, 0.125f, true, lg, (const float*)(a.ws() + WS_TABR), tid);
    { const int row = tid >> 2, qq = tid & 3; const v4u* src = (const v4u*)(proj + (grow0 + row) * NPROJ + C_VR + h * 128 + qq * 32);
#pragma unroll
      for (int c = 0; c < 4; ++c) *(LAS v4u*)(VL + row * RVS + qq * 64 + c * 16) = src[c]; }
    __syncthreads();
    const int w = tid >> 6, lane = tid & 63, ql = lane & 31, hh = lane >> 5, q4 = (lane & 15) >> 2, p4 = lane & 3, blk = (lane >> 4) & 1;
    const int et = w >> 1, dt = w & 1;
    f32x16_t acc;
#pragma unroll
    for (int e = 0; e < 16; ++e) acc[e] = 0.f;
#pragma unroll
    for (int s = 0; s < 8; ++s) { const int row0 = 16 * s + 8 * hh + q4;
        const LAS char* vp = VL + row0 * RVS + (32 * et + 16 * blk + 4 * p4) * 2; const LAS char* kp = KL + row0 * RKS + (32 * dt + 16 * blk + 4 * p4) * 2;
        const s16x4_t alo = ldtr(vp), ahi = ldtr(vp + 4 * RVS), blo = ldtr(kp), bhi = ldtr(kp + 4 * RKS);
        const bf16x8_t af = __builtin_shufflevector(alo, ahi, 0, 1, 2, 3, 4, 5, 6, 7), bfr = __builtin_shufflevector(blo, bhi, 0, 1, 2, 3, 4, 5, 6, 7);
        acc = __builtin_amdgcn_mfma_f32_32x32x16_bf16(af, bfr, acc, 0, 0, 0); }
    float* kv = (float*)(a.ws() + WS_KV) + ((size_t)((b * 4 + h) * 128 + n)) * 8192;
#pragma unroll
    for (int e = 0; e < 16; ++e) kv[(32 * et + crow16(e, hh)) * 64 + 32 * dt + ql] = acc[e];
    __syncthreads();
}
struct RetRaw { v4u q[4], k[4], v[4], g[4]; f32x4 pv[4]; };
DI void ret_issue(const KArgs& a, int unit, int tid, RetRaw& r) {
    const int n = unit & 127, h = (unit >> 7) & 3, b = unit >> 9, row = tid >> 2, qd = tid & 3;
    const bf16* base = (const bf16*)(a.ws() + WS_PROJ) + ((size_t)b * SEQ + n * 128 + row) * NPROJ;
    const bf16* sq = base + C_QR + h * 64; const bf16* sk = base + C_KR + h * 64; const bf16* sv = base + C_VR + h * 128 + qd * 32;
    r.q[0] = *(const v4u*)(sq + qd * 16); r.q[1] = *(const v4u*)(sq + qd * 16 + 8); r.q[2] = *(const v4u*)(sq + (qd ^ 2) * 16); r.q[3] = *(const v4u*)(sq + (qd ^ 2) * 16 + 8);
    r.k[0] = *(const v4u*)(sk + qd * 16); r.k[1] = *(const v4u*)(sk + qd * 16 + 8); r.k[2] = *(const v4u*)(sk + (qd ^ 2) * 16); r.k[3] = *(const v4u*)(sk + (qd ^ 2) * 16 + 8);
#pragma unroll
    for (int c = 0; c < 4; ++c) { r.v[c] = *(const v4u*)(sv + 8 * c); r.g[c] = *(const v4u*)(base + C_GR + h * 128 + qd * 32 + 8 * c); }
    const f32x4* sp = (const f32x4*)((const float*)(a.ws() + WS_KV) + ((size_t)((b * 4 + h) * 128 + n)) * 8192 + row * 64 + qd * 16);
#pragma unroll
    for (int c = 0; c < 4; ++c) r.pv[c] = sp[c];
}
DI void ret_rope_store(LAS char* dst, const v4u (&raw)[4], const float* cs, int qd, float scale) {
    float own[16], par[16];
    { float t8[8]; unpack8(raw[0], t8);
#pragma unroll
      for (int e = 0; e < 8; ++e) own[e] = t8[e];
      unpack8(raw[1], t8);
#pragma unroll
      for (int e = 0; e < 8; ++e) own[8 + e] = t8[e];
      unpack8(raw[2], t8);
#pragma unroll
      for (int e = 0; e < 8; ++e) par[e] = t8[e];
      unpack8(raw[3], t8);
#pragma unroll
      for (int e = 0; e < 8; ++e) par[8 + e] = t8[e]; }
    float o[16];
#pragma unroll
    for (int e = 0; e < 16; ++e) { const float c = cs[2 * e], s = cs[2 * e + 1]; o[e] = ((qd < 2) ? own[e] * c - par[e] * s : own[e] * c + par[e] * s) * scale; }
    v4u w0, w1; w0.x = pk2(o[0], o[1]); w0.y = pk2(o[2], o[3]); w0.z = pk2(o[4], o[5]); w0.w = pk2(o[6], o[7]); w1.x = pk2(o[8], o[9]); w1.y = pk2(o[10], o[11]); w1.z = pk2(o[12], o[13]); w1.w = pk2(o[14], o[15]);
    *(LAS v4u*)dst = w0; *(LAS v4u*)(dst + 16) = w1;
}
template <class F> DI void ret_out_run(const KArgs& a, LAS char* lds, int layer, int nun, const F& unit_of, int tid) {
    asm volatile("" : "+v"(tid));
    if (nun <= 0) return;
    LAS char* QL = lds; LAS char* KL = lds + 128 * RKS; LAS char* VL = lds + 2 * 128 * RKS; LAS char* PL = VL + 128 * RVS; LAS float* ST = (LAS float*)(PL + 128 * RKS);
    const bf16* proj = (const bf16*)(a.ws() + WS_PROJ); const float* tabR = (const float*)(a.ws() + WS_TABR);
    const int w = tid >> 6, lane = tid & 63, ql = lane & 31, hh = lane >> 5, q4 = (lane & 15) >> 2, p4 = lane & 3, blk = (lane >> 4) & 1;
    const int ib = w >> 1, eh = w & 1, i = 32 * ib + ql, row = tid >> 2, qd = tid & 3;
    RetRaw raw; int unit = unit_of(0);
    ret_issue(a, unit, tid, raw);
    for (int kk = 0; kk < nun; ++kk) {
        const int n = unit & 127, h = (unit >> 7) & 3, b = unit >> 9; const size_t grow0 = (size_t)b * SEQ + n * 128; const float lg = ret_loggamma(h);
        { const float* cs = tabR + ((size_t)(n * 128 + row) * 32 + (qd & 1) * 16) * 2;
          ret_rope_store(QL + row * RKS + qd * 32, raw.q, cs, qd, 1.0f); ret_rope_store(KL + row * RKS + qd * 32, raw.k, cs, qd, 0.125f * __expf(-lg * (float)(row + 1)));
#pragma unroll
          for (int c = 0; c < 4; ++c) *(LAS v4u*)(VL + row * RVS + qd * 64 + c * 16) = raw.v[c];
          v4u w0, w1; w0.x = pk2(raw.pv[0].x, raw.pv[0].y); w0.y = pk2(raw.pv[0].z, raw.pv[0].w); w0.z = pk2(raw.pv[1].x, raw.pv[1].y); w0.w = pk2(raw.pv[1].z, raw.pv[1].w);
          w1.x = pk2(raw.pv[2].x, raw.pv[2].y); w1.y = pk2(raw.pv[2].z, raw.pv[2].w); w1.z = pk2(raw.pv[3].x, raw.pv[3].y); w1.w = pk2(raw.pv[3].z, raw.pv[3].w);
          *(LAS v4u*)(PL + row * RKS + qd * 32) = w0; *(LAS v4u*)(PL + row * RKS + qd * 32 + 16) = w1; }
        v4u gcur[4];
#pragma unroll
        for (int c = 0; c < 4; ++c) gcur[c] = raw.g[c];
        __syncthreads();
        unit = unit_of(kk + 1 < nun ? kk + 1 : kk); ret_issue(a, unit, tid, raw);
        bf16x8_t qf[4], qsf[4];
        { const float xi = __expf(lg * (float)(i + 1));
#pragma unroll
          for (int s = 0; s < 4; ++s) { qf[s] = *(const LAS bf16x8_t*)(QL + i * RKS + 32 * s + 16 * hh); float t8[8]; unpack8(__builtin_bit_cast(v4u, qf[s]), t8);
              v4u ww; ww.x = cvtpk(t8[0] * xi, t8[1] * xi); ww.y = cvtpk(t8[2] * xi, t8[3] * xi); ww.z = cvtpk(t8[4] * xi, t8[5] * xi); ww.w = cvtpk(t8[6] * xi, t8[7] * xi); qsf[s] = __builtin_bit_cast(bf16x8_t, ww); } }
        f32x16_t o[2];
#pragma unroll
        for (int e = 0; e < 16; ++e) { o[0][e] = 0.f; o[1][e] = 0.f; }
#pragma unroll
        for (int t = 0; t < 2; ++t)
#pragma unroll
            for (int s = 0; s < 4; ++s) { const bf16x8_t af = *(const LAS bf16x8_t*)(PL + (64 * eh + 32 * t + ql) * RKS + 32 * s + 16 * hh); o[t] = __builtin_amdgcn_mfma_f32_32x32x16_bf16(af, qsf[s], o[t], 0, 0, 0); }
        for (int jb = 0; jb <= ib; ++jb) {
            f32x16_t p;
#pragma unroll
            for (int e = 0; e < 16; ++e) p[e] = 0.f;
#pragma unroll
            for (int s = 0; s < 4; ++s) { const bf16x8_t kf = *(const LAS bf16x8_t*)(KL + (32 * jb + ql) * RKS + 32 * s + 16 * hh); p = __builtin_amdgcn_mfma_f32_32x32x16_bf16(kf, qsf[s], p, 0, 0, 0); }
            if (jb == ib) {
#pragma unroll
                for (int e = 0; e < 16; ++e) p[e] = (ql >= crow16(e, hh)) ? p[e] : 0.f; }
#pragma unroll
            for (int s2 = 0; s2 < 2; ++s2) {
                v4u pw; pw.x = cvtpk(p[8 * s2], p[8 * s2 + 1]); pw.y = cvtpk(p[8 * s2 + 2], p[8 * s2 + 3]); pw.z = cvtpk(p[8 * s2 + 4], p[8 * s2 + 5]); pw.w = cvtpk(p[8 * s2 + 6], p[8 * s2 + 7]);
                const bf16x8_t pb = __builtin_bit_cast(bf16x8_t, pw);
                const int row0 = 32 * jb + 16 * s2 + 4 * hh + q4;
#pragma unroll
                for (int t = 0; t < 2; ++t) { const LAS char* vp = VL + row0 * RVS + (64 * eh + 32 * t + 16 * blk + 4 * p4) * 2;
                    const s16x4_t lo = ldtr(vp), hi = ldtr(vp + 8 * RVS);
                    const bf16x8_t af = __builtin_shufflevector(lo, hi, 0, 1, 2, 3, 4, 5, 6, 7);
                    o[t] = __builtin_amdgcn_mfma_f32_32x32x16_bf16(af, pb, o[t], 0, 0, 0); } }
        }
        float s1 = 0.f, s2 = 0.f;
#pragma unroll
        for (int t = 0; t < 2; ++t)
#pragma unroll
            for (int e = 0; e < 16; ++e) { s1 += o[t][e]; s2 += o[t][e] * o[t][e]; }
        s1 += __shfl_xor(s1, 32); s2 += __shfl_xor(s2, 32);
        if (hh == 0) { ST[((ib * 2 + eh) * 32 + ql) * 2] = s1; ST[((ib * 2 + eh) * 32 + ql) * 2 + 1] = s2; }
        __syncthreads();
        const float t1 = ST[((ib * 2) * 32 + ql) * 2] + ST[((ib * 2 + 1) * 32 + ql) * 2], t2 = ST[((ib * 2) * 32 + ql) * 2 + 1] + ST[((ib * 2 + 1) * 32 + ql) * 2 + 1];
        const float mu = t1 * (1.f / 128.f), var = fmaxf(t2 * (1.f / 128.f) - mu * mu, 0.f), rstd = rsqrtf(var + 1e-5f);
#pragma unroll
        for (int t = 0; t < 2; ++t)
#pragma unroll
            for (int g4 = 0; g4 < 4; ++g4) { v2u yw; yw.x = cvtpk((o[t][4 * g4] - mu) * rstd, (o[t][4 * g4 + 1] - mu) * rstd); yw.y = cvtpk((o[t][4 * g4 + 2] - mu) * rstd, (o[t][4 * g4 + 3] - mu) * rstd);
                *(LAS v2u*)(VL + i * RVS + (64 * eh + 32 * t + 8 * g4 + 4 * hh) * 2) = yw; }
        __syncthreads();
        { const float* gn = a.in(I_GNG) + layer * 512 + h * 128 + qd * 32;
          bf16* op = (bf16*)(a.ws() + WS_XN) + (grow0 + row) * DM + 256 + h * 128 + qd * 32;
#pragma unroll
          for (int c = 0; c < 4; ++c) { float y8[8], g8[8], o8[8]; unpack8(*(const LAS v4u*)(VL + row * RVS + qd * 64 + c * 16), y8); unpack8(gcur[c], g8);
              const f32x4 n0 = *(const f32x4*)(gn + 8 * c), n1 = *(const f32x4*)(gn + 8 * c + 4); const float nn[8] = {n0.x, n0.y, n0.z, n0.w, n1.x, n1.y, n1.z, n1.w};
#pragma unroll
              for (int e = 0; e < 8; ++e) o8[e] = g8[e] * sigmoidf_(g8[e]) * y8[e] * nn[e];
              *(v4u*)(op + 8 * c) = pack8(o8); } }
        __syncthreads();
    }
}
template <int PARTS = 3> DI void ssm_out_unit(const KArgs& a, LAS char* lds, int layer, int unit, int tid) {
    asm volatile("" : "+v"(tid));
    const int chunk = unit & 127, b = unit >> 7, wave = __builtin_amdgcn_readfirstlane(tid >> 6), lane = tid & 63;
    constexpr int ZLD = 528;
    LAS char* ZS = lds; LAS char* XS = lds + 128 * ZLD + wave * (16 * SSM_XLD); LAS char* UWb = lds + 128 * ZLD + 8 * 16 * SSM_XLD + wave * 512;
    const float* sst = (const float*)(a.ws() + WS_SST);
    if (PARTS & 1) for (int gi = 0; gi < 2; ++gi) { const int g = wave + 8 * gi;
        const size_t so = (((size_t)(b * 128 + chunk)) * 1024 + g * 64 + lane) * 2; float hr = sst[so], hi = sst[so + 1];
        ssm_wave_chunk<true>(a, layer, b, chunk, g, XS, UWb, ZS, ZLD, hr, hi, lane); }
    __syncthreads();
    if (!(PARTS & 2)) return;
    const int ql = lane & 31, hh = lane >> 5, n = 32 * wave + ql;
    const bf16* glwt = (const bf16*)(a.ws() + WS_SSM + (size_t)layer * SSM_LAYER_BYTES + SSM_GLWT);
    bf16x8_t bfr[16];
#pragma unroll
    for (int s = 0; s < 16; ++s) bfr[s] = *(const bf16x8_t*)(glwt + (size_t)n * 256 + 16 * s + 8 * hh);
    const float bn = a.in(I_GLB)[layer * 256 + n];
    bf16* mixed = (bf16*)(a.ws() + WS_XN); const size_t grow0 = (size_t)b * SEQ + chunk * 128;
#pragma unroll 1
    for (int rt = 0; rt < 4; ++rt) { f32x16_t acc;
#pragma unroll
        for (int e = 0; e < 16; ++e) acc[e] = 0.f;
#pragma unroll
        for (int s = 0; s < 16; ++s) { const bf16x8_t af = *(const LAS bf16x8_t*)(ZS + (32 * rt + ql) * ZLD + (16 * s + 8 * hh) * 2); acc = __builtin_amdgcn_mfma_f32_32x32x16_bf16(af, bfr[s], acc, 0, 0, 0); }
#pragma unroll
        for (int e = 0; e < 16; ++e) { const int t = 32 * rt + crow16(e, hh); const float z = bf2f(*(const LAS bf16*)(ZS + t * ZLD + n * 2));
            mixed[(grow0 + t) * DM + 768 + n] = (bf16)f2bf(z * sigmoidf_(acc[e] + bn)); } }
    __syncthreads();
}
#ifndef MK_PER_PHASE
#define MK_PER_PHASE 0
#endif

#ifdef DIS_KV
#define TST_KV(x)
#else
#define TST_KV(x) x
#endif
#ifdef DIS_ATT
#define TST_ATT(x)
#else
#define TST_ATT(x) x
#endif
#ifdef DIS_RO
#define TST_RO(x)
#else
#define TST_RO(x) x
#endif
#ifdef DIS_SO
#define TST_SO(x)
#else
#define TST_SO(x) x
#endif
#ifdef DIS_PRO
#define EN_PRO 0
#else
#define EN_PRO 1
#endif
#ifdef DIS_INP
#define EN_INP 0
#else
#define EN_INP 1
#endif
#ifdef DIS_M1
#define EN_M1 0
#else
#define EN_M1 1
#endif
#ifdef DIS_M2
#define EN_M2 0
#else
#define EN_M2 1
#endif
#ifdef DIS_M3
#define EN_M3 0
#else
#define EN_M3 1
#endif
#ifdef DIS_WOUT
#define EN_WOUT 0
#else
#define EN_WOUT 1
#endif
#ifdef DIS_N2
#define EN_N2 0
#else
#define EN_N2 1
#endif
#ifdef DIS_FUP
#define EN_FUP 0
#else
#define EN_FUP 1
#endif
#ifdef DIS_FDN
#define EN_FDN 0
#else
#define EN_FDN 1
#endif
#ifdef DIS_N1
#define EN_N1 0
#else
#define EN_N1 1
#endif
#ifdef DIS_MUP
#define EN_MUP 0
#else
#define EN_MUP 1
#endif
#ifdef DIS_MDN
#define EN_MDN 0
#else
#define EN_MDN 1
#endif

#ifdef DUP_RO
#define PROBE_RO(x) x
#else
#define PROBE_RO(x)
#endif
#ifdef DUP_SO
#define PROBE_SO(x) x
#else
#define PROBE_SO(x)
#endif
#ifndef THIN_REPS
#define THIN_REPS 1
#endif
#ifndef EXTRA_BARS
#define EXTRA_BARS 0
#endif
#ifndef WOUT_REPS
#define WOUT_REPS 1
#endif
#ifndef FDN_REPS
#define FDN_REPS 1
#endif
#ifndef MDN_EPI
#define MDN_EPI pg8::EpiMoeDown
#endif
#ifndef MDN_REPS
#define MDN_REPS 1
#endif
#ifndef RO_REPS
#define RO_REPS 1
#endif
#ifndef INP_REPS
#define INP_REPS 1
#endif
#ifndef FUP_REPS
#define FUP_REPS 1
#endif
#ifndef MUP_REPS
#define MUP_REPS 1
#endif
#ifdef DUP_CONV
#define MOECONV_REPS 2
#else
#define MOECONV_REPS 1
#endif
#ifdef DUP_ATT
#define PROBE_ATT(x) x
#else
#define PROBE_ATT(x)
#endif
#ifdef DUP_KV
#define PROBE_KV(x) x
#else
#define PROBE_KV(x)
#endif
#ifndef ATT_REPS
#define ATT_REPS 1
#endif
#ifndef SO_PARTS
#define SO_PARTS 3
#endif
#ifndef ORDER_SPLIT
#define ORDER_SPLIT 1
#endif
#ifndef CONV_IN_WOUT
#define CONV_IN_WOUT 1
#endif
#define MOE_ITEM(d, it_) do { const int e = (it_) / 5376; int r = (it_) - e * 5376; \
                    if (r < 3584) { const int up = r / 1792; r -= up * 1792; const int kb = r / 112, nb = r % 112, n0 = 32 * nb; \
                        d.W = args.in(up ? I_MU : I_MG) + (size_t)e * DM * DFE; d.ldw = DFE; d.WT = (unsigned char*)(ws + WS_MGU) + (size_t)e * 2 * DFE * DM; d.ldo = DM; d.k0 = 64 * kb; d.n0 = n0; d.drow0 = (n0 >> 7) * 256 + (n0 & 127) + up * 128; d.scale = 32.0f; } \
                    else { r -= 3584; const int kb = r / 32, nb = r % 32; \
                        d.W = args.in(I_MD) + (size_t)e * DFE * DM; d.ldw = DM; d.WT = (unsigned char*)(ws + WS_MDN) + (size_t)e * DM * DFE; d.ldo = DFE; d.k0 = 64 * kb; d.n0 = 32 * nb; d.drow0 = 32 * nb; d.scale = 64.0f; } } while (0)
#define MOE_CONV() do { float* scr = (float*)(L + wave * 16384); constexpr int NIT_ = 8 * 5376; \
                for (int rep_ = 0; rep_ < MOECONV_REPS; ++rep_) \
                    for (int it = gw; it < NIT_; it += 2 * NGW) { const int it2 = (it + NGW < NIT_) ? it + NGW : it;     \
                        T8Item da, db; float va[32], vb[32]; MOE_ITEM(da, it); MOE_ITEM(db, it2); t8_load(va, da, lane); t8_load(vb, db, lane); \
                        t8_store(va, da, scr, lane); t8_store(vb, db, scr, lane); } } while (0)
constexpr int PH_PRO = 0, PH_L0 = 1, PH_PER_LAYER = 13, NPH = 1 + 2 * PH_PER_LAYER;
__global__ void __launch_bounds__(NWAVES * 64, 2) fwd_kernel(Args args_) {
    const KArgs args;
    extern __shared__ __attribute__((aligned(16))) unsigned char lds[];
    const int tid0 = threadIdx.x;
    const int wave0 = __builtin_amdgcn_readfirstlane(tid0 >> 6);
    const int G = gridDim.x, bx = blockIdx.x, NGW = G * NWAVES;
#define PHASE_IDS int wave = wave0; asm volatile("" : "+s"(wave)); unsigned z_ = 0u; asm volatile("" : "+v"(z_)); const int lane = (int)__builtin_amdgcn_mbcnt_hi(~0u, __builtin_amdgcn_mbcnt_lo(~0u, z_)); const int tid = wave * 64 + lane, gw = bx * NWAVES + wave; (void)tid; (void)gw
    unsigned char* ws = args.ws();
    unsigned* ctl = (unsigned*)(ws + WS_CTL);
    volatile LAS unsigned* MISC = (volatile LAS unsigned*)((LAS unsigned char*)lds + MISC_OFF);
    if (tid0 < 32) MISC[tid0] = 0u;
    __syncthreads();
    const int lo = args.ph_lo(), hi = args.ph_hi();
    XcdBarrier bar; bar.bar = ctl + CW_BAR; bar.x = 0; bar.st = nullptr;
    if (hi - lo > 1) bar = xcd_barrier_post(ctl + CW_BAR, MISC + 8, tid0 == 0);
#define IN(k) (lo <= (k) && (k) < hi)
#define SEAM(k) do { if ((k) + 1 < hi) { int w_ = wave0; asm volatile("" : "+s"(w_)); unsigned zz_ = 0u; asm volatile("" : "+v"(zz_)); const int l_ = (int)__builtin_amdgcn_mbcnt_hi(~0u, __builtin_amdgcn_mbcnt_lo(~0u, zz_)); xcd_barrier(bar, (w_ * 64 + l_) == 0); } } while (0)
    char* L = (char*)lds;
    LAS unsigned char* L3 = (LAS unsigned char*)lds;
    bf16* XN = (bf16*)(ws + WS_XN); bf16* PROJ = (bf16*)(ws + WS_PROJ);

    if (EN_PRO && IN(PH_PRO)) { PHASE_IDS; for (int rep_ = 0; rep_ < THIN_REPS; ++rep_) phase_prologue(args, L, gw, NGW, wave, lane); for (int xb_ = 0; xb_ < EXTRA_BARS; ++xb_) SEAM(PH_PRO); SEAM(PH_PRO); }

#define LAYER_BODY(layer) do { \
        const int base = PH_L0 + layer * PH_PER_LAYER; \
         \
        if (EN_INP && IN(base + 0)) { PHASE_IDS; \
            pg8::Gemm g{layer == 0 ? XN : (const bf16*)(ws + WS_XN2), (const bf16*)(ws + WS_WIN) + (size_t)layer * NPROJ * DM, T, NPROJ, DM, DM}; pg8::StaticOrder S; S.init(T, NPROJ, G, bx); \
            LAS float* RS = (LAS float*)((LAS char*)lds + 132096); if (layer == 1) build_rs(RS, S, (const float*)(ws + WS_SSQ), tid); \
            pg8::EpiBf16 E{PROJ, NPROJ, layer == 1 ? RS : (LAS float*)nullptr}; \
            for (int rep_ = 0; rep_ < INP_REPS; ++rep_) pg8::gemm_phase<pg8::EpiBf16, pg8::StaticOrder, true, true, false>(L3, g, S, E, tid); \
            SEAM(base + 0); \
        } \
         \
        if (EN_M1 && IN(base + 1)) { \
            \
          const int og_ = ORDER_SPLIT ? ((bx >> 3) & 1) : 0; \
          _Pragma("unroll 1") for (int s_ = 0; s_ < 3; ++s_) { const int part_ = og_ ? 2 - s_ : s_; \
           if (part_ == 0) { PHASE_IDS; \
            const float* tabA = (const float*)(ws + WS_TABA); \
            prep_phase(PROJ, args.in(I_QNG) + layer * 64, args.in(I_KNG) + layer * 64, tabA, gw, NGW, lane); \
           } else if (part_ == 1) { \
            { PHASE_IDS; TST_KV(for (int u = bx; u < 1024; u += G) ret_kv_unit_mfma(args, (LAS char*)lds, u, tid);) } \
            PROBE_KV({ PHASE_IDS; for (int u = bx; u < 1024; u += G) ret_kv_unit_mfma(args, (LAS char*)lds, u, tid); }) \
           } else { \
            for (int rep_ = 0; rep_ < THIN_REPS; ++rep_) { PHASE_IDS; for (int u = bx; u < 256; u += G) { const int chunk = u & 127, b = u >> 7; LAS char* XS = (LAS char*)lds + wave * (16 * SSM_XLD); LAS char* UWb = (LAS char*)lds + 8 * 16 * SSM_XLD + wave * 512; \
                for (int gi = 0; gi < 2; ++gi) { const int g = wave + 8 * gi; float hr = 0.f, hi_ = 0.f; \
                    ssm_wave_chunk<false>(args, layer, b, chunk, g, XS, UWb, XS, 0, hr, hi_, lane); \
                    float* sst = (float*)(ws + WS_SST) + (((size_t)(b * 128 + chunk)) * 1024 + g * 64 + lane) * 2; sst[0] = hr; sst[1] = hi_; } \
                __syncthreads(); } } \
           } \
           __syncthreads(); } \
            SEAM(base + 1); \
        } \
         \
        if (EN_M2 && IN(base + 2)) { PHASE_IDS; \
            for (int u = bx; u < 128; u += G) {                     \
                const int gid = u * 512 + tid, bh = gid >> 13, el = gid & 8191; const float cd = __expf(ret_loggamma(bh & 3) * 128.0f); \
                float* p = (float*)(ws + WS_KV) + (size_t)bh * 128 * 8192 + el; float st = 0.f; \
                for (int n0 = 0; n0 < 128; n0 += 64) { float x[64];        \
                    _Pragma("unroll") for (int k = 0; k < 64; ++k) x[k] = p[(size_t)(n0 + k) * 8192]; \
                    _Pragma("unroll") for (int k = 0; k < 64; ++k) { p[(size_t)(n0 + k) * 8192] = st; st = cd * st + x[k]; } } } \
            { const int idx = bx;                                    \
              for (int u = idx; u < 4; u += G) {                    \
                const int gid = u * 512 + tid, b = gid >> 10, gp = gid & 1023; \
                const float* sp = (const float*)(ws + WS_SSM + (size_t)layer * SSM_LAYER_BYTES); const float ar = sp[SSM_ABARL / 4 + 2 * gp], ai = sp[SSM_ABARL / 4 + 2 * gp + 1]; \
                float* p = (float*)(ws + WS_SST) + ((size_t)b * 128 * 1024 + gp) * 2; float cr = 0.f, ci = 0.f; \
                for (int c0 = 0; c0 < 128; c0 += 32) { f32x2_t xv[32]; \
                    _Pragma("unroll") for (int k = 0; k < 32; ++k) xv[k] = *(const f32x2_t*)(p + (size_t)(c0 + k) * 2048); \
                    _Pragma("unroll") for (int k = 0; k < 32; ++k) { f32x2_t o_; o_.x = cr; o_.y = ci; *(f32x2_t*)(p + (size_t)(c0 + k) * 2048) = o_; const float nr = ar * cr - ai * ci + xv[k].x, ni = ar * ci + ai * cr + xv[k].y; cr = nr; ci = ni; } } } } \
            { PHASE_IDS; \
              if (G == 256) { const int na = bx < 128 ? 5 : 7; const int bx_ = bx; \
                  attn_run(args, (LAS char*)lds, na, [bx_](int k) { return (k < 6) ? bx_ + 256 * k : (bx_ - 128) + 1280; }, tid); } \
              else { const int bx_ = bx, G_ = G; attn_run(args, (LAS char*)lds, (1536 - bx + G - 1) / G, [bx_, G_](int k) { return bx_ + G_ * k; }, tid); } } \
            SEAM(base + 2); \
        } \
         \
        if (EN_M3 && IN(base + 3)) { \
          const int og_ = ORDER_SPLIT ? ((bx >> 3) & 1) : 0; \
          _Pragma("unroll 1") for (int s_ = 0; s_ < 3; ++s_) { const int part_ = og_ ? 2 - s_ : s_; \
           if (part_ == 0) { PHASE_IDS; \
            { const bf16* attp = (const bf16*)(ws + WS_ATTP); const float* lse = (const float*)(ws + WS_LSE); const int h = lane >> 4, sub = lane & 15; \
              for (int rep_ = 0; rep_ < THIN_REPS; ++rep_) for (int t0 = gw; t0 < T; t0 += 4 * NGW) { \
                float ls[4][3]; v2u ow[4][3]; \
                _Pragma("unroll") for (int r = 0; r < 4; ++r) { const int t = t0 + r * NGW; if (t < T) { \
                    _Pragma("unroll") for (int p = 0; p < 3; ++p) { ls[r][p] = lse[((size_t)p * T + t) * 4 + h]; ow[r][p] = *(const v2u*)(attp + ((size_t)p * T + t) * 256 + h * 64 + sub * 4); } } } \
                _Pragma("unroll") for (int r = 0; r < 4; ++r) { const int t = t0 + r * NGW; if (t < T) { \
                    const float M = fmaxf(ls[r][0], fmaxf(ls[r][1], ls[r][2])); const float w0 = __expf(ls[r][0] - M), w1 = __expf(ls[r][1] - M), w2 = __expf(ls[r][2] - M); const float iw = 1.0f / (w0 + w1 + w2); \
                    const float r0 = (w0 * bflo(ow[r][0].x) + w1 * bflo(ow[r][1].x) + w2 * bflo(ow[r][2].x)) * iw, r1 = (w0 * bfhi(ow[r][0].x) + w1 * bfhi(ow[r][1].x) + w2 * bfhi(ow[r][2].x)) * iw; \
                    const float r2 = (w0 * bflo(ow[r][0].y) + w1 * bflo(ow[r][1].y) + w2 * bflo(ow[r][2].y)) * iw, r3 = (w0 * bfhi(ow[r][0].y) + w1 * bfhi(ow[r][1].y) + w2 * bfhi(ow[r][2].y)) * iw; \
                    v2u w; w.x = pk2(r0, r1); w.y = pk2(r2, r3); *(v2u*)(XN + (size_t)t * DM + h * 64 + sub * 4) = w; } } } } \
           } else if (part_ == 1) { \
            for (int rep_ = 0; rep_ < RO_REPS; ++rep_) { PHASE_IDS; const int bx_ = bx, G_ = G; ret_out_run(args, (LAS char*)lds, layer, (1024 - bx + G - 1) / G, [bx_, G_](int k) { return bx_ + G_ * k; }, tid); } \
           } else { \
            { PHASE_IDS; TST_SO(for (int u = bx; u < 256; u += G) ssm_out_unit(args, (LAS char*)lds, layer, u, tid);) } \
            PROBE_SO({ PHASE_IDS; for (int u = bx; u < 256; u += G) ssm_out_unit<SO_PARTS>(args, (LAS char*)lds, layer, u, tid); }) \
           } \
           __syncthreads(); } \
            SEAM(base + 3); \
        } \
         \
        if (EN_WOUT && IN(base + 4)) { \
              \
            const int cgrp = (bx >> 3) & 1; \
            if (CONV_IN_WOUT && layer == 1 && cgrp == 0) { PHASE_IDS; MOE_CONV(); __syncthreads(); } \
            if (LATE_CONV && layer == 0 && cgrp == 0) { PHASE_IDS; conv_weights<true>(args, L, gw, NGW, wave, lane); __syncthreads(); } \
            { PHASE_IDS; \
            pg8::Gemm g{XN, (const bf16*)(ws + WS_WOUT) + (size_t)layer * DM * DM, T, DM, DM, DM}; pg8::StaticOrder S; S.init(T, DM, G, bx); \
            for (int rep_ = 0; rep_ < WOUT_REPS; ++rep_) { pg8::EpiResF32 E{(layer == 0 && rep_ == 0) ? args.in(I_X) : args.out(), args.out(), DM, rep_ == WOUT_REPS - 1 ? 1.0f : 0.0f, layer == 0 ? (bf16*)(ws + WS_XN2) : (bf16*)nullptr, args.in(I_N2G), (float*)(ws + WS_SSQ), layer == 0}; \
            pg8::gemm_phase<pg8::EpiResF32, pg8::StaticOrder, true, true, false>(L3, g, S, E, tid); } } \
            if (CONV_IN_WOUT && layer == 1 && cgrp == 1) { PHASE_IDS; __syncthreads(); MOE_CONV(); } \
            if (LATE_CONV && layer == 0 && cgrp == 1) { PHASE_IDS; __syncthreads(); conv_weights<true>(args, L, gw, NGW, wave, lane); } \
            SEAM(base + 4); \
        } \
         \
        if (EN_N2 && layer == 1 && IN(base + 5)) { PHASE_IDS; \
            const float* g2 = args.in(I_N2G) + layer * DM; \
            if (layer == 1) { \
                int* sel_e = (int*)(L + 140000); float* sel_g = (float*)(L + 141024); int* lpair = (int*)(L + 142176); int* lpbase = (int*)(L + 142432); \
                float rw[16][8]; \
        _Pragma("unroll") \
                for (int j = 0; j < 4; ++j) \
        _Pragma("unroll") \
                    for (int c = 0; c < 4; ++c) { const f32x4* rp = (const f32x4*)(args.in(I_RT) + (size_t)(4 * lane + c + 256 * j) * 8); const f32x4 r0 = rp[0], r1 = rp[1]; \
                        rw[j * 4 + c][0] = r0.x; rw[j * 4 + c][1] = r0.y; rw[j * 4 + c][2] = r0.z; rw[j * 4 + c][3] = r0.w; rw[j * 4 + c][4] = r1.x; rw[j * 4 + c][5] = r1.y; rw[j * 4 + c][6] = r1.z; rw[j * 4 + c][7] = r1.w; } \
                f32x4 gg2[4]; \
                _Pragma("unroll") for (int j = 0; j < 4; ++j) gg2[j] = ((const f32x4*)g2)[lane + 64 * j]; \
                for (int u = bx; u < T / 128; u += G) { \
                    if (tid < 64) lpair[tid] = 0; \
                    for (int rr = 0; rr < 16; rr += 2) { f32x4 v[2][4]; \
                        _Pragma("unroll") for (int q_ = 0; q_ < 2; ++q_) { const int m = u * 128 + wave * 16 + rr + q_; \
                            _Pragma("unroll") for (int j = 0; j < 4; ++j) v[q_][j] = __builtin_nontemporal_load((const f32x4*)(args.out() + (size_t)m * DM) + lane + 64 * j); } \
                        _Pragma("unroll") for (int q_ = 0; q_ < 2; ++q_) { const int rl = wave * 16 + rr + q_, m = u * 128 + rl; float ss = 0.f; \
                            _Pragma("unroll") for (int j = 0; j < 4; ++j) ss += (v[q_][j].x * v[q_][j].x + v[q_][j].y * v[q_][j].y) + (v[q_][j].z * v[q_][j].z + v[q_][j].w * v[q_][j].w); \
                            const float rs = rsqrtf(wave_sum(ss) * (1.f / DM) + 1e-6f); \
                            _Pragma("unroll") for (int j = 0; j < 4; ++j) { v[q_][j] = v[q_][j] * rs * gg2[j]; ((unsigned*)((unsigned char*)XN + (size_t)m * DM))[lane + 64 * j] = pg8::pk4_fp8(v[q_][j].x, v[q_][j].y, v[q_][j].z, v[q_][j].w); } \
                            float pl[8]; \
                            _Pragma("unroll") for (int e = 0; e < 8; ++e) { float s = 0.f; \
                                _Pragma("unroll") for (int j = 0; j < 4; ++j) s += v[q_][j].x * rw[j * 4 + 0][e] + v[q_][j].y * rw[j * 4 + 1][e] + v[q_][j].z * rw[j * 4 + 2][e] + v[q_][j].w * rw[j * 4 + 3][e]; \
                                pl[e] = s; } \
                            const bool b5 = (lane & 32) != 0, b4 = (lane & 16) != 0, b3 = (lane & 8) != 0; float w4[4], w2[2], w1; \
                            _Pragma("unroll") for (int k = 0; k < 4; ++k) { const float send = b5 ? pl[k] : pl[k + 4], keep = b5 ? pl[k + 4] : pl[k]; w4[k] = keep + __shfl_xor(send, 32); } \
                            _Pragma("unroll") for (int k = 0; k < 2; ++k) { const float send = b4 ? w4[k] : w4[k + 2], keep = b4 ? w4[k + 2] : w4[k]; w2[k] = keep + __shfl_xor(send, 16); } \
                            { const float send = b3 ? w2[0] : w2[1], keep = b3 ? w2[1] : w2[0]; w1 = keep + __shfl_xor(send, 8); } \
                            w1 += __shfl_xor(w1, 4); w1 += __shfl_xor(w1, 2); w1 += __shfl_xor(w1, 1); \
                            float lg[8]; \
                            _Pragma("unroll") for (int e = 0; e < 8; ++e) lg[e] = __builtin_bit_cast(float, __builtin_amdgcn_readlane(__builtin_bit_cast(int, w1), 8 * e)); \
                            int e0 = 0; float l0 = lg[0]; \
                            _Pragma("unroll") for (int e = 1; e < 8; ++e) if (lg[e] > l0) { l0 = lg[e]; e0 = e; } \
                            int e1 = -1; float l1 = -INFINITY; \
                            _Pragma("unroll") for (int e = 0; e < 8; ++e) if (e != e0 && lg[e] > l1) { l1 = lg[e]; e1 = e; } \
                            const float g0 = 1.0f / (1.0f + __expf(l1 - l0)); \
                            if (lane == 0) { sel_e[rl * 2] = e0; sel_e[rl * 2 + 1] = e1; sel_g[rl * 2] = g0; sel_g[rl * 2 + 1] = 1.0f - g0; } } } \
                    __syncthreads(); \
                    int pr = 0, ppos = 0; \
                    if (tid < 128) { pr = sel_e[tid * 2] * 8 + sel_e[tid * 2 + 1]; ppos = atomicAdd(&lpair[pr], 1); } \
                    __syncthreads(); \
                    if (tid < 64) lpbase[tid] = (int)__hip_atomic_fetch_add(ctl + CW_PAIRCNT + tid, (unsigned)lpair[tid], __ATOMIC_RELAXED, __HIP_MEMORY_SCOPE_AGENT); \
                    __syncthreads(); \
                    if (tid < 128) { v4u ti; ti.x = (unsigned)(sel_e[tid * 2] | (sel_e[tid * 2 + 1] << 8)); ti.y = (unsigned)(lpbase[pr] + ppos); ti.z = __float_as_uint(sel_g[tid * 2]); ti.w = __float_as_uint(sel_g[tid * 2 + 1]); \
                        ((v4u*)(ws + WS_TOKINFO))[u * 128 + tid] = ti; } \
                    __syncthreads(); \
                } \
                if (!CONV_IN_WOUT) { MOE_CONV(); } \
            } \
            SEAM(base + 5); \
        } \
        if (layer == 1 && IN(base + 6)) { PHASE_IDS; \
            int* sel_e = (int*)(L + 140000); float* sel_g = (float*)(L + 141024); int* lcnt = (int*)(L + 142048); int* lbase = (int*)(L + 142112); int* fl = (int*)(L + 142688); int* pc = (int*)(L + 142944); int* pa = (int*)(L + 143200); \
            int* tokmap = (int*)(ws + WS_MAPS); float* gatemap = (float*)(ws + WS_MAPS + 2 * MiB); \
            if (tid < 64) { pc[tid] = (int)__hip_atomic_load(ctl + CW_PAIRCNT + tid, __ATOMIC_RELAXED, __HIP_MEMORY_SCOPE_AGENT); fl[tid] = 0; } \
            __syncthreads(); \
            if (tid == 0) { int rsum = 0; \
                for (int i = 0; i < 8; ++i) { int a_ = 0; for (int j = 0; j < 8; ++j) a_ += pc[i * 8 + j]; pa[i] = a_; pa[8 + i] = a_ & 255; pa[16 + i] = -(a_ & 255); rsum += a_ & 255; } \
                for (int m_ = rsum >> 8; m_ > 0; --m_) { int best = -1, bv = -1; for (int i = 0; i < 8; ++i) if (pa[16 + i] <= 0 && pa[8 + i] > bv) { bv = pa[8 + i]; best = i; } if (best >= 0) pa[16 + best] = 256 - pa[8 + best]; } \
                for (int i = 0; i < 8; ++i) if (pa[16 + i] < 0) { int s_ = -pa[16 + i]; \
                    for (int j = 0; j < 8 && s_ > 0; ++j) if (j != i && pa[16 + j] > 0) { int x_ = s_ < pa[16 + j] ? s_ : pa[16 + j]; if (x_ > pc[i * 8 + j]) x_ = pc[i * 8 + j]; fl[i * 8 + j] = x_; s_ -= x_; pa[16 + j] -= x_; } } } \
            __syncthreads(); \
            for (int u = bx; u < T / 128; u += G) { \
                if (tid < 16) lcnt[tid] = 0; \
                if (tid < 128) { const v4u ti = ((const v4u*)(ws + WS_TOKINFO))[u * 128 + tid]; const int e0 = (int)(ti.x & 255u), e1 = (int)((ti.x >> 8) & 255u); const bool flip = (int)ti.y < fl[e0 * 8 + e1]; \
                    sel_e[tid * 2] = flip ? e1 : e0; sel_e[tid * 2 + 1] = flip ? e0 : e1; sel_g[tid * 2] = __uint_as_float(flip ? ti.w : ti.z); sel_g[tid * 2 + 1] = __uint_as_float(flip ? ti.z : ti.w); } \
                __syncthreads(); \
                int e = 0, posv = 0; const int rl = tid >> 1, r = tid & 1; \
                if (tid < 256) { e = sel_e[rl * 2 + r]; posv = atomicAdd(&lcnt[r * 8 + e], 1); } \
                __syncthreads(); \
                if (tid < 16) lbase[tid] = (int)__hip_atomic_fetch_add(ctl + CW_MOECNT + tid, (unsigned)lcnt[tid], __ATOMIC_RELAXED, __HIP_MEMORY_SCOPE_AGENT); \
                __syncthreads(); \
                if (tid < 256) { const int slot = lbase[r * 8 + e] + posv; tokmap[(size_t)(r * 8 + e) * 32768 + slot] = u * 128 + rl; gatemap[(size_t)(r * 8 + e) * 32768 + slot] = sel_g[rl * 2 + r]; } \
                __syncthreads(); \
            } \
            SEAM(base + 6); \
        } \
        if (layer == 0) { \
             \
            if (EN_FUP && IN(base + 6)) { PHASE_IDS; \
                pg8::Gemm g{(const bf16*)(ws + WS_XN2), (const bf16*)(ws + WS_FGU), T, 2 * DFF, DM, DM}; pg8::StaticOrder S; S.init(T, 2 * DFF, G, bx); \
                LAS float* RS = (LAS float*)((LAS char*)lds + 132096); build_rs(RS, S, (const float*)(ws + WS_SSQ), tid); \
                pg8::EpiSwiGLU E{(bf16*)(ws + WS_ACT), DFF, RS}; \
                for (int rep_ = 0; rep_ < FUP_REPS; ++rep_) pg8::gemm_phase<pg8::EpiSwiGLU, pg8::StaticOrder, true, true, false>(L3, g, S, E, tid); \
                SEAM(base + 6); \
            } \
            if (EN_FDN && IN(base + 7)) { PHASE_IDS; \
                pg8::Gemm g{(const bf16*)(ws + WS_ACT), (const bf16*)(ws + WS_FDN), T, DM, DFF, DFF}; pg8::StaticOrder S; S.init(T, DM, G, bx); \
                for (int rep_ = 0; rep_ < FDN_REPS; ++rep_) { pg8::EpiResF32 E{args.out(), args.out(), DM, rep_ == FDN_REPS - 1 ? 1.0f : 0.0f, (bf16*)(ws + WS_XN2), args.in(I_N1G) + DM, (float*)(ws + WS_SSQ), false}; \
                pg8::gemm_phase<pg8::EpiResF32, pg8::StaticOrder, true, true, false>(L3, g, S, E, tid); } \
                SEAM(base + 7); \
            } \
        } else { \
             \
          \
        const int mgrp = (bx >> 3) & 1; \
        _Pragma("unroll 1") \
            for (int st = 0; st < 4; ++st) { \
                const bool is_up = (st == 0) || (st == 1 && mgrp == 0) || (st == 2 && mgrp == 1); const int r = (st == 0) ? 0 : (st == 3) ? 1 : (is_up ? 1 : 0); \
                const int* tokmap = (const int*)(ws + WS_MAPS) + (size_t)r * 8 * 32768; const float* gatemap = (const float*)(ws + WS_MAPS + 2 * MiB) + (size_t)r * 8 * 32768; \
                unsigned char* mact = ws + (r == 0 ? WS_MACT : WS_MACT2); \
                if (is_up) { if (EN_MUP && IN(base + 7)) { PHASE_IDS; \
                    pg8::Gemm g{XN, (const bf16*)(ws + WS_MGU), 0, 2 * DFE, DM, DM}; pg8::MoeOrder S; S.init_moe(ctl + CW_MOECNT + r * 8, tokmap, 2 * DFE, G, bx); S.build_ltab((LAS int*)((LAS char*)lds + 132096), tid); \
                    pg8::EpiSwiGLU8 E{mact, DFE, 1.0f / 32.0f, 4.0f}; \
                    for (int rep_ = 0; rep_ < MUP_REPS; ++rep_) pg8::gemm_phase<pg8::EpiSwiGLU8, pg8::MoeOrder, true, true, true, true>(L3, g, S, E, tid); \
                } } else { if (EN_MDN && IN(base + 7)) { PHASE_IDS; \
                    pg8::Gemm g{(const bf16*)mact, (const bf16*)(ws + WS_MDN), 0, DM, DFE, DFE}; pg8::MoeOrder S; S.init_moe(ctl + CW_MOECNT + r * 8, tokmap, DM, G, bx, r == 1 ? 128 : (1 << 20)); \
                    for (int rep_ = 0; rep_ < MDN_REPS; ++rep_) { MDN_EPI E{args.out(), DM, tokmap, gatemap, rep_ == MDN_REPS - 1 ? (1.0f / 256.0f) : 0.0f}; \
                    pg8::gemm_phase<MDN_EPI, pg8::MoeOrder, true, true, false, true>(L3, g, S, E, tid); } \
                    if (r == 1) { pg8::MoeOrder SA; SA.init_moe(ctl + CW_MOECNT + r * 8, tokmap, DM, G, bx); const int ntl = (SA.tiles() - 128) * 4; const int KS = ntl <= 18 ? 14 : 7;     \
                      pg8::MoeTailOrder ST; ST.init(&SA, G, bx, KS, DFE / KS, 32); \
                      pg8::Gemm gt{(const bf16*)mact, (const bf16*)(ws + WS_MDN), 0, DM, DFE / KS, DFE}; pg8::EpiPart EP{(float*)(ws + WS_XN)}; \
                      pg8::gemm_phase<pg8::EpiPart, pg8::MoeTailOrder, true, true, false, true>(L3, gt, ST, EP, tid); } \
                } } \
                __syncthreads(); \
                if (st != 1) SEAM(base + 7 + st); \
            } \
            { const int r = 1; const int* tokmap = (const int*)(ws + WS_MAPS) + (size_t)r * 8 * 32768; const float* gatemap = (const float*)(ws + WS_MAPS + 2 * MiB) + (size_t)r * 8 * 32768; \
                if (EN_MDN && IN(base + 12)) { PHASE_IDS; \
                    pg8::MoeOrder SA; SA.init_moe(ctl + CW_MOECNT + r * 8, tokmap, DM, G, bx); int ntl = (SA.tiles() - 128) * 4; ntl = ntl < 0 ? 0 : (ntl > 32 ? 32 : ntl); const int KS = ntl <= 18 ? 14 : 7; \
                    const float* part = (const float*)(ws + WS_XN); float* outp = args.out(); \
                    for (int gi = bx * 512 + tid; gi < ntl * 16384; gi += G * 512) { const int t = gi >> 14, row = (gi >> 6) & 255, c4 = gi & 63; \
                        pg8::Unit u; u.pm = 128 + (t >> 2); u.pn = t & 3; SA.decode(u); const int slot = u.r0 + row; \
                        if (slot < u.cn) { const int tk = tokmap[u.e * 32768 + slot]; const float gt_ = gatemap[u.e * 32768 + slot]; \
                            f32x4 s = (f32x4){0.f, 0.f, 0.f, 0.f}; \
                            { const float* pp_ = part + (size_t)(t * KS) * 65536 + row * 256 + c4 * 4; f32x4 pv_[14];        \
                              if (KS == 14) { _Pragma("unroll") for (int ks = 0; ks < 14; ++ks) pv_[ks] = *(const f32x4*)(pp_ + (size_t)ks * 65536); _Pragma("unroll") for (int ks = 0; ks < 14; ++ks) s = s + pv_[ks]; } \
                              else { _Pragma("unroll") for (int ks = 0; ks < 7; ++ks) pv_[ks] = *(const f32x4*)(pp_ + (size_t)ks * 65536); _Pragma("unroll") for (int ks = 0; ks < 7; ++ks) s = s + pv_[ks]; } } \
                            float* op = outp + (size_t)tk * DM + u.pn * 256 + c4 * 4; *(f32x4*)op = *(const f32x4*)op + s * (gt_ * (1.0f / 256.0f)); } } \
                    SEAM(base + 12); \
                } \
            } \
        } \
    } while (0)
    LAYER_BODY(0);
    LAYER_BODY(1);
#undef LAYER_BODY
#undef IN
#undef SEAM
}

extern "C" void kernel_launch(void* const* d_in, const int* in_sizes, int n_in, void* d_out, int out_size, void* d_ws, size_t ws_size, hipStream_t stream) {
    static int grid = 0;
    if (grid == 0) {
        if (n_in != 25 || in_sizes[0] != T * DM || out_size != T * DM || ws_size < WS_END) { fprintf(stderr, "kernel_launch: unexpected shapes (n_in %d, in0 %d, out %d, ws %zu); nothing launched\n", n_in, n_in > 0 ? in_sizes[0] : -1, out_size, ws_size); grid = -1; return; }
        int dev = 0, cus = 0, per_cu = 0;
        if (hipGetDevice(&dev) != hipSuccess || hipDeviceGetAttribute(&cus, hipDeviceAttributeMultiprocessorCount, dev) != hipSuccess) { grid = -1; return; }
        if (hipFuncSetAttribute((const void*)fwd_kernel, hipFuncAttributeMaxDynamicSharedMemorySize, LDS_BYTES) != hipSuccess) { fprintf(stderr, "kernel_launch: hipFuncSetAttribute failed\n"); grid = -1; return; }
        if (hipOccupancyMaxActiveBlocksPerMultiprocessor(&per_cu, (const void*)fwd_kernel, NWAVES * 64, LDS_BYTES) != hipSuccess || per_cu < 1) { fprintf(stderr, "kernel_launch: occupancy query reports %d blocks per CU\n", per_cu); }
        (void)hipGetLastError();
        grid = cus;
    }
    if (grid < 0) return;
    const size_t ws_off = ((ws_size - WS_END) >> 20) << 20;
    (void)hipMemsetAsync((char*)d_ws + ws_off + WS_CTL, 0, CTL_ZERO_BYTES, stream);
    Args a{};
    for (int i = 0; i < 25; ++i) a.in[i] = (const float*)d_in[i];
    a.out = (float*)d_out; a.ws = (unsigned char*)d_ws;
#if MK_PER_PHASE
    for (int p = 0; p < NPH; ++p) { if (p == PH_L0 + 6 + 3 || p == PH_L0 + 6 + 4) continue; a.ph_lo = p; a.ph_hi = p + 1; hipLaunchKernelGGL(fwd_kernel, dim3(grid), dim3(NWAVES * 64), LDS_BYTES, stream, a); }
#else
    a.ph_lo = (int)((ws_off >> 20) << 8); a.ph_hi = NPH; hipLaunchKernelGGL(fwd_kernel, dim3(grid), dim3(NWAVES * 64), LDS_BYTES, stream, a);
#endif
}
```
